# Optimizing an MI355X kernel written in HIP

```python
import math
import jax, jax.numpy as jnp
from jax import lax
import numpy as np

D_MODEL = 1024
BATCH = 4
SEQ = 8192
DEPTH = 1
DEC_BATCH = 8
DEC_SEQ = 4096
PAST_LEN = 128

GROUP_SIZE = 64
CONV_WIDTH = D_MODEL // 2
HYENA_WIDTH = D_MODEL - CONV_WIDTH
CONV_GROUPS = CONV_WIDTH // GROUP_SIZE
HYENA_GROUPS = HYENA_WIDTH // GROUP_SIZE
PROJ_WIDTH = 3 * CONV_WIDTH + 3 * HYENA_WIDTH
SHORT_K = 3
POS_BANDS = 16
POS_EMB = 1 + 2 * POS_BANDS
FILTER_HIDDEN = 64
DECAY_TARGET = 1e-2
FAST_DECAY_PCT = 0.3
SLOW_DECAY_PCT = 1.5
PEER_HEADS = 8
PEER_KEYS = 128
PEER_EXPERTS = PEER_KEYS * PEER_KEYS
PEER_TOPK = 16
PEER_QDIM = 256
PEER_HALF = PEER_QDIM // 2
PEER_TOKEN_BLOCK = 128
ALPHA = (2.0 * DEPTH) ** 0.25
BETA = (8.0 * DEPTH) ** -0.25
LN_EPS = 1e-5

kernel_name = 'hybrid_conv_hyena_peer_encoder'

F32 = jnp.float32


def layer_norm(x, g, b):
    xf = x.astype(F32)
    mu = jnp.mean(xf, -1, keepdims=True)
    var = jnp.mean(jnp.square(xf - mu), -1, keepdims=True)
    return ((xf - mu) * lax.rsqrt(var + LN_EPS) * g.astype(F32) + b.astype(F32)).astype(x.dtype)


def short_conv(z, w):
    L = z.shape[1]
    pad = SHORT_K // 2
    zp = jnp.pad(z, ((0, 0), (pad, pad), (0, 0)))
    out = zp[:, 0:L] * w[0]
    for j in range(1, SHORT_K):
        out = out + zp[:, j:j + L] * w[j]
    return out


def hyena_filter(L, w1, b1, freq, w2, b2, w3, decay):
    t = jnp.linspace(0.0, 1.0, L, dtype=F32)[:, None]
    w = (2.0 * math.pi) * jnp.arange(L, dtype=F32)[:, None] / L
    f = jnp.linspace(1e-4, POS_BANDS - 1, POS_BANDS, dtype=F32)[None, :]
    feat = jnp.concatenate([t, jnp.cos(f * w), -jnp.sin(f * w)], -1)
    fr = freq.astype(F32)
    h = jnp.sin(fr * (feat @ w1.astype(F32) + b1.astype(F32)))
    h = jnp.sin(fr * (h @ w2.astype(F32) + b2.astype(F32)))
    h = (h @ w3.astype(F32)).reshape(L, 2, HYENA_WIDTH)
    h = h * jnp.exp(-t[:, :, None] * jnp.abs(decay.astype(F32))[None])
    fwd, bwd = h[:, 0], h[:, 1]
    k = jnp.concatenate([fwd, jnp.zeros((1, HYENA_WIDTH), F32), bwd[:0:-1]], 0)
    return k / jnp.sum(jnp.abs(k), 0, keepdims=True)


def long_conv(z, k):
    L = z.shape[1]
    n = 2 * L
    zf = jnp.fft.rfft(z.astype(F32), n=n, axis=1)
    kf = jnp.fft.rfft(k, n=n, axis=0)
    return jnp.fft.irfft(zf * kf[None], n=n, axis=1)[:, :L].astype(z.dtype)


def peer(x, wq, keys, u, v):
    B, L, D = x.shape
    xs = x.reshape(-1, PEER_TOKEN_BLOCK, D)

    def block(xb):
        T = xb.shape[0]
        q = (xb @ wq).reshape(T, PEER_HEADS, 2, PEER_HALF)
        s = jnp.einsum('thpk,hpnk->thpn', q, keys).astype(F32)
        s_top, i_top = lax.top_k(s, PEER_TOPK)
        cand = (s_top[:, :, 0, :, None] + s_top[:, :, 1, None, :]).reshape(T, PEER_HEADS, PEER_TOPK * PEER_TOPK)
        cidx = (i_top[:, :, 0, :, None] * PEER_KEYS + i_top[:, :, 1, None, :]).reshape(T, PEER_HEADS, PEER_TOPK * PEER_TOPK)
        best, pos = lax.top_k(cand, PEER_TOPK)
        eidx = jnp.take_along_axis(cidx, pos, -1)
        g = jax.nn.softmax(best, -1)
        u_sel = jnp.take(u, eidx, axis=0)
        act = jax.nn.gelu(jnp.einsum('thkd,td->thk', u_sel, xb).astype(F32), approximate=False)
        coef = (g * act).astype(x.dtype)
        v_sel = jnp.take(v, eidx, axis=0)
        return jnp.einsum('thk,thkd->td', coef, v_sel)

    return lax.map(block, xs).reshape(B, L, D)


def encoder_layer(x, w_in, b_in, a_conv_w, h_conv_w, h_conv_b, hf_w1, hf_b1, hf_freq, hf_w2, hf_b2,
                  hf_w3, hy_decay, hy_bias, w_out, ln1_g, ln1_b, peer_wq, peer_keys, peer_u, peer_v,
                  ln2_g, ln2_b):
    L = x.shape[1]
    p = x @ w_in + b_in
    cw = CONV_WIDTH
    a_b, a_c, a_h = p[..., :cw], p[..., cw:2 * cw], p[..., 2 * cw:3 * cw]
    y_a = a_b * short_conv(a_c * a_h, a_conv_w)
    hy = short_conv(p[..., 3 * cw:], h_conv_w) + h_conv_b
    hw = HYENA_WIDTH
    x0, x1, hv = hy[..., :hw], hy[..., hw:2 * hw], hy[..., 2 * hw:]
    k = hyena_filter(L, hf_w1, hf_b1, hf_freq, hf_w2, hf_b2, hf_w3, hy_decay)
    z = hv * x1
    z = long_conv(z, k) + z * hy_bias
    y_h = x0 * z
    mix = jnp.concatenate([y_a, y_h], -1) @ w_out
    x = layer_norm(ALPHA * x + mix, ln1_g, ln1_b)
    x = layer_norm(ALPHA * x + peer(x, peer_wq, peer_keys, peer_u, peer_v), ln2_g, ln2_b)
    return x


def setup_inputs(seed: int = 0) -> dict:
    key = jax.random.key(seed)
    ks = jax.random.split(key, 24)
    nrm = lambda k, shape, s: jax.random.normal(k, shape, F32) * s
    decay_lo = abs(math.log(DECAY_TARGET)) / SLOW_DECAY_PCT
    decay_hi = abs(math.log(DECAY_TARGET)) / FAST_DECAY_PCT
    decay_base = jnp.linspace(decay_lo, decay_hi, HYENA_WIDTH, dtype=F32)
    return {
        'x_prompt': nrm(ks[0], (BATCH, SEQ, D_MODEL), 1.0),
        'x_sample': nrm(ks[1], (DEC_BATCH, DEC_SEQ, D_MODEL), 1.0),
        'w_in': nrm(ks[2], (DEPTH, D_MODEL, PROJ_WIDTH), D_MODEL ** -0.5),
        'b_in': nrm(ks[3], (DEPTH, PROJ_WIDTH), 0.02),
        'a_conv_w': nrm(ks[4], (DEPTH, SHORT_K, CONV_WIDTH), SHORT_K ** -0.5),
        'h_conv_w': nrm(ks[5], (DEPTH, SHORT_K, 3 * HYENA_WIDTH), SHORT_K ** -0.5),
        'h_conv_b': nrm(ks[6], (DEPTH, 3 * HYENA_WIDTH), 0.02),
        'hf_w1': nrm(ks[7], (DEPTH, POS_EMB, FILTER_HIDDEN), POS_EMB ** -0.5),
        'hf_b1': nrm(ks[8], (DEPTH, FILTER_HIDDEN), 0.02),
        'hf_freq': 1.0 + nrm(ks[9], (DEPTH, FILTER_HIDDEN), 0.01),
        'hf_w2': nrm(ks[10], (DEPTH, FILTER_HIDDEN, FILTER_HIDDEN), FILTER_HIDDEN ** -0.5),
        'hf_b2': nrm(ks[11], (DEPTH, FILTER_HIDDEN), 0.02),
        'hf_w3': nrm(ks[12], (DEPTH, FILTER_HIDDEN, 2 * HYENA_WIDTH), FILTER_HIDDEN ** -0.5),
        'hy_decay': decay_base + nrm(ks[13], (DEPTH, 2, HYENA_WIDTH), 0.1),
        'hy_bias': nrm(ks[14], (DEPTH, HYENA_WIDTH), 1.0),
        'w_out': nrm(ks[15], (DEPTH, D_MODEL, D_MODEL), BETA * D_MODEL ** -0.5),
        'ln1_g': 1.0 + nrm(ks[16], (DEPTH, D_MODEL), 0.02),
        'ln1_b': nrm(ks[17], (DEPTH, D_MODEL), 0.02),
        'peer_wq': nrm(ks[18], (DEPTH, D_MODEL, PEER_HEADS * PEER_QDIM), D_MODEL ** -0.5),
        'peer_keys': nrm(ks[19], (DEPTH, PEER_HEADS, 2, PEER_KEYS, PEER_HALF), PEER_HALF ** -0.5),
        'peer_u': nrm(ks[20], (DEPTH, PEER_EXPERTS, D_MODEL), D_MODEL ** -0.5),
        'peer_v': nrm(ks[21], (DEPTH, PEER_EXPERTS, D_MODEL), BETA * PEER_HEADS ** -0.5),
        'ln2_g': 1.0 + nrm(ks[22], (DEPTH, D_MODEL), 0.02),
        'ln2_b': nrm(ks[23], (DEPTH, D_MODEL), 0.02),
    }


def reference(x_prompt, x_sample, w_in, b_in, a_conv_w, h_conv_w, h_conv_b, hf_w1, hf_b1, hf_freq,
              hf_w2, hf_b2, hf_w3, hy_decay, hy_bias, w_out, ln1_g, ln1_b, peer_wq, peer_keys,
              peer_u, peer_v, ln2_g, ln2_b):
    def trunk(x):
        for l in range(DEPTH):
            x = encoder_layer(x, w_in[l], b_in[l], a_conv_w[l], h_conv_w[l], h_conv_b[l], hf_w1[l],
                              hf_b1[l], hf_freq[l], hf_w2[l], hf_b2[l], hf_w3[l], hy_decay[l],
                              hy_bias[l], w_out[l], ln1_g[l], ln1_b[l], peer_wq[l], peer_keys[l],
                              peer_u[l], peer_v[l], ln2_g[l], ln2_b[l])
        return x

    y_prompt = trunk(x_prompt)
    y_sample = trunk(x_sample)
    return (y_prompt, y_sample)
```

```cpp
#include <hip/hip_runtime.h>
#include <hip/hip_cooperative_groups.h>
#include <cstdio>
namespace cg = cooperative_groups;
#ifndef ONE_LAUNCH
#define ONE_LAUNCH 0
#endif
#ifdef PROBE_A
#define PROBE_NOPEER 1
#endif
namespace pg8 {
#define PG8_LAS __attribute__((address_space(3)))
typedef unsigned short bf16_t;
typedef short bf16x8 __attribute__((ext_vector_type(8)));
typedef float f32x4 __attribute__((ext_vector_type(4)));
typedef unsigned u32x4 __attribute__((ext_vector_type(4)));
constexpr int BM = 256, BK = 64, HALF = 128, HTB = HALF * BK * 2  , STAGE_BYTES = 8 * HTB, NXCD = 8, WGM = 8;

__host__ __device__ __forceinline__ int lds_byte(int r, int c) { const int st = (r >> 4) * 2 + (c >> 5), rr = r & 15, cc = c & 31, ob = rr * 64 + cc * 2; return st * 1024 + (ob ^ (((ob >> 9) & 1) << 5)); }
__host__ __device__ __forceinline__ void stage_rc(int b, int& R, int& C) { const int st = b / 1024, sb = b % 1024, swz = sb ^ (((sb >> 9) & 1) << 5); R = (st >> 1) * 16 + swz / 64; C = (st & 1) * 32 + (swz % 64) / 2; }
__host__ __device__ __forceinline__ int perm32(int rho) { const int n = rho >> 4, i = rho & 15; return 8 * (i >> 2) + 4 * n + (i & 3); }

struct Unit { int pm, pn; };
struct Gemm { const bf16_t* A; const bf16_t* Bt; int M, N, K; };

struct StaticOrder {
    int nM, nN, nwg, G, c;
    __host__ __device__ void init(int M, int N, int G_, int c_) { nM = M / BM; nN = N / BM; nwg = nM * nN; G = G_; c = c_; }
    __host__ __device__ bool next(int i, Unit& u) const {
        const long L = (long)i * G + c; if (L >= nwg) return false;
        int wgid = (int)L; { const int q = nwg / NXCD, r = nwg % NXCD, xcd = wgid % NXCD, off = wgid / NXCD; wgid = (xcd < r ? xcd * (q + 1) : r * (q + 1) + (xcd - r) * q) + off; }
        const int nig = WGM * nN, gid = wgid / nig, fm = gid * WGM, gsz = (nM - fm) < WGM ? (nM - fm) : WGM;
        u.pm = fm + ((wgid % nig) % gsz); u.pn = (wgid % nig) / gsz; return true;
    }
    __device__ __forceinline__ void a_ready(const Unit&) const {}
    __device__ __forceinline__ void done(const Unit&) const {}
};
struct CountedOrder : StaticOrder {
    const unsigned* ready; unsigned need; unsigned* tmo;
    __device__ __forceinline__ void a_ready(const Unit& u) const {
        if (threadIdx.x < 64) {
            const unsigned long long t0 = __builtin_amdgcn_s_memrealtime(); unsigned polls = 0;
            while ((unsigned)__builtin_amdgcn_readfirstlane(__hip_atomic_load(ready + 64 * u.pm, __ATOMIC_RELAXED, __HIP_MEMORY_SCOPE_AGENT)) < need) {
                if ((++polls & 255u) == 0u && __builtin_amdgcn_readfirstlane(__hip_atomic_load(tmo, __ATOMIC_RELAXED, __HIP_MEMORY_SCOPE_AGENT)) != 0u) break;
                if (__builtin_amdgcn_s_memrealtime() - t0 > 2000000ull) {
                    if (threadIdx.x == 0) { unsigned expect = 0u; __hip_atomic_compare_exchange_strong(tmo + 1, &expect, 0x600u | (unsigned)(u.pm & 0xff), __ATOMIC_RELAXED, __ATOMIC_RELAXED, __HIP_MEMORY_SCOPE_AGENT); __hip_atomic_store(tmo, 1u, __ATOMIC_RELAXED, __HIP_MEMORY_SCOPE_AGENT); }
                    break; }
                __builtin_amdgcn_s_sleep(2); }
            __builtin_amdgcn_fence(__ATOMIC_ACQUIRE, "agent");
            asm volatile("s_waitcnt vmcnt(0)" ::: "memory");
        }
#if !defined(BROKEN_HOOK_NO_BARRIER)
        asm volatile("" ::: "memory"); __builtin_amdgcn_s_barrier(); asm volatile("" ::: "memory");
#endif
    }
};

__device__ __forceinline__ unsigned cvt_pk_bf16(float lo, float hi) { unsigned r; asm volatile("v_cvt_pk_bf16_f32 %0, %1, %2" : "=v"(r) : "v"(lo), "v"(hi)); return r; }
typedef float f32x2 __attribute__((ext_vector_type(2)));
__device__ __forceinline__ f32x2 gelu_pk(f32x2 v) {
    const f32x2 av = __builtin_elementwise_abs(v), d = av * 0.2316418882f + 1.0f;
    f32x2 t; t.x = __builtin_amdgcn_rcpf(d.x); t.y = __builtin_amdgcn_rcpf(d.y);
    f32x2 q = t * 0.5307027145f + (-0.7265760135f); q = q * t + 0.7107068705f; q = q * t + (-0.142248368f); q = q * t + 0.127414796f; q = q * t;
    const f32x2 s = (v * v) * (-0.72134752044f);
    f32x2 e; e.x = __builtin_amdgcn_exp2f(s.x); e.y = __builtin_amdgcn_exp2f(s.y);
    const f32x2 m = v * (q * e), r = v - m;
    f32x2 o; o.x = v.x < 0.f ? m.x : r.x; o.y = v.y < 0.f ? m.y : r.y; return o;
}

struct EpiF32 {
    static constexpr bool PERM = false, AFTER_DRAIN = false;
    float* C; int ldc; const float* bias;
    __device__ __forceinline__ void operator()(const f32x4 (&acc)[2][2][4][2], const Unit& u, int wr, int wc, int fr, int fq) const {
        const int row0 = u.pm * BM + wr * 64 + fr, col0 = u.pn * BM + wc * 32 + 4 * fq;
        f32x4 bv[2][2];
#pragma unroll
        for (int bj = 0; bj < 2; ++bj)
#pragma unroll
            for (int n = 0; n < 2; ++n) bv[bj][n] = bias ? *(const f32x4*)(bias + col0 + bj * HALF + n * 16) : (f32x4){0.f, 0.f, 0.f, 0.f};
#pragma unroll
        for (int ai = 0; ai < 2; ++ai)
#pragma unroll
            for (int m = 0; m < 4; ++m) { float* rowp = C + (size_t)(row0 + ai * HALF + m * 16) * ldc + col0;
#pragma unroll
                for (int bj = 0; bj < 2; ++bj)
#pragma unroll
                    for (int n = 0; n < 2; ++n) *(f32x4*)(rowp + bj * HALF + n * 16) = acc[ai][bj][m][n] + bv[bj][n]; }
    }
};
template <int ACT  > struct EpiBf16 {
    static constexpr bool PERM = true, AFTER_DRAIN = false;
    bf16_t* O; int ldc; const float* bias; int split_cols; size_t split_stride;
    __device__ __forceinline__ void operator()(const f32x4 (&acc)[2][2][4][2], const Unit& u, int wr, int wc, int fr, int fq) const {
        const int row0 = u.pm * BM + wr * 64 + fr; int colt = u.pn * BM; bf16_t* base = O;
        if (split_cols) { const int t = colt / split_cols; base += (size_t)t * split_stride; colt -= t * split_cols; }
        const int col0 = colt + wc * 32 + 8 * fq, bcol0 = u.pn * BM + wc * 32 + 8 * fq;
        f32x4 bv[2][2];
#pragma unroll
        for (int bj = 0; bj < 2; ++bj)
#pragma unroll
            for (int n = 0; n < 2; ++n) bv[bj][n] = bias ? *(const f32x4*)(bias + bcol0 + bj * HALF + 4 * n) : (f32x4){0.f, 0.f, 0.f, 0.f};
#pragma unroll
        for (int ai = 0; ai < 2; ++ai)
#pragma unroll
            for (int m = 0; m < 4; ++m) { bf16_t* rowp = base + (size_t)(row0 + ai * HALF + m * 16) * ldc + col0;
#pragma unroll
                for (int bj = 0; bj < 2; ++bj) { f32x4 v0 = acc[ai][bj][m][0] + bv[bj][0], v1 = acc[ai][bj][m][1] + bv[bj][1];
                    if (ACT == 1) { f32x2 a = gelu_pk((f32x2){v0[0], v0[1]}), b = gelu_pk((f32x2){v0[2], v0[3]}), c = gelu_pk((f32x2){v1[0], v1[1]}), d = gelu_pk((f32x2){v1[2], v1[3]});
                        v0 = (f32x4){a.x, a.y, b.x, b.y}; v1 = (f32x4){c.x, c.y, d.x, d.y}; }
                    if (ACT == 2) {
#pragma unroll
                        for (int j = 0; j < 4; ++j) { v0[j] = 0.5f * v0[j] * (1.0f + erff(v0[j] * 0.70710678f)); v1[j] = 0.5f * v1[j] * (1.0f + erff(v1[j] * 0.70710678f)); } }
                    u32x4 w; w.x = cvt_pk_bf16(v0[0], v0[1]); w.y = cvt_pk_bf16(v0[2], v0[3]); w.z = cvt_pk_bf16(v1[0], v1[1]); w.w = cvt_pk_bf16(v1[2], v1[3]);
                    *(u32x4*)(rowp + bj * HALF) = w; } }
    }
};

struct PanelStats {
    unsigned* xbuf;
    unsigned* cnt;
    unsigned* tmo;
    int ntn; float eps;
    unsigned code;
    __device__ __forceinline__ bool run(const f32x4 (&v)[2][2][4][2], const Unit& u, int wr, int wc, int fr, int fq, PG8_LAS unsigned char* lds, int wid, int lane) const {
        typedef float f32x2v __attribute__((ext_vector_type(2)));
        PG8_LAS f32x2v* P = (PG8_LAS f32x2v*)lds;
        PG8_LAS f32x2v* S = (PG8_LAS f32x2v*)(lds + 8192);
        PG8_LAS unsigned* flag = (PG8_LAS unsigned*)(lds + 8192 + 2048);
#pragma unroll
        for (int ai = 0; ai < 2; ++ai)
#pragma unroll
            for (int m = 0; m < 4; ++m) {
                float s = 0.f;
#pragma unroll
                for (int bj = 0; bj < 2; ++bj)
#pragma unroll
                    for (int n = 0; n < 2; ++n) { const f32x4 x = v[ai][bj][m][n]; s += (x[0] + x[1]) + (x[2] + x[3]); }
                s += __shfl_xor(s, 16); s += __shfl_xor(s, 32);
                const float mw = s * (1.0f / 64.0f); float q = 0.f;
#pragma unroll
                for (int bj = 0; bj < 2; ++bj)
#pragma unroll
                    for (int n = 0; n < 2; ++n) { const f32x4 d = v[ai][bj][m][n] - mw; q += (d[0] * d[0] + d[1] * d[1]) + (d[2] * d[2] + d[3] * d[3]); }
                q += __shfl_xor(q, 16); q += __shfl_xor(q, 32);
                if (fq == 0) P[(ai * HALF + wr * 64 + m * 16 + fr) * 4 + wc] = (f32x2v){mw, q};
            }
        asm volatile("s_waitcnt lgkmcnt(0)" ::: "memory"); __builtin_amdgcn_s_barrier(); asm volatile("" ::: "memory");
#if defined(BROKEN_NO_WAIT)
        if (blockIdx.x >= 64) { const long long t0 = clock64(); while (clock64() - t0 < 60000) __builtin_amdgcn_s_sleep(8); }
#endif
        const int row = wid * 32 + (lane & 31);
        if (lane < 32) {
            const f32x2v a = P[row * 4 + 0], b = P[row * 4 + 1], c = P[row * 4 + 2], d = P[row * 4 + 3];
            const float mt = (a.x + b.x + c.x + d.x) * 0.25f;
            const float da = a.x - mt, db = b.x - mt, dc = c.x - mt, dd = d.x - mt;
            const float m2 = (a.y + b.y) + (c.y + d.y) + 64.0f * ((da * da + db * db) + (dc * dc + dd * dd));
            unsigned long long* slot = (unsigned long long*)xbuf + ((size_t)(u.pm * BM + row) * 4 + u.pn);
            __hip_atomic_store(slot, ((unsigned long long)__float_as_uint(m2) << 32) | __float_as_uint(mt), __ATOMIC_RELAXED, __HIP_MEMORY_SCOPE_AGENT);
        }
        asm volatile("s_waitcnt vmcnt(0)" ::: "memory");
        if (lane == 0) __hip_atomic_fetch_add(cnt + 64 * u.pm, 1u, __ATOMIC_RELAXED, __HIP_MEMORY_SCOPE_AGENT);
        if (wid == 0) {
            bool dead = false; const unsigned long long t0 = __builtin_amdgcn_s_memrealtime(); const unsigned want = 8u * (unsigned)ntn;
            for (;;) {
#if defined(BROKEN_NO_WAIT)
                break;
#endif
                if ((unsigned)__builtin_amdgcn_readfirstlane(__hip_atomic_load(cnt + 64 * u.pm, __ATOMIC_RELAXED, __HIP_MEMORY_SCOPE_AGENT)) >= want) break;
                if (__builtin_amdgcn_s_memrealtime() - t0 > 2000000ull) {
                    if (lane == 0) { unsigned expect = 0u; __hip_atomic_compare_exchange_strong(tmo + 1, &expect, code | (unsigned)(u.pm & 0xff), __ATOMIC_RELAXED, __ATOMIC_RELAXED, __HIP_MEMORY_SCOPE_AGENT);
                                     __hip_atomic_store(tmo, 1u, __ATOMIC_RELAXED, __HIP_MEMORY_SCOPE_AGENT); }
                    dead = true; break; }
                __builtin_amdgcn_s_sleep(2);
            }
            __builtin_amdgcn_fence(__ATOMIC_ACQUIRE, "agent");
            if (lane == 0) flag[0] = dead ? 1u : 0u;
        }
        asm volatile("s_waitcnt vmcnt(0) lgkmcnt(0)" ::: "memory"); __builtin_amdgcn_s_barrier(); asm volatile("" ::: "memory");
        const bool bad = flag[0] != 0u;
        if (lane < 32) {
            const unsigned long long* slot = (const unsigned long long*)xbuf + (size_t)(u.pm * BM + row) * 4; float mt[4], m2[4]; float ms = 0.f;
#pragma unroll
            for (int t = 0; t < 4; ++t) { if (t < ntn) { const unsigned long long w = __hip_atomic_load(slot + t, __ATOMIC_RELAXED, __HIP_MEMORY_SCOPE_AGENT); mt[t] = __uint_as_float((unsigned)w); m2[t] = __uint_as_float((unsigned)(w >> 32)); } else { mt[t] = 0.f; m2[t] = 0.f; } ms += mt[t]; }
            const float mean = ms / (float)ntn; float q = 0.f;
#pragma unroll
            for (int t = 0; t < 4; ++t) if (t < ntn) { const float dm = mt[t] - mean; q += m2[t] + 256.0f * dm * dm; }
            S[row] = (f32x2v){mean, 1.0f / sqrtf(q / (256.0f * (float)ntn) + eps)};
        }
        asm volatile("s_waitcnt lgkmcnt(0)" ::: "memory"); __builtin_amdgcn_s_barrier(); asm volatile("" ::: "memory");
        return bad;
    }
};
struct EpiLnRes {
    static constexpr bool PERM = false, AFTER_DRAIN = true;
    const float* base; float* out; int ldc; const float* bias; PanelStats st; unsigned poison;
    __device__ __forceinline__ void refuse(size_t i0, size_t stride, int M, int N) const { const float q = __builtin_nanf(""); for (size_t i = i0; i < (size_t)M * N; i += stride) out[(i / N) * ldc + i % N] = q;
        if (i0 == 0) { unsigned expect = 0u; __hip_atomic_compare_exchange_strong(st.tmo + 1, &expect, 0x7f0u, __ATOMIC_RELAXED, __ATOMIC_RELAXED, __HIP_MEMORY_SCOPE_AGENT); __hip_atomic_store(st.tmo, 1u, __ATOMIC_RELAXED, __HIP_MEMORY_SCOPE_AGENT); } }
    __device__ __forceinline__ void fused(f32x4 (&acc)[2][2][4][2], const Unit& u, int wr, int wc, int fr, int fq, PG8_LAS unsigned char* lds, int wid, int lane) const {
        typedef float f32x2v __attribute__((ext_vector_type(2)));
        const PG8_LAS f32x2v* S = (const PG8_LAS f32x2v*)(lds + 8192);
        const int col0 = u.pn * BM + wc * 32 + 4 * fq;
#pragma unroll
        for (int bj = 0; bj < 2; ++bj)
#pragma unroll
            for (int n = 0; n < 2; ++n) { const f32x4 bv = bias ? *(const f32x4*)(bias + col0 + bj * HALF + n * 16) : (f32x4){0.f, 0.f, 0.f, 0.f};
#pragma unroll
                for (int ai = 0; ai < 2; ++ai)
#pragma unroll
                    for (int m = 0; m < 4; ++m) acc[ai][bj][m][n] += bv; }
        const bool bad = st.run(acc, u, wr, wc, fr, fq, lds, wid, lane) || poison != 0u;
        const float qnan = __builtin_nanf("");
#pragma unroll
        for (int ai = 0; ai < 2; ++ai)
#pragma unroll
            for (int m = 0; m < 4; ++m) { const int r = ai * HALF + wr * 64 + m * 16 + fr; const f32x2v sr = S[r]; const size_t off = (size_t)(u.pm * BM + r) * ldc + col0;
#pragma unroll
                for (int bj = 0; bj < 2; ++bj)
#pragma unroll
                    for (int n = 0; n < 2; ++n) { const f32x4 bs = *(const f32x4*)(base + off + bj * HALF + n * 16); f32x4 o = bs + (acc[ai][bj][m][n] - sr.x) * sr.y;
                        if (bad) o = (f32x4){qnan, qnan, qnan, qnan}; *(f32x4*)(out + off + bj * HALF + n * 16) = o; }
                asm volatile("" ::: "memory"); }
    }
};
struct EpiLnResLn {
    static constexpr bool PERM = false, AFTER_DRAIN = true;
    const float* base; float* out; bf16_t* xn; int ldc; const float* bias; PanelStats st1, st2; unsigned poison;
    __device__ __forceinline__ void refuse(size_t i0, size_t stride, int M, int N) const { const float q = __builtin_nanf(""); for (size_t i = i0; i < (size_t)M * N; i += stride) { const size_t o = (i / N) * ldc + i % N; out[o] = q; xn[o] = (bf16_t)0x7fc0u; }
        if (i0 == 0) { unsigned expect = 0u; __hip_atomic_compare_exchange_strong(st1.tmo + 1, &expect, 0x7f0u, __ATOMIC_RELAXED, __ATOMIC_RELAXED, __HIP_MEMORY_SCOPE_AGENT); __hip_atomic_store(st1.tmo, 1u, __ATOMIC_RELAXED, __HIP_MEMORY_SCOPE_AGENT); } }
    __device__ __forceinline__ void fused(f32x4 (&acc)[2][2][4][2], const Unit& u, int wr, int wc, int fr, int fq, PG8_LAS unsigned char* lds, int wid, int lane) const {
        typedef float f32x2v __attribute__((ext_vector_type(2))); typedef unsigned u32x2v __attribute__((ext_vector_type(2)));
        const PG8_LAS f32x2v* S = (const PG8_LAS f32x2v*)(lds + 8192);
        const int col0 = u.pn * BM + wc * 32 + 4 * fq;
#pragma unroll
        for (int bj = 0; bj < 2; ++bj)
#pragma unroll
            for (int n = 0; n < 2; ++n) { const f32x4 bv = bias ? *(const f32x4*)(bias + col0 + bj * HALF + n * 16) : (f32x4){0.f, 0.f, 0.f, 0.f};
#pragma unroll
                for (int ai = 0; ai < 2; ++ai)
#pragma unroll
                    for (int m = 0; m < 4; ++m) acc[ai][bj][m][n] += bv; }
        bool bad = st1.run(acc, u, wr, wc, fr, fq, lds, wid, lane) || poison != 0u;
        const float qnan = __builtin_nanf("");
#pragma unroll
        for (int ai = 0; ai < 2; ++ai)
#pragma unroll
            for (int m = 0; m < 4; ++m) { const int r = ai * HALF + wr * 64 + m * 16 + fr; const f32x2v sr = S[r]; const size_t off = (size_t)(u.pm * BM + r) * ldc + col0;
#pragma unroll
                for (int bj = 0; bj < 2; ++bj)
#pragma unroll
                    for (int n = 0; n < 2; ++n) { const f32x4 bs = *(const f32x4*)(base + off + bj * HALF + n * 16); acc[ai][bj][m][n] = bs + (acc[ai][bj][m][n] - sr.x) * sr.y; }
                asm volatile("" : "+v"(acc[ai][0][m][0]), "+v"(acc[ai][0][m][1]), "+v"(acc[ai][1][m][0]), "+v"(acc[ai][1][m][1]));
                if (m & 1) asm volatile("" ::: "memory"); }
        const bool bad1 = bad;
        bad = st2.run(acc, u, wr, wc, fr, fq, lds, wid, lane) || bad;
#pragma unroll
        for (int ai = 0; ai < 2; ++ai)
#pragma unroll
            for (int m = 0; m < 4; ++m) { const int r = ai * HALF + wr * 64 + m * 16 + fr; const f32x2v sr = S[r]; const size_t off = (size_t)(u.pm * BM + r) * ldc + col0;
#pragma unroll
                for (int bj = 0; bj < 2; ++bj)
#pragma unroll
                    for (int n = 0; n < 2; ++n) { const f32x4 x1 = acc[ai][bj][m][n]; *(f32x4*)(out + off + bj * HALF + n * 16) = bad1 ? (f32x4){qnan, qnan, qnan, qnan} : x1;
                        const f32x4 o = (x1 - sr.x) * sr.y; u32x2v w; w.x = cvt_pk_bf16(o[0], o[1]); w.y = cvt_pk_bf16(o[2], o[3]);
                        if (bad) { w.x = 0x7fc07fc0u; w.y = 0x7fc07fc0u; } *(u32x2v*)(xn + off + bj * HALF + n * 16) = w; }
                asm volatile("" ::: "memory"); }
    }
};

template <class Epi, class Sched, bool STAMP = false>
__device__ __forceinline__ void gemm_phase(PG8_LAS unsigned char* lds, const Gemm g, const Sched& S, const Epi& E, unsigned long long* stamps) {
    const int tid = threadIdx.x, wid = __builtin_amdgcn_readfirstlane(tid >> 6), lane = tid & 63, wr = wid >> 2, wc = wid & 3, fr = lane & 15, fq = lane >> 4;
    const int K = g.K, nt = K / BK;
    int ts_lo = 0, ts_hi = 0, nts = 0; const unsigned long long rt_entry = STAMP ? (unsigned long long)wall_clock64() : 0ull;
#define PG8_STAMP() do { if (STAMP && wid == 0 && nts < 64) { const unsigned long long _c = (unsigned long long)clock64(); \
        ts_lo = (lane == nts) ? (int)(unsigned)_c : ts_lo; ts_hi = (lane == nts) ? (int)(unsigned)(_c >> 32) : ts_hi; ++nts; } } while (0)
    PG8_STAMP();
    unsigned voffA[2], voffB[2];
#pragma unroll
    for (int i = 0; i < 2; ++i) { int R, C; stage_rc(tid * 16 + i * 8192, R, C); const int Rb = Epi::PERM ? ((R & ~31) + perm32(R & 31)) : R;
        voffA[i] = (unsigned)(R * K + C) * 2u; voffB[i] = (unsigned)(Rb * K + C) * 2u; }
    const size_t kstep = (size_t)(BK * 2);
    const size_t hstep = (size_t)HALF * K * 2;
    const size_t tstep = 2 * hstep;
    const unsigned ldsw = (unsigned)wid * 1024u;
    const int aoff = lds_byte(wr * 64 + fr, fq * 8), boff = lds_byte(wc * 32 + fr, fq * 8);
#define PG8_SA(b, h) (((b) * 2 + (h)) * HTB)
#define PG8_SB(b, h) ((4 + (b) * 2 + (h)) * HTB)
#define PG8_STAGE(bufoff, gbase, voff) do { _Pragma("unroll") for (int _i = 0; _i < 2; ++_i) \
        __builtin_amdgcn_global_load_lds((const unsigned*)((const char*)(gbase) + (voff)[_i]), (PG8_LAS unsigned*)(lds + (bufoff) + ldsw + _i * 8192), 16, 0, 0); } while (0)
#define PG8_LDA(dst, b, h) do { _Pragma("unroll") for (int m = 0; m < 4; ++m) _Pragma("unroll") for (int k = 0; k < 2; ++k) dst[m][k] = *(const PG8_LAS bf16x8*)(lds + PG8_SA(b, h) + aoff + m * 2048 + k * 1024); } while (0)
#define PG8_LDB(dst, b, h) do { _Pragma("unroll") for (int n = 0; n < 2; ++n) _Pragma("unroll") for (int k = 0; k < 2; ++k) dst[n][k] = *(const PG8_LAS bf16x8*)(lds + PG8_SB(b, h) + boff + n * 2048 + k * 1024); } while (0)
#define PG8_MMA(ai, bj, At, Bt) do { __builtin_amdgcn_s_setprio(1); _Pragma("unroll") for (int m = 0; m < 4; ++m) _Pragma("unroll") for (int n = 0; n < 2; ++n) _Pragma("unroll") for (int k = 0; k < 2; ++k) \
        acc[ai][bj][m][n] = __builtin_amdgcn_mfma_f32_16x16x32_bf16(Bt[n][k], At[m][k], acc[ai][bj][m][n], 0, 0, 0); __builtin_amdgcn_s_setprio(0); } while (0)
#define PG8_WAIT_V(n) asm volatile("s_waitcnt vmcnt(" #n ")" ::: "memory")
#define PG8_WAIT_L(n) asm volatile("s_waitcnt lgkmcnt(" #n ")" ::: "memory")
#define PG8_BAR __builtin_amdgcn_s_barrier()
#define PG8_SCHED __builtin_amdgcn_sched_barrier(0)
    Unit cur, nxt; int ui = 0;
    if (!S.next(0, cur)) return;
    f32x4 acc[2][2][4][2];
#pragma unroll
    for (int a = 0; a < 2; ++a)
#pragma unroll
        for (int b = 0; b < 2; ++b)
#pragma unroll
            for (int m = 0; m < 4; ++m)
#pragma unroll
                for (int n = 0; n < 2; ++n) acc[a][b][m][n] = (f32x4){0.f, 0.f, 0.f, 0.f};
    bf16x8 At[4][2], B0[2][2], B1[2][2];
    const char* cA = (const char*)g.A + (size_t)cur.pm * tstep; const char* cB = (const char*)g.Bt + (size_t)cur.pn * tstep;
    S.a_ready(cur);
    PG8_STAGE(PG8_SB(0, 0), cB, voffB); PG8_STAGE(PG8_SA(0, 0), cA, voffA); PG8_STAGE(PG8_SB(0, 1), cB + hstep, voffB); PG8_STAGE(PG8_SA(0, 1), cA + hstep, voffA);
    if (wr == 1) PG8_BAR;
    PG8_WAIT_V(4); PG8_BAR;
    PG8_STAGE(PG8_SB(1, 0), cB + kstep, voffB); PG8_STAGE(PG8_SA(1, 0), cA + kstep, voffA); PG8_STAGE(PG8_SB(1, 1), cB + hstep + kstep, voffB);
    PG8_WAIT_V(6); PG8_BAR;
    PG8_STAMP();
    for (;;) {
        const bool has_next = S.next(ui + 1, nxt);
        const char* nA = has_next ? (const char*)g.A + (size_t)nxt.pm * tstep : cA; const char* nB = has_next ? (const char*)g.Bt + (size_t)nxt.pn * tstep : cB;
        for (int t = 0; t < nt; t += 2) {
            const bool last = (t == nt - 2);
            const char* a1 = cA + (size_t)(t + 1) * kstep;
            const char* a2 = last ? nA : cA + (size_t)(t + 2) * kstep; const char* b2 = last ? nB : cB + (size_t)(t + 2) * kstep;
            const char* a3 = a2 + kstep; const char* b3 = b2 + kstep;
            if (last && has_next) S.a_ready(nxt);
            PG8_LDB(B0, 0, 0); PG8_SCHED; PG8_LDA(At, 0, 0); PG8_STAGE(PG8_SA(1, 1), a1 + hstep, voffA);
            PG8_WAIT_L(8); PG8_BAR; PG8_WAIT_L(0); PG8_MMA(0, 0, At, B0); PG8_BAR; PG8_SCHED;
            PG8_LDB(B1, 0, 1); PG8_STAGE(PG8_SB(0, 0), b2, voffB);
            PG8_BAR; PG8_WAIT_L(0); PG8_MMA(0, 1, At, B1); PG8_BAR;
            PG8_LDA(At, 0, 1); PG8_STAGE(PG8_SA(0, 0), a2, voffA);
            PG8_BAR; PG8_WAIT_L(0); PG8_MMA(1, 0, At, B0); PG8_BAR; PG8_SCHED;
            PG8_STAGE(PG8_SB(0, 1), b2 + hstep, voffB);
            PG8_WAIT_V(6); PG8_BAR; PG8_MMA(1, 1, At, B1); PG8_BAR;
            PG8_LDB(B0, 1, 0); PG8_SCHED; PG8_LDA(At, 1, 0); PG8_STAGE(PG8_SA(0, 1), a2 + hstep, voffA);
            PG8_WAIT_L(8); PG8_BAR; PG8_WAIT_L(0); PG8_MMA(0, 0, At, B0); PG8_BAR; PG8_SCHED;
            PG8_LDB(B1, 1, 1); PG8_STAGE(PG8_SB(1, 0), b3, voffB);
            PG8_BAR; PG8_WAIT_L(0); PG8_MMA(0, 1, At, B1); PG8_BAR;
            PG8_LDA(At, 1, 1); PG8_STAGE(PG8_SA(1, 0), a3, voffA);
            PG8_BAR; PG8_WAIT_L(0); PG8_MMA(1, 0, At, B0); PG8_BAR; PG8_SCHED;
            PG8_STAGE(PG8_SB(1, 1), b3 + hstep, voffB);
            PG8_WAIT_V(6); PG8_BAR; PG8_MMA(1, 1, At, B1); PG8_BAR;
        }
        PG8_STAMP();
        if constexpr (!Epi::AFTER_DRAIN) { E(acc, cur, wr, wc, fr, fq); S.done(cur); }
        PG8_STAMP();
        if (!has_next) break;
#pragma unroll
        for (int a = 0; a < 2; ++a)
#pragma unroll
            for (int b = 0; b < 2; ++b)
#pragma unroll
                for (int m = 0; m < 4; ++m)
#pragma unroll
                    for (int n = 0; n < 2; ++n) acc[a][b][m][n] = (f32x4){0.f, 0.f, 0.f, 0.f};
        cur = nxt; cA = nA; cB = nB; ++ui;
    }
    PG8_WAIT_V(0);
    if (wr == 0) PG8_BAR;
    PG8_BAR;
    if constexpr (Epi::AFTER_DRAIN) { E.fused(acc, cur, wr, wc, fr, fq, lds, wid, lane); S.done(cur); }
    PG8_STAMP();
    if (STAMP && wid == 0) { stamps[lane] = lane < nts ? (((unsigned long long)(unsigned)ts_hi << 32) | (unsigned)ts_lo) : 0ull;
        if (lane == 62) stamps[62] = rt_entry; if (lane == 63) stamps[63] = (unsigned long long)wall_clock64(); }
#undef PG8_STAMP
#undef PG8_SA
#undef PG8_SB
#undef PG8_STAGE
#undef PG8_LDA
#undef PG8_LDB
#undef PG8_MMA
#undef PG8_WAIT_V
#undef PG8_WAIT_L
#undef PG8_BAR
#undef PG8_SCHED
}
}

#define LAS __attribute__((address_space(3)))
typedef unsigned short bf16_t;
typedef short bf16x8 __attribute__((ext_vector_type(8)));
typedef float f32x4 __attribute__((ext_vector_type(4)));
typedef unsigned u32x4 __attribute__((ext_vector_type(4)));
typedef unsigned u32x2 __attribute__((ext_vector_type(2)));
typedef __bf16 bf2_t __attribute__((ext_vector_type(2)));
typedef _Float16 h2_t __attribute__((ext_vector_type(2)));

constexpr int NTOK = 65536, DM = 1024, NTOK_P = 32768;
constexpr int L0 = 8192, L1 = 4096;
constexpr float ALPHA_C = 1.189207115002721f;
constexpr float LN_EPS_C = 1e-5f;
constexpr int NTHREADS = 512;
constexpr int LDS_BYTES = 143360;
constexpr size_t MiB = 1024ull * 1024ull;
constexpr size_t WS_XB = 0;
constexpr size_t WS_PH = 128 * MiB;
constexpr size_t WS_ZT = 320 * MiB;
constexpr size_t WS_UBF = 384 * MiB, WS_VBF = 416 * MiB;
constexpr size_t WS_WINT = 448 * MiB, WS_WOUTT = 454 * MiB, WS_WPT = 456 * MiB;
constexpr size_t WS_FG = 460 * MiB;
constexpr size_t WS_PART = 484 * MiB;
constexpr size_t WS_END = 488 * MiB;
constexpr size_t WS_EIDX = 0, WS_GATE = 32 * MiB;
constexpr size_t OUT_X0T = 192 * MiB;

struct Params { const float* in[24]; float* out; unsigned char* ws; int ph_lo, ph_hi; };

__device__ __forceinline__ unsigned pack2bf(float lo, float hi) { return pg8::cvt_pk_bf16(lo, hi); }
__device__ __forceinline__ float bf_lo(unsigned w) { return __uint_as_float(w << 16); }
__device__ __forceinline__ float bf_hi(unsigned w) { return __uint_as_float(w & 0xffff0000u); }
__device__ __forceinline__ unsigned short f2bf(float f) { return (unsigned short)(pack2bf(f, 0.f) & 0xffffu); }

__device__ __forceinline__ void seq_of(int tok0, int& seq, int& L, int& tl) {
    if (tok0 < NTOK_P) { seq = tok0 >> 13; L = L0; tl = tok0 & (L0 - 1); }
    else { const int r = tok0 - NTOK_P; seq = 4 + (r >> 12); L = L1; tl = r & (L1 - 1); }
}
__device__ __forceinline__ size_t seq_base_T(int seq) { return seq < 4 ? (size_t)seq * 512 * L0 : (size_t)4 * 512 * L0 + (size_t)(seq - 4) * 512 * L1; }

struct EpiP {
    static constexpr bool PERM = true, AFTER_DRAIN = false;
    bf16_t* PA; bf16_t* PH; const float* bias;
    __device__ __forceinline__ void operator()(const f32x4 (&acc)[2][2][4][2], const pg8::Unit& u, int wr, int wc, int fr, int fq) const {
        const int row0 = u.pm * 256 + wr * 64 + fr; int colt = u.pn * 256; bf16_t* base = PA;
        if (colt >= 1536) { base = PH; colt -= 1536; }
        const int col0 = colt + wc * 32 + 8 * fq, bcol0 = u.pn * 256 + wc * 32 + 8 * fq;
        f32x4 bv[2][2];
#pragma unroll
        for (int bj = 0; bj < 2; ++bj)
#pragma unroll
            for (int n = 0; n < 2; ++n) bv[bj][n] = *(const f32x4*)(bias + bcol0 + bj * 128 + 4 * n);
#pragma unroll
        for (int ai = 0; ai < 2; ++ai)
#pragma unroll
            for (int m = 0; m < 4; ++m) { bf16_t* rowp = base + (size_t)(row0 + ai * 128 + m * 16) * 1536 + col0;
#pragma unroll
                for (int bj = 0; bj < 2; ++bj) { const f32x4 v0 = acc[ai][bj][m][0] + bv[bj][0], v1 = acc[ai][bj][m][1] + bv[bj][1];
                    u32x4 w; w.x = pack2bf(v0[0], v0[1]); w.y = pack2bf(v0[2], v0[3]); w.z = pack2bf(v1[0], v1[1]); w.w = pack2bf(v1[2], v1[3]);
                    *(u32x4*)(rowp + bj * 128) = w; } }
    }
};
struct EpiH1 {
    static constexpr bool PERM = false, AFTER_DRAIN = false;
    const float* xp; const float* xs; float* out;
    __device__ __forceinline__ void operator()(const f32x4 (&acc)[2][2][4][2], const pg8::Unit& u, int wr, int wc, int fr, int fq) const {
        const int row0 = u.pm * 256 + wr * 64 + fr, col0 = u.pn * 256 + wc * 32 + 4 * fq;
        const float* xb = (u.pm * 256 < NTOK_P) ? xp : (xs - (size_t)NTOK_P * DM);
#pragma unroll
        for (int ai = 0; ai < 2; ++ai)
#pragma unroll
            for (int m = 0; m < 4; ++m) { const size_t off = (size_t)(row0 + ai * 128 + m * 16) * DM + col0;
#pragma unroll
                for (int bj = 0; bj < 2; ++bj)
#pragma unroll
                    for (int n = 0; n < 2; ++n) { const f32x4 xv = *(const f32x4*)(xb + off + bj * 128 + n * 16);
                        *(f32x4*)(out + off + bj * 128 + n * 16) = xv * ALPHA_C + acc[ai][bj][m][n]; } }
    }
};
struct EpiS {
    static constexpr bool PERM = true, AFTER_DRAIN = false;
    unsigned short* S;
    __device__ __forceinline__ void operator()(const f32x4 (&acc)[2][2][4][2], const pg8::Unit& u, int wr, int wc, int fr, int fq) const {
        const int row0 = u.pm * 256 + wr * 64 + fr, col0 = u.pn * 256 + wc * 32 + 8 * fq;
#pragma unroll
        for (int ai = 0; ai < 2; ++ai)
#pragma unroll
            for (int m = 0; m < 4; ++m) { unsigned short* rowp = S + (size_t)(row0 + ai * 128 + m * 16) * 2048 + col0;
#pragma unroll
                for (int bj = 0; bj < 2; ++bj) { const f32x4 v0 = acc[ai][bj][m][0], v1 = acc[ai][bj][m][1];
                    u32x4 w;
                    w.x = __builtin_bit_cast(unsigned, __builtin_amdgcn_cvt_pkrtz(v0[0], v0[1])); w.y = __builtin_bit_cast(unsigned, __builtin_amdgcn_cvt_pkrtz(v0[2], v0[3]));
                    w.z = __builtin_bit_cast(unsigned, __builtin_amdgcn_cvt_pkrtz(v1[0], v1[1])); w.w = __builtin_bit_cast(unsigned, __builtin_amdgcn_cvt_pkrtz(v1[2], v1[3]));
                    *(u32x4*)(rowp + bj * 128) = w; } }
    }
};

__device__ void cvt_f32_bf16(const float* __restrict__ s, bf16_t* __restrict__ d, size_t n8) {
    for (size_t i = (size_t)blockIdx.x * NTHREADS + threadIdx.x; i < n8; i += (size_t)gridDim.x * NTHREADS) {
        const float4 a = ((const float4*)s)[2 * i], b = ((const float4*)s)[2 * i + 1];
        u32x4 w; w.x = pack2bf(a.x, a.y); w.y = pack2bf(a.z, a.w); w.z = pack2bf(b.x, b.y); w.w = pack2bf(b.z, b.w);
        ((u32x4*)d)[i] = w;
    }
}
__device__ void transpose_cvt(const float* __restrict__ src, int R, int C, bf16_t* __restrict__ dst, float* tile  ) {
    const int tid = threadIdx.x, nct = C / 64, nu = (R / 64) * nct;
    for (int u = blockIdx.x; u < nu; u += gridDim.x) {
        const int r0 = (u / nct) * 64, c0 = (u % nct) * 64;
        { const int r = tid >> 3, c8 = (tid & 7) * 8; const float4 a = *(const float4*)(src + (size_t)(r0 + r) * C + c0 + c8), b = *(const float4*)(src + (size_t)(r0 + r) * C + c0 + c8 + 4);
          float* t = tile + r * 65 + c8; t[0] = a.x; t[1] = a.y; t[2] = a.z; t[3] = a.w; t[4] = b.x; t[5] = b.y; t[6] = b.z; t[7] = b.w; }
        __syncthreads();
        { const int c = tid >> 3, r8 = (tid & 7) * 8; float v[8];
#pragma unroll
          for (int k = 0; k < 8; ++k) v[k] = tile[(r8 + k) * 65 + c];
          u32x4 w; w.x = pack2bf(v[0], v[1]); w.y = pack2bf(v[2], v[3]); w.z = pack2bf(v[4], v[5]); w.w = pack2bf(v[6], v[7]);
          *(u32x4*)(dst + (size_t)(c0 + c) * R + r0 + r8) = w; }
        __syncthreads();
    }
}
__device__ void fold_wq_keys(const float* __restrict__ wq, const float* __restrict__ keys, bf16_t* __restrict__ WpT, float* lds) {
    float* sk = lds; float* sw = lds + 64 * 132;
    const int tid = threadIdx.x;
    for (int u = blockIdx.x; u < 512; u += gridDim.x) {
        const int hp = u >> 5, n0 = ((u >> 4) & 1) * 64, d0 = (u & 15) * 64;
        for (int i = tid; i < 64 * 32; i += NTHREADS) { const int r = i >> 5, k4 = (i & 31) * 4;
            const float4 a = *(const float4*)(keys + ((size_t)hp * 128 + n0 + r) * 128 + k4); float* t = sk + r * 132 + k4; t[0] = a.x; t[1] = a.y; t[2] = a.z; t[3] = a.w;
            const float4 b = *(const float4*)(wq + (size_t)(d0 + r) * 2048 + hp * 128 + k4); float* s = sw + r * 132 + k4; s[0] = b.x; s[1] = b.y; s[2] = b.z; s[3] = b.w; }
        __syncthreads();
        const int ni = tid >> 3, dj = tid & 7; float acc[8];
#pragma unroll
        for (int q = 0; q < 8; ++q) acc[q] = 0.f;
        for (int k = 0; k < 128; ++k) { const float a = sk[ni * 132 + k];
#pragma unroll
            for (int q = 0; q < 8; ++q) acc[q] += a * sw[(dj + 8 * q) * 132 + k]; }
#pragma unroll
        for (int q = 0; q < 8; ++q) WpT[((size_t)hp * 128 + n0 + ni) * 1024 + d0 + dj + 8 * q] = f2bf(acc[q]);
        __syncthreads();
    }
}
__device__ void hyena_filter_gen(const Params& p, float* lds) {
    const float* w1 = p.in[7]; const float* b1 = p.in[8]; const float* fr = p.in[9]; const float* w2 = p.in[10]; const float* b2 = p.in[11]; const float* w3 = p.in[12]; const float* dec = p.in[13];
    bf16_t* Fg = (bf16_t*)(p.ws + WS_FG); float* part = (float*)(p.ws + WS_PART);
    float* sfeat = lds; float* sh1 = lds + 16 * 33; float* sh2 = sh1 + 16 * 64;
    const int tid = threadIdx.x, c = tid;
    float sum0 = 0.f, sum1 = 0.f;
    const float a0 = fabsf(dec[c]), a1 = fabsf(dec[512 + c]);
    for (int it = blockIdx.x; it < 768; it += gridDim.x) {
        const int variant = it >= 512, L = variant ? L1 : L0, n0 = (variant ? it - 512 : it) * 16;
        const float tstep = 1.0f / (float)(L - 1);
        for (int idx = tid; idx < 16 * 33; idx += NTHREADS) { const int pp = idx / 33, f = idx % 33, n = n0 + pp; float val;
            if (f == 0) val = (float)n * tstep;
            else { const int band = (f - 1) & 15; const float fj = 1e-4f + (float)band * ((15.0f - 1e-4f) / 15.0f); const float w = 6.283185307179586f * (float)n / (float)L; const float arg = fj * w;
                   val = (f - 1) >= 16 ? -sinf(arg) : cosf(arg); }
            sfeat[idx] = val; }
        __syncthreads();
        for (int idx = tid; idx < 1024; idx += NTHREADS) { const int pp = idx >> 6, j = idx & 63; float s = b1[j];
            for (int f = 0; f < 33; ++f) s += sfeat[pp * 33 + f] * w1[f * 64 + j];
            sh1[idx] = sinf(fr[j] * s); }
        __syncthreads();
        for (int idx = tid; idx < 1024; idx += NTHREADS) { const int pp = idx >> 6, j = idx & 63; float s = b2[j];
            for (int i = 0; i < 64; ++i) s += sh1[pp * 64 + i] * w2[i * 64 + j];
            sh2[idx] = sinf(fr[j] * s); }
        __syncthreads();
        float acc0[16], acc1[16];
#pragma unroll
        for (int pp = 0; pp < 16; ++pp) { acc0[pp] = 0.f; acc1[pp] = 0.f; }
        for (int j = 0; j < 64; ++j) { const float w30 = w3[j * 1024 + c], w31 = w3[j * 1024 + 512 + c];
#pragma unroll
            for (int pp = 0; pp < 16; ++pp) { const float h = sh2[pp * 64 + j]; acc0[pp] += h * w30; acc1[pp] += h * w31; } }
        bf16_t* Fc = Fg + (variant ? (size_t)512 * 2 * L0 : 0) + (size_t)c * 2 * L;
        float s = 0.f;
#pragma unroll
        for (int pp = 0; pp < 16; ++pp) { const int n = n0 + pp; const float t = (float)n * tstep;
            const float v0 = acc0[pp] * expf(-t * a0), v1 = acc1[pp] * expf(-t * a1);
            s += fabsf(v0); Fc[L - n] = f2bf(v0);
            if (n >= 1) { s += fabsf(v1); Fc[L + n] = f2bf(v1); } else Fc[0] = 0; }
        if (variant) sum1 += s; else sum0 += s;
        __syncthreads();
    }
    part[((size_t)0 * 1024 + blockIdx.x) * 512 + c] = sum0;
    part[((size_t)1 * 1024 + blockIdx.x) * 512 + c] = sum1;
}

__device__ __forceinline__ void unpack8(const u32x4 w, float (&f)[8]) { f[0] = bf_lo(w.x); f[1] = bf_hi(w.x); f[2] = bf_lo(w.y); f[3] = bf_hi(w.y); f[4] = bf_lo(w.z); f[5] = bf_hi(w.z); f[6] = bf_lo(w.w); f[7] = bf_hi(w.w); }
__device__ void phase_conv3(const Params& p, unsigned char* lds) {
    const bf16_t* PA = (const bf16_t*)p.out; const bf16_t* PH = (const bf16_t*)(p.ws + WS_PH);
    bf16_t* Ycat = (bf16_t*)(p.ws + WS_XB); bf16_t* zT = (bf16_t*)(p.ws + WS_ZT); bf16_t* x0T = (bf16_t*)((unsigned char*)p.out + OUT_X0T);
    const float* acw = p.in[4]; const float* hcw = p.in[5]; const float* hcb = p.in[6];
    bf16_t* sx0 = (bf16_t*)lds; bf16_t* sz = sx0 + 64 * 66;
    const int tid = threadIdx.x, r = tid >> 3, cg8 = tid & 7;
    for (int u = blockIdx.x; u < 8192; u += gridDim.x) {
        const int tt = u >> 3, ct = u & 7, tok0 = tt * 64; int seq, L, tl; seq_of(tok0, seq, L, tl);
        const int tok = tok0 + r, pos = tl + r, c0 = ct * 64 + cg8 * 8;
        const bool hp = pos > 0, hn = pos < L - 1;
        const u32x4 zero4 = {0u, 0u, 0u, 0u};
        { const bf16_t* row = PA + (size_t)tok * 1536 + c0;
          float ab[8], gc[8], gp[8], gn[8], t0[8], t1[8];
          unpack8(*(const u32x4*)row, ab);
          unpack8(*(const u32x4*)(row + 512), t0); unpack8(*(const u32x4*)(row + 1024), t1);
#pragma unroll
          for (int k = 0; k < 8; ++k) gc[k] = t0[k] * t1[k];
          unpack8(hp ? *(const u32x4*)(row - 1536 + 512) : zero4, t0); unpack8(hp ? *(const u32x4*)(row - 1536 + 1024) : zero4, t1);
#pragma unroll
          for (int k = 0; k < 8; ++k) gp[k] = t0[k] * t1[k];
          unpack8(hn ? *(const u32x4*)(row + 1536 + 512) : zero4, t0); unpack8(hn ? *(const u32x4*)(row + 1536 + 1024) : zero4, t1);
#pragma unroll
          for (int k = 0; k < 8; ++k) gn[k] = t0[k] * t1[k];
          float y[8];
#pragma unroll
          for (int k = 0; k < 8; ++k) y[k] = ab[k] * (acw[c0 + k] * gp[k] + acw[512 + c0 + k] * gc[k] + acw[1024 + c0 + k] * gn[k]);
          u32x4 w; w.x = pack2bf(y[0], y[1]); w.y = pack2bf(y[2], y[3]); w.z = pack2bf(y[4], y[5]); w.w = pack2bf(y[6], y[7]);
          *(u32x4*)(Ycat + (size_t)tok * DM + c0) = w; }
        { const bf16_t* row = PH + (size_t)tok * 1536 + c0; float hy[3][8];
#pragma unroll
          for (int part = 0; part < 3; ++part) { float vp[8], vc[8], vn[8]; const bf16_t* rp = row + part * 512; const int cc = part * 512 + c0;
              unpack8(*(const u32x4*)rp, vc); unpack8(hp ? *(const u32x4*)(rp - 1536) : zero4, vp); unpack8(hn ? *(const u32x4*)(rp + 1536) : zero4, vn);
#pragma unroll
              for (int k = 0; k < 8; ++k) hy[part][k] = hcw[cc + k] * vp[k] + hcw[1536 + cc + k] * vc[k] + hcw[3072 + cc + k] * vn[k] + hcb[cc + k]; }
#pragma unroll
          for (int k = 0; k < 8; ++k) { sx0[(cg8 * 8 + k) * 66 + r] = f2bf(hy[0][k]); sz[(cg8 * 8 + k) * 66 + r] = f2bf(hy[2][k] * hy[1][k]); } }
        __syncthreads();
        { const int c = tid >> 3, ch = tid & 7; const unsigned* s0 = (const unsigned*)(sx0 + c * 66 + ch * 8); const unsigned* s1 = (const unsigned*)(sz + c * 66 + ch * 8);
          u32x4 w0 = {s0[0], s0[1], s0[2], s0[3]}, w1 = {s1[0], s1[1], s1[2], s1[3]};
          const size_t o = seq_base_T(seq) + (size_t)(ct * 64 + c) * L + tl + ch * 8;
          *(u32x4*)(x0T + o) = w0; *(u32x4*)(zT + o) = w1; }
        __syncthreads();
    }
}

__device__ void phase_longconv(const Params& p, unsigned char* ldsg) {
    LAS unsigned char* lds = (LAS unsigned char*)ldsg;
    const bf16_t* Fg = (const bf16_t*)(p.ws + WS_FG); const float* part = (const float*)(p.ws + WS_PART);
    const bf16_t* zT = (const bf16_t*)(p.ws + WS_ZT); const bf16_t* x0T = (const bf16_t*)((const unsigned char*)p.out + OUT_X0T);
    bf16_t* yhT = (bf16_t*)(p.ws + WS_PH); const float* hyb = p.in[14];
    constexpr int F1OFF = 32768, ZOFF = 65536, SCAL = ZOFF + 73728;
    const int tid = threadIdx.x, wave = __builtin_amdgcn_readfirstlane(tid >> 6), lane = tid & 63, n = lane & 15, kq = lane >> 4;
    for (int u = blockIdx.x; u < 1024; u += gridDim.x) {
        const int variant = u >= 512, c = u & 511, L = variant ? L1 : L0, nb = L >> 6, nseq = variant ? 8 : 4;
        const bf16_t* Fc = Fg + (variant ? (size_t)512 * 2 * L0 : 0) + (size_t)c * 2 * L;
        for (int i = tid; i < (2 * L) / 8; i += NTHREADS) *(LAS u32x4*)(lds + i * 16) = ((const u32x4*)Fc)[i];
        for (int i = tid; i < nseq * (L / 8); i += NTHREADS) { const int b = i / (L / 8), q = i % (L / 8);
            const int seq = variant ? 4 + b : b;
            *(LAS u32x4*)(lds + ZOFF + (b * nb + (q >> 3)) * 144 + (q & 7) * 16) = *(const u32x4*)(zT + seq_base_T(seq) + (size_t)c * L + q * 8); }
        if (wave == 0) { float s = 0.f; for (int b = lane; b < (int)gridDim.x; b += 64) s += part[((size_t)variant * 1024 + b) * 512 + c];
#pragma unroll
            for (int o = 32; o >= 1; o >>= 1) s += __shfl_xor(s, o);
            if (lane == 0) *(LAS float*)(lds + SCAL) = 1.0f / s; }
        __syncthreads();
        for (int i = tid; i < L; i += NTHREADS) { const unsigned a = *(LAS unsigned*)(lds + i * 4); const unsigned b = (i + 1 < L) ? *(LAS unsigned*)(lds + i * 4 + 4) : 0u;
            *(LAS unsigned*)(lds + F1OFF + i * 4) = (a >> 16) | (b << 16); }
        __syncthreads();
        const float inv = *(LAS float*)(lds + SCAL);
        const int b = variant ? wave : (wave >> 1), J0 = variant ? 0 : (wave & 1) * 64;
        f32x4 acc[4][4];
#pragma unroll
        for (int mi = 0; mi < 4; ++mi)
#pragma unroll
            for (int nt = 0; nt < 4; ++nt) acc[mi][nt] = (f32x4){0.f, 0.f, 0.f, 0.f};
        const int cl = ((n & 1) ? F1OFF - 2 : 0) + 2 * (L + 8 * kq - n);
        const int zrow = ZOFF + b * nb * 144 + kq * 16;
        for (int d = J0 - (nb - 1); d <= J0 + 63; ++d) {
            bf16x8 a[6];
            const int abase = cl - 128 * d;
#pragma unroll
            for (int ai = 0; ai < 6; ++ai) { const LAS unsigned* fp = (const LAS unsigned*)(lds + abase - 32 * (ai - 2)); const u32x4 w = {fp[0], fp[1], fp[2], fp[3]}; a[ai] = __builtin_bit_cast(bf16x8, w); }
#pragma unroll
            for (int nt = 0; nt < 4; ++nt) {
                const int lo = J0 + 16 * nt - (nb - 1), hi = J0 + 16 * nt + 15;
                if (d >= lo && d <= hi) {
                    const int blk = J0 + 16 * nt + n - d; const bool valid = (unsigned)blk < (unsigned)nb; const int blkc = valid ? blk : 0;
                    bf16x8 b0 = *(const LAS bf16x8*)(lds + zrow + blkc * 144), b1 = *(const LAS bf16x8*)(lds + zrow + blkc * 144 + 64);
                    if (!valid) { b0 = (bf16x8){0, 0, 0, 0, 0, 0, 0, 0}; b1 = b0; }
#pragma unroll
                    for (int mi = 0; mi < 4; ++mi) { acc[mi][nt] = __builtin_amdgcn_mfma_f32_16x16x32_bf16(a[mi + 2], b0, acc[mi][nt], 0, 0, 0);
                                                      acc[mi][nt] = __builtin_amdgcn_mfma_f32_16x16x32_bf16(a[mi], b1, acc[mi][nt], 0, 0, 0); }
                }
            }
        }
        const float hb = hyb[c]; const int seq = variant ? 4 + b : b; const size_t gbase = seq_base_T(seq) + (size_t)c * L;
#pragma unroll
        for (int nt = 0; nt < 4; ++nt) { const int J = J0 + 16 * nt + n;
#pragma unroll
            for (int mi = 0; mi < 4; ++mi) { const int i0 = 16 * mi + 4 * kq; const size_t o = gbase + (size_t)J * 64 + i0;
                const u32x2 zw = *(const LAS u32x2*)(lds + ZOFF + (b * nb + J) * 144 + i0 * 2); const u32x2 xw = *(const u32x2*)(x0T + o);
                const f32x4 v = acc[mi][nt];
                const float y0 = bf_lo(xw.x) * (v[0] * inv + hb * bf_lo(zw.x)), y1 = bf_hi(xw.x) * (v[1] * inv + hb * bf_hi(zw.x));
                const float y2 = bf_lo(xw.y) * (v[2] * inv + hb * bf_lo(zw.y)), y3 = bf_hi(xw.y) * (v[3] * inv + hb * bf_hi(zw.y));
                u32x2 w; w.x = pack2bf(y0, y1); w.y = pack2bf(y2, y3); *(u32x2*)(yhT + o) = w; } }
        __syncthreads();
    }
}

__device__ void phase_yh_transpose(const Params& p, unsigned char* lds) {
    const bf16_t* yhT = (const bf16_t*)(p.ws + WS_PH); bf16_t* Ycat = (bf16_t*)(p.ws + WS_XB);
    bf16_t* st = (bf16_t*)lds; const int tid = threadIdx.x;
    for (int u = blockIdx.x; u < 8192; u += gridDim.x) {
        const int tt = u >> 3, ct = u & 7, tok0 = tt * 64; int seq, L, tl; seq_of(tok0, seq, L, tl);
        { const int c = tid >> 3, ch = tid & 7; const u32x4 w = *(const u32x4*)(yhT + seq_base_T(seq) + (size_t)(ct * 64 + c) * L + tl + ch * 8);
          unsigned* s = (unsigned*)(st + c * 66 + ch * 8); s[0] = w.x; s[1] = w.y; s[2] = w.z; s[3] = w.w; }
        __syncthreads();
        { const int r = tid >> 3, cg8 = tid & 7; unsigned short v[8];
#pragma unroll
          for (int k = 0; k < 8; ++k) v[k] = st[(cg8 * 8 + k) * 66 + r];
          u32x4 w; w.x = v[0] | ((unsigned)v[1] << 16); w.y = v[2] | ((unsigned)v[3] << 16); w.z = v[4] | ((unsigned)v[5] << 16); w.w = v[6] | ((unsigned)v[7] << 16);
          *(u32x4*)(Ycat + (size_t)(tok0 + r) * DM + 512 + ct * 64 + cg8 * 8) = w; }
        __syncthreads();
    }
}

__device__ void phase_ln1(const Params& p) {
    float* out = p.out; bf16_t* x1b = (bf16_t*)(p.ws + WS_XB); const float* g = p.in[16]; const float* be = p.in[17];
    const int wave = threadIdx.x >> 6, lane = threadIdx.x & 63;
    for (int row = blockIdx.x * 8 + wave; row < NTOK; row += gridDim.x * 8) {
        float4 v[4]; float s = 0.f;
#pragma unroll
        for (int k = 0; k < 4; ++k) { v[k] = ((const float4*)(out + (size_t)row * DM))[lane + 64 * k]; s += (v[k].x + v[k].y) + (v[k].z + v[k].w); }
#pragma unroll
        for (int o = 32; o >= 1; o >>= 1) s += __shfl_xor(s, o);
        const float mu = s * (1.0f / DM); float q = 0.f;
#pragma unroll
        for (int k = 0; k < 4; ++k) { const float a = v[k].x - mu, b = v[k].y - mu, c = v[k].z - mu, d = v[k].w - mu; q += (a * a + b * b) + (c * c + d * d); }
#pragma unroll
        for (int o = 32; o >= 1; o >>= 1) q += __shfl_xor(q, o);
        const float rstd = 1.0f / sqrtf(q * (1.0f / DM) + LN_EPS_C);
#pragma unroll
        for (int k = 0; k < 4; ++k) { const float4 gg = ((const float4*)g)[lane + 64 * k], bb = ((const float4*)be)[lane + 64 * k]; float4 y;
            y.x = (v[k].x - mu) * rstd * gg.x + bb.x; y.y = (v[k].y - mu) * rstd * gg.y + bb.y; y.z = (v[k].z - mu) * rstd * gg.z + bb.z; y.w = (v[k].w - mu) * rstd * gg.w + bb.w;
            ((float4*)(out + (size_t)row * DM))[lane + 64 * k] = y;
            u32x2 w; w.x = pack2bf(y.x, y.y); w.y = pack2bf(y.z, y.w); ((u32x2*)(x1b + (size_t)row * DM))[lane + 64 * k] = w; }
    }
}

__device__ __forceinline__ int f2key(float f) { const int b = __float_as_int(f); return b ^ ((b >> 31) & 0x7fffffff); }
__device__ __forceinline__ float key2f(int k) { return __int_as_float(k ^ ((k >> 31) & 0x7fffffff)); }
__device__ __forceinline__ void sort16_desc(int (&k)[16]) {
#pragma unroll
    for (int sz = 2; sz <= 16; sz <<= 1)
#pragma unroll
        for (int j = sz >> 1; j > 0; j >>= 1)
#pragma unroll
            for (int i = 0; i < 16; ++i) { const int l = i ^ j;
                if (l > i) { const bool desc = ((i & sz) == 0); const int hi = max(k[i], k[l]), lo = min(k[i], k[l]); k[i] = desc ? hi : lo; k[l] = desc ? lo : hi; } }
}
__device__ __forceinline__ void merge_top16(int (&a)[16], const int (&b)[16]) {
#pragma unroll
    for (int i = 0; i < 16; ++i) a[i] = max(a[i], b[15 - i]);
#pragma unroll
    for (int j = 8; j > 0; j >>= 1)
#pragma unroll
        for (int i = 0; i < 16; ++i) { const int l = i ^ j; if (l > i) { const int hi = max(a[i], a[l]), lo = min(a[i], a[l]); a[i] = hi; a[l] = lo; } }
}
__device__ __forceinline__ void chunk_keys(const u32x4 w0, const u32x4 w1, int idx0, int (&k)[16]) {
    const unsigned ww[8] = {w0.x, w0.y, w0.z, w0.w, w1.x, w1.y, w1.z, w1.w};
#pragma unroll
    for (int e = 0; e < 8; ++e) { const h2_t h = __builtin_bit_cast(h2_t, ww[e]);
        k[2 * e] = (f2key((float)h.x) & ~0x7F) | (idx0 + 2 * e); k[2 * e + 1] = (f2key((float)h.y) & ~0x7F) | (idx0 + 2 * e + 1); }
}
__device__ __forceinline__ void row_top16(const unsigned short* __restrict__ row, int (&run)[16]) {
    const u32x4* rp = (const u32x4*)row;
    u32x4 w0 = rp[0], w1 = rp[1];
    chunk_keys(w0, w1, 0, run); sort16_desc(run);
    w0 = rp[2]; w1 = rp[3];
#pragma unroll 1
    for (int ch = 1; ch < 8; ++ch) {
        int k[16]; chunk_keys(w0, w1, ch * 16, k);
        if (ch < 7) { w0 = rp[2 * ch + 2]; w1 = rp[2 * ch + 3]; }
        sort16_desc(k); merge_top16(run, k);
    }
}
__device__ void phase_topk(const Params& p, unsigned char* ldsg) {
    const unsigned short* S = (const unsigned short*)(p.ws + WS_PH);
    int* eidx = (int*)(p.ws + WS_EIDX); float* gate = (float*)(p.ws + WS_GATE);
    int* sl = (int*)ldsg + threadIdx.x * 33;
    constexpr int OFF[16] = {0, 16, 24, 29, 33, 36, 38, 40, 42, 43, 44, 45, 46, 47, 48, 49};
    for (int gt = blockIdx.x * NTHREADS + threadIdx.x; gt < NTOK * 8; gt += gridDim.x * NTHREADS) {
        const int t = gt >> 3, h = gt & 7;
        int a[16], b[16];
        row_top16(S + (size_t)t * 2048 + (h * 2 + 0) * 128, a);
        row_top16(S + (size_t)t * 2048 + (h * 2 + 1) * 128, b);
#pragma unroll
        for (int i = 0; i < 16; ++i) { sl[i] = a[i]; sl[16 + i] = b[i]; }
        float va[16], vb[16];
#pragma unroll
        for (int i = 0; i < 16; ++i) { va[i] = key2f(a[i] & ~0x7F); vb[i] = key2f(b[i] & ~0x7F); }
        int cnd[4][16];
#pragma unroll
        for (int q = 0; q < 4; ++q)
#pragma unroll
            for (int i = 0; i < 16; ++i) cnd[q][i] = (int)0x80000000;
#pragma unroll
        for (int i = 0; i < 16; ++i)
#pragma unroll
            for (int j = 0; j < 16 / (i + 1); ++j) { const int pos = OFF[i] + j; cnd[pos >> 4][pos & 15] = (f2key(va[i] + vb[j]) & ~0xFF) | (i * 16 + j); }
        sort16_desc(cnd[0]); sort16_desc(cnd[1]); sort16_desc(cnd[2]); sort16_desc(cnd[3]);
        merge_top16(cnd[0], cnd[1]); merge_top16(cnd[2], cnd[3]); merge_top16(cnd[0], cnd[2]);
        float best[16]; int ei[16]; float m = -3.0e38f;
#pragma unroll
        for (int r = 0; r < 16; ++r) { const int code = cnd[0][r] & 0xFF; const int ka = sl[code >> 4], kb = sl[16 + (code & 15)];
            ei[r] = (ka & 0x7F) * 128 + (kb & 0x7F); best[r] = key2f(ka & ~0x7F) + key2f(kb & ~0x7F); m = fmaxf(m, best[r]); }
        float se = 0.f;
#pragma unroll
        for (int r = 0; r < 16; ++r) { best[r] = __expf(best[r] - m); se += best[r]; }
        const float inv = 1.0f / se;
#pragma unroll
        for (int q = 0; q < 4; ++q) { ((int4*)(eidx + (size_t)gt * 16))[q] = make_int4(ei[4 * q], ei[4 * q + 1], ei[4 * q + 2], ei[4 * q + 3]);
            ((float4*)(gate + (size_t)gt * 16))[q] = make_float4(best[4 * q] * inv, best[4 * q + 1] * inv, best[4 * q + 2] * inv, best[4 * q + 3] * inv); }
    }
}

__device__ __forceinline__ float dot2bf(unsigned a, unsigned b, float c) { return __builtin_amdgcn_fdot2_f32_bf16(__builtin_bit_cast(bf2_t, a), __builtin_bit_cast(bf2_t, b), c, false); }
__device__ __forceinline__ void load_row8(u32x4 (&r)[8], const bf16_t* __restrict__ tab, int e, int j) {
    const u32x4* rp = (const u32x4*)(tab + (size_t)e * DM) + j;
#pragma unroll
    for (int m = 0; m < 8; ++m) r[m] = rp[16 * m];
}
__device__ void phase_peer(const Params& p, unsigned char* ldsg) {
    float* out = p.out; const bf16_t* ubf = (const bf16_t*)(p.ws + WS_UBF); const bf16_t* vbf = (const bf16_t*)(p.ws + WS_VBF);
    const int* eidx = (const int*)(p.ws + WS_EIDX); const float* gate = (const float*)(p.ws + WS_GATE);
    const float* g2 = p.in[22]; const float* b2 = p.in[23];
    const int wave = threadIdx.x >> 6, lane = threadIdx.x & 63, g = lane >> 4, j = lane & 15;
    int* sE = (int*)(ldsg + wave * 2048); float* sG = (float*)(ldsg + wave * 2048 + 512); float* sC = (float*)(ldsg + wave * 2048 + 1024);
    for (int tok = blockIdx.x * 8 + wave; tok < NTOK; tok += gridDim.x * 8) {
        sE[lane] = eidx[(size_t)tok * 128 + lane]; sE[64 + lane] = eidx[(size_t)tok * 128 + 64 + lane];
        sG[lane] = gate[(size_t)tok * 128 + lane]; sG[64 + lane] = gate[(size_t)tok * 128 + 64 + lane];
        const float* xr = out + (size_t)tok * DM;
        u32x4 xp[8];
#pragma unroll
        for (int m = 0; m < 8; ++m) { const float4 a = *(const float4*)(xr + 128 * m + 8 * j), b = *(const float4*)(xr + 128 * m + 8 * j + 4);
            xp[m].x = pack2bf(a.x, a.y); xp[m].y = pack2bf(a.z, a.w); xp[m].z = pack2bf(b.x, b.y); xp[m].w = pack2bf(b.z, b.w); }
        u32x4 ra[8], rb[8];
        load_row8(ra, ubf, sE[g], j);
#pragma unroll 1
        for (int s = 0; s < 32; s += 2) {
            load_row8(rb, ubf, sE[4 * (s + 1) + g], j);
            { float d = 0.f;
#pragma unroll
              for (int m = 0; m < 8; ++m) { d = dot2bf(ra[m].x, xp[m].x, d); d = dot2bf(ra[m].y, xp[m].y, d);
                  d = dot2bf(ra[m].z, xp[m].z, d); d = dot2bf(ra[m].w, xp[m].w, d); }
              d += __shfl_xor(d, 1); d += __shfl_xor(d, 2); d += __shfl_xor(d, 4); d += __shfl_xor(d, 8);
              const float act = 0.5f * d * (1.0f + erff(d * 0.70710678118654752f));
              if (j == 0) sC[4 * s + g] = sG[4 * s + g] * act; }
            if (s + 2 < 32) load_row8(ra, ubf, sE[4 * (s + 2) + g], j);
            { float d = 0.f;
#pragma unroll
              for (int m = 0; m < 8; ++m) { d = dot2bf(rb[m].x, xp[m].x, d); d = dot2bf(rb[m].y, xp[m].y, d);
                  d = dot2bf(rb[m].z, xp[m].z, d); d = dot2bf(rb[m].w, xp[m].w, d); }
              d += __shfl_xor(d, 1); d += __shfl_xor(d, 2); d += __shfl_xor(d, 4); d += __shfl_xor(d, 8);
              const float act = 0.5f * d * (1.0f + erff(d * 0.70710678118654752f));
              if (j == 0) sC[4 * (s + 1) + g] = sG[4 * (s + 1) + g] * act; }
        }
        float o[8][8];
#pragma unroll
        for (int m = 0; m < 8; ++m)
#pragma unroll
            for (int k = 0; k < 8; ++k) o[m][k] = 0.f;
        load_row8(ra, vbf, sE[g], j);
#pragma unroll 1
        for (int s = 0; s < 32; s += 2) {
            load_row8(rb, vbf, sE[4 * (s + 1) + g], j);
            { const float cf = sC[4 * s + g];
#pragma unroll
              for (int m = 0; m < 8; ++m) { o[m][0] += cf * bf_lo(ra[m].x); o[m][1] += cf * bf_hi(ra[m].x); o[m][2] += cf * bf_lo(ra[m].y); o[m][3] += cf * bf_hi(ra[m].y);
                  o[m][4] += cf * bf_lo(ra[m].z); o[m][5] += cf * bf_hi(ra[m].z); o[m][6] += cf * bf_lo(ra[m].w); o[m][7] += cf * bf_hi(ra[m].w); } }
            if (s + 2 < 32) load_row8(ra, vbf, sE[4 * (s + 2) + g], j);
            { const float cf = sC[4 * (s + 1) + g];
#pragma unroll
              for (int m = 0; m < 8; ++m) { o[m][0] += cf * bf_lo(rb[m].x); o[m][1] += cf * bf_hi(rb[m].x); o[m][2] += cf * bf_lo(rb[m].y); o[m][3] += cf * bf_hi(rb[m].y);
                  o[m][4] += cf * bf_lo(rb[m].z); o[m][5] += cf * bf_hi(rb[m].z); o[m][6] += cf * bf_lo(rb[m].w); o[m][7] += cf * bf_hi(rb[m].w); } }
        }
        float r1[4][8];
        const bool up = g >= 2;
#pragma unroll
        for (int m = 0; m < 4; ++m)
#pragma unroll
            for (int k = 0; k < 8; ++k) { const float send = up ? o[m][k] : o[m + 4][k]; const float keep = up ? o[m + 4][k] : o[m][k]; r1[m][k] = keep + __shfl_xor(send, 32); }
        float r2[2][8];
        const bool odd = (g & 1) != 0;
#pragma unroll
        for (int m = 0; m < 2; ++m)
#pragma unroll
            for (int k = 0; k < 8; ++k) { const float send = odd ? r1[m][k] : r1[m + 2][k]; const float keep = odd ? r1[m + 2][k] : r1[m][k]; r2[m][k] = keep + __shfl_xor(send, 16); }
        float hv[2][8]; float s = 0.f;
#pragma unroll
        for (int m = 0; m < 2; ++m) { const int col = 128 * (2 * g + m) + 8 * j; const float4 a = *(const float4*)(xr + col), b = *(const float4*)(xr + col + 4);

#ifdef PROBE_NOPEER
            for (int k = 0; k < 8; ++k) r2[m][k] = 0.f;
#endif
            hv[m][0] = ALPHA_C * a.x + r2[m][0]; hv[m][1] = ALPHA_C * a.y + r2[m][1]; hv[m][2] = ALPHA_C * a.z + r2[m][2]; hv[m][3] = ALPHA_C * a.w + r2[m][3];
            hv[m][4] = ALPHA_C * b.x + r2[m][4]; hv[m][5] = ALPHA_C * b.y + r2[m][5]; hv[m][6] = ALPHA_C * b.z + r2[m][6]; hv[m][7] = ALPHA_C * b.w + r2[m][7];
#pragma unroll
            for (int k = 0; k < 8; ++k) s += hv[m][k]; }
#pragma unroll
        for (int of = 32; of >= 1; of >>= 1) s += __shfl_xor(s, of);
        const float mu = s * (1.0f / DM); float q = 0.f;
#pragma unroll
        for (int m = 0; m < 2; ++m)
#pragma unroll
            for (int k = 0; k < 8; ++k) { const float dd = hv[m][k] - mu; q += dd * dd; }
#pragma unroll
        for (int of = 32; of >= 1; of >>= 1) q += __shfl_xor(q, of);
        const float rstd = 1.0f / sqrtf(q * (1.0f / DM) + LN_EPS_C);
#pragma unroll
        for (int m = 0; m < 2; ++m) { const int col = 128 * (2 * g + m) + 8 * j;
            const float4 ga = *(const float4*)(g2 + col), gb = *(const float4*)(g2 + col + 4), ba = *(const float4*)(b2 + col), bb = *(const float4*)(b2 + col + 4);
            float4 y0, y1;
            y0.x = (hv[m][0] - mu) * rstd * ga.x + ba.x; y0.y = (hv[m][1] - mu) * rstd * ga.y + ba.y; y0.z = (hv[m][2] - mu) * rstd * ga.z + ba.z; y0.w = (hv[m][3] - mu) * rstd * ga.w + ba.w;
            y1.x = (hv[m][4] - mu) * rstd * gb.x + bb.x; y1.y = (hv[m][5] - mu) * rstd * gb.y + bb.y; y1.z = (hv[m][6] - mu) * rstd * gb.z + bb.z; y1.w = (hv[m][7] - mu) * rstd * gb.w + bb.w;
            *(float4*)(out + (size_t)tok * DM + col) = y0; *(float4*)(out + (size_t)tok * DM + col + 4) = y1; }
    }
}

__global__ void __launch_bounds__(NTHREADS) hybrid_fwd(Params p) {
    extern __shared__ __attribute__((aligned(16))) unsigned char lds[];
    cg::grid_group grid = cg::this_grid();
    const int lo = p.ph_lo, hi = p.ph_hi;
#define IN(k) (lo <= (k) && (k) < hi)
#define SEAM(k) do { if (IN(k) && IN((k) + 1)) grid.sync(); } while (0)
    unsigned char* ws = p.ws;
    if (IN(0)) {
        cvt_f32_bf16(p.in[0], (bf16_t*)(ws + WS_XB), (size_t)NTOK_P * DM / 8);
        cvt_f32_bf16(p.in[1], (bf16_t*)(ws + WS_XB) + (size_t)NTOK_P * DM, (size_t)NTOK_P * DM / 8);
        cvt_f32_bf16(p.in[20], (bf16_t*)(ws + WS_UBF), (size_t)16384 * DM / 8);
        cvt_f32_bf16(p.in[21], (bf16_t*)(ws + WS_VBF), (size_t)16384 * DM / 8);
        transpose_cvt(p.in[2], 1024, 3072, (bf16_t*)(ws + WS_WINT), (float*)lds);
        transpose_cvt(p.in[15], 1024, 1024, (bf16_t*)(ws + WS_WOUTT), (float*)lds);
        fold_wq_keys(p.in[18], p.in[19], (bf16_t*)(ws + WS_WPT), (float*)lds);
        hyena_filter_gen(p, (float*)lds);
    }
    SEAM(0);
    if (IN(1)) {
        pg8::Gemm g{(const bf16_t*)(ws + WS_XB), (const bf16_t*)(ws + WS_WINT), NTOK, 3072, DM}; pg8::StaticOrder S; S.init(NTOK, 3072, gridDim.x, blockIdx.x);
        EpiP E{(bf16_t*)p.out, (bf16_t*)(ws + WS_PH), p.in[3]};
        pg8::gemm_phase<EpiP, pg8::StaticOrder, false>((LAS unsigned char*)lds, g, S, E, nullptr);
    }
    SEAM(1);
    if (IN(2)) phase_conv3(p, lds);
    SEAM(2);
    if (IN(3)) phase_longconv(p, lds);
    SEAM(3);
    if (IN(4)) phase_yh_transpose(p, lds);
    SEAM(4);
    if (IN(5)) {
        pg8::Gemm g{(const bf16_t*)(ws + WS_XB), (const bf16_t*)(ws + WS_WOUTT), NTOK, DM, DM}; pg8::StaticOrder S; S.init(NTOK, DM, gridDim.x, blockIdx.x);
        EpiH1 E{p.in[0], p.in[1], p.out};
        pg8::gemm_phase<EpiH1, pg8::StaticOrder, false>((LAS unsigned char*)lds, g, S, E, nullptr);
    }
    SEAM(5);
    if (IN(6)) phase_ln1(p);
    SEAM(6);
    if (IN(7)) {
        pg8::Gemm g{(const bf16_t*)(ws + WS_XB), (const bf16_t*)(ws + WS_WPT), NTOK, 2048, DM}; pg8::StaticOrder S; S.init(NTOK, 2048, gridDim.x, blockIdx.x);
        EpiS E{(unsigned short*)(ws + WS_PH)};
        pg8::gemm_phase<EpiS, pg8::StaticOrder, false>((LAS unsigned char*)lds, g, S, E, nullptr);
    }
    SEAM(7);
    if (IN(8)) phase_topk(p, lds);
    SEAM(8);
    if (IN(9)) phase_peer(p, lds);
#undef IN
#undef SEAM
}

extern "C" void kernel_launch(void* const* d_in, const int* in_sizes, int n_in, void* d_out, int out_size, void* d_ws, size_t ws_size, hipStream_t stream) {
    static int grid = 0;
    if (grid == 0) {
        if (n_in != 24 || out_size != NTOK * DM || ws_size < WS_END) { fprintf(stderr, "kernel_launch: unexpected shapes (n_in %d out %d ws %zu)\n", n_in, out_size, ws_size); grid = -1; return; }
        int dev = 0, cus = 0, per_cu = 0;
        hipGetDevice(&dev); hipDeviceGetAttribute(&cus, hipDeviceAttributeMultiprocessorCount, dev);
        if (hipFuncSetAttribute((const void*)hybrid_fwd, hipFuncAttributeMaxDynamicSharedMemorySize, LDS_BYTES) != hipSuccess) { fprintf(stderr, "kernel_launch: hipFuncSetAttribute failed\n"); grid = -1; return; }
        if (hipOccupancyMaxActiveBlocksPerMultiprocessor(&per_cu, (const void*)hybrid_fwd, NTHREADS, LDS_BYTES) != hipSuccess || per_cu < 1) { fprintf(stderr, "kernel_launch: occupancy query says %d\n", per_cu); per_cu = 1; }
        (void)hipGetLastError();
        grid = cus * per_cu; if (grid > 1024) grid = 1024;
    }
    if (grid < 0) return;
    Params p{};
    for (int i = 0; i < 24; ++i) p.in[i] = (const float*)d_in[i];
    p.out = (float*)d_out; p.ws = (unsigned char*)d_ws;
#if ONE_LAUNCH
    p.ph_lo = 0; p.ph_hi = 10;
    void* args[] = {&p};
    hipError_t e = hipLaunchCooperativeKernel((const void*)hybrid_fwd, dim3(grid), dim3(NTHREADS), args, LDS_BYTES, stream);
    if (e != hipSuccess) fprintf(stderr, "cooperative launch failed: %s (grid %d)\n", hipGetErrorString(e), grid);
#else
    for (int ph = 0; ph < 10; ++ph) { p.ph_lo = ph; p.ph_hi = ph + 1; hipLaunchKernelGGL(hybrid_fwd, dim3(grid), dim3(NTHREADS), LDS_BYTES, stream, p); }
#endif
}
```

```cpp
#include <hip/hip_runtime.h>
#include <hip/hip_cooperative_groups.h>
#include <cstdio>
namespace cg = cooperative_groups;
#ifndef ONE_LAUNCH
#define ONE_LAUNCH 1
#endif
#ifdef PROBE_A
#define PROBE_NOPEER 1
#endif
namespace pg8 {
#define PG8_LAS __attribute__((address_space(3)))
typedef unsigned short bf16_t;
typedef short bf16x8 __attribute__((ext_vector_type(8)));
typedef float f32x4 __attribute__((ext_vector_type(4)));
typedef unsigned u32x4 __attribute__((ext_vector_type(4)));
constexpr int BM = 256, BK = 64, HALF = 128, HTB = HALF * BK * 2  , STAGE_BYTES = 8 * HTB, NXCD = 8, WGM = 8;

__host__ __device__ __forceinline__ int lds_byte(int r, int c) { const int st = (r >> 4) * 2 + (c >> 5), rr = r & 15, cc = c & 31, ob = rr * 64 + cc * 2; return st * 1024 + (ob ^ (((ob >> 9) & 1) << 5)); }
__host__ __device__ __forceinline__ void stage_rc(int b, int& R, int& C) { const int st = b / 1024, sb = b % 1024, swz = sb ^ (((sb >> 9) & 1) << 5); R = (st >> 1) * 16 + swz / 64; C = (st & 1) * 32 + (swz % 64) / 2; }
__host__ __device__ __forceinline__ int perm32(int rho) { const int n = rho >> 4, i = rho & 15; return 8 * (i >> 2) + 4 * n + (i & 3); }

struct Unit { int pm, pn; };
struct Gemm { const bf16_t* A; const bf16_t* Bt; int M, N, K; };

struct StaticOrder {
    int nM, nN, nwg, G, c;
    __host__ __device__ void init(int M, int N, int G_, int c_) { nM = M / BM; nN = N / BM; nwg = nM * nN; G = G_; c = c_; }
    __host__ __device__ bool next(int i, Unit& u) const {
        const long L = (long)i * G + c; if (L >= nwg) return false;
        int wgid = (int)L; { const int q = nwg / NXCD, r = nwg % NXCD, xcd = wgid % NXCD, off = wgid / NXCD; wgid = (xcd < r ? xcd * (q + 1) : r * (q + 1) + (xcd - r) * q) + off; }
        const int nig = WGM * nN, gid = wgid / nig, fm = gid * WGM, gsz = (nM - fm) < WGM ? (nM - fm) : WGM;
        u.pm = fm + ((wgid % nig) % gsz); u.pn = (wgid % nig) / gsz; return true;
    }
    __device__ __forceinline__ void a_ready(const Unit&) const {}
    __device__ __forceinline__ void done(const Unit&) const {}
};
struct CountedOrder : StaticOrder {
    const unsigned* ready; unsigned need; unsigned* tmo;
    __device__ __forceinline__ void a_ready(const Unit& u) const {
        if (threadIdx.x < 64) {
            const unsigned long long t0 = __builtin_amdgcn_s_memrealtime(); unsigned polls = 0;
            while ((unsigned)__builtin_amdgcn_readfirstlane(__hip_atomic_load(ready + 64 * u.pm, __ATOMIC_RELAXED, __HIP_MEMORY_SCOPE_AGENT)) < need) {
                if ((++polls & 255u) == 0u && __builtin_amdgcn_readfirstlane(__hip_atomic_load(tmo, __ATOMIC_RELAXED, __HIP_MEMORY_SCOPE_AGENT)) != 0u) break;
                if (__builtin_amdgcn_s_memrealtime() - t0 > 2000000ull) {
                    if (threadIdx.x == 0) { unsigned expect = 0u; __hip_atomic_compare_exchange_strong(tmo + 1, &expect, 0x600u | (unsigned)(u.pm & 0xff), __ATOMIC_RELAXED, __ATOMIC_RELAXED, __HIP_MEMORY_SCOPE_AGENT); __hip_atomic_store(tmo, 1u, __ATOMIC_RELAXED, __HIP_MEMORY_SCOPE_AGENT); }
                    break; }
                __builtin_amdgcn_s_sleep(2); }
            __builtin_amdgcn_fence(__ATOMIC_ACQUIRE, "agent");
            asm volatile("s_waitcnt vmcnt(0)" ::: "memory");
        }
#if !defined(BROKEN_HOOK_NO_BARRIER)
        asm volatile("" ::: "memory"); __builtin_amdgcn_s_barrier(); asm volatile("" ::: "memory");
#endif
    }
};

__device__ __forceinline__ unsigned cvt_pk_bf16(float lo, float hi) { unsigned r; asm volatile("v_cvt_pk_bf16_f32 %0, %1, %2" : "=v"(r) : "v"(lo), "v"(hi)); return r; }
typedef float f32x2 __attribute__((ext_vector_type(2)));
__device__ __forceinline__ f32x2 gelu_pk(f32x2 v) {
    const f32x2 av = __builtin_elementwise_abs(v), d = av * 0.2316418882f + 1.0f;
    f32x2 t; t.x = __builtin_amdgcn_rcpf(d.x); t.y = __builtin_amdgcn_rcpf(d.y);
    f32x2 q = t * 0.5307027145f + (-0.7265760135f); q = q * t + 0.7107068705f; q = q * t + (-0.142248368f); q = q * t + 0.127414796f; q = q * t;
    const f32x2 s = (v * v) * (-0.72134752044f);
    f32x2 e; e.x = __builtin_amdgcn_exp2f(s.x); e.y = __builtin_amdgcn_exp2f(s.y);
    const f32x2 m = v * (q * e), r = v - m;
    f32x2 o; o.x = v.x < 0.f ? m.x : r.x; o.y = v.y < 0.f ? m.y : r.y; return o;
}

struct EpiF32 {
    static constexpr bool PERM = false, AFTER_DRAIN = false;
    float* C; int ldc; const float* bias;
    __device__ __forceinline__ void operator()(const f32x4 (&acc)[2][2][4][2], const Unit& u, int wr, int wc, int fr, int fq) const {
        const int row0 = u.pm * BM + wr * 64 + fr, col0 = u.pn * BM + wc * 32 + 4 * fq;
        f32x4 bv[2][2];
#pragma unroll
        for (int bj = 0; bj < 2; ++bj)
#pragma unroll
            for (int n = 0; n < 2; ++n) bv[bj][n] = bias ? *(const f32x4*)(bias + col0 + bj * HALF + n * 16) : (f32x4){0.f, 0.f, 0.f, 0.f};
#pragma unroll
        for (int ai = 0; ai < 2; ++ai)
#pragma unroll
            for (int m = 0; m < 4; ++m) { float* rowp = C + (size_t)(row0 + ai * HALF + m * 16) * ldc + col0;
#pragma unroll
                for (int bj = 0; bj < 2; ++bj)
#pragma unroll
                    for (int n = 0; n < 2; ++n) *(f32x4*)(rowp + bj * HALF + n * 16) = acc[ai][bj][m][n] + bv[bj][n]; }
    }
};
template <int ACT  > struct EpiBf16 {
    static constexpr bool PERM = true, AFTER_DRAIN = false;
    bf16_t* O; int ldc; const float* bias; int split_cols; size_t split_stride;
    __device__ __forceinline__ void operator()(const f32x4 (&acc)[2][2][4][2], const Unit& u, int wr, int wc, int fr, int fq) const {
        const int row0 = u.pm * BM + wr * 64 + fr; int colt = u.pn * BM; bf16_t* base = O;
        if (split_cols) { const int t = colt / split_cols; base += (size_t)t * split_stride; colt -= t * split_cols; }
        const int col0 = colt + wc * 32 + 8 * fq, bcol0 = u.pn * BM + wc * 32 + 8 * fq;
        f32x4 bv[2][2];
#pragma unroll
        for (int bj = 0; bj < 2; ++bj)
#pragma unroll
            for (int n = 0; n < 2; ++n) bv[bj][n] = bias ? *(const f32x4*)(bias + bcol0 + bj * HALF + 4 * n) : (f32x4){0.f, 0.f, 0.f, 0.f};
#pragma unroll
        for (int ai = 0; ai < 2; ++ai)
#pragma unroll
            for (int m = 0; m < 4; ++m) { bf16_t* rowp = base + (size_t)(row0 + ai * HALF + m * 16) * ldc + col0;
#pragma unroll
                for (int bj = 0; bj < 2; ++bj) { f32x4 v0 = acc[ai][bj][m][0] + bv[bj][0], v1 = acc[ai][bj][m][1] + bv[bj][1];
                    if (ACT == 1) { f32x2 a = gelu_pk((f32x2){v0[0], v0[1]}), b = gelu_pk((f32x2){v0[2], v0[3]}), c = gelu_pk((f32x2){v1[0], v1[1]}), d = gelu_pk((f32x2){v1[2], v1[3]});
                        v0 = (f32x4){a.x, a.y, b.x, b.y}; v1 = (f32x4){c.x, c.y, d.x, d.y}; }
                    if (ACT == 2) {
#pragma unroll
                        for (int j = 0; j < 4; ++j) { v0[j] = 0.5f * v0[j] * (1.0f + erff(v0[j] * 0.70710678f)); v1[j] = 0.5f * v1[j] * (1.0f + erff(v1[j] * 0.70710678f)); } }
                    u32x4 w; w.x = cvt_pk_bf16(v0[0], v0[1]); w.y = cvt_pk_bf16(v0[2], v0[3]); w.z = cvt_pk_bf16(v1[0], v1[1]); w.w = cvt_pk_bf16(v1[2], v1[3]);
                    *(u32x4*)(rowp + bj * HALF) = w; } }
    }
};

struct PanelStats {
    unsigned* xbuf;
    unsigned* cnt;
    unsigned* tmo;
    int ntn; float eps;
    unsigned code;
    __device__ __forceinline__ bool run(const f32x4 (&v)[2][2][4][2], const Unit& u, int wr, int wc, int fr, int fq, PG8_LAS unsigned char* lds, int wid, int lane) const {
        typedef float f32x2v __attribute__((ext_vector_type(2)));
        PG8_LAS f32x2v* P = (PG8_LAS f32x2v*)lds;
        PG8_LAS f32x2v* S = (PG8_LAS f32x2v*)(lds + 8192);
        PG8_LAS unsigned* flag = (PG8_LAS unsigned*)(lds + 8192 + 2048);
#pragma unroll
        for (int ai = 0; ai < 2; ++ai)
#pragma unroll
            for (int m = 0; m < 4; ++m) {
                float s = 0.f;
#pragma unroll
                for (int bj = 0; bj < 2; ++bj)
#pragma unroll
                    for (int n = 0; n < 2; ++n) { const f32x4 x = v[ai][bj][m][n]; s += (x[0] + x[1]) + (x[2] + x[3]); }
                s += __shfl_xor(s, 16); s += __shfl_xor(s, 32);
                const float mw = s * (1.0f / 64.0f); float q = 0.f;
#pragma unroll
                for (int bj = 0; bj < 2; ++bj)
#pragma unroll
                    for (int n = 0; n < 2; ++n) { const f32x4 d = v[ai][bj][m][n] - mw; q += (d[0] * d[0] + d[1] * d[1]) + (d[2] * d[2] + d[3] * d[3]); }
                q += __shfl_xor(q, 16); q += __shfl_xor(q, 32);
                if (fq == 0) P[(ai * HALF + wr * 64 + m * 16 + fr) * 4 + wc] = (f32x2v){mw, q};
            }
        asm volatile("s_waitcnt lgkmcnt(0)" ::: "memory"); __builtin_amdgcn_s_barrier(); asm volatile("" ::: "memory");
#if defined(BROKEN_NO_WAIT)
        if (blockIdx.x >= 64) { const long long t0 = clock64(); while (clock64() - t0 < 60000) __builtin_amdgcn_s_sleep(8); }
#endif
        const int row = wid * 32 + (lane & 31);
        if (lane < 32) {
            const f32x2v a = P[row * 4 + 0], b = P[row * 4 + 1], c = P[row * 4 + 2], d = P[row * 4 + 3];
            const float mt = (a.x + b.x + c.x + d.x) * 0.25f;
            const float da = a.x - mt, db = b.x - mt, dc = c.x - mt, dd = d.x - mt;
            const float m2 = (a.y + b.y) + (c.y + d.y) + 64.0f * ((da * da + db * db) + (dc * dc + dd * dd));
            unsigned long long* slot = (unsigned long long*)xbuf + ((size_t)(u.pm * BM + row) * 4 + u.pn);
            __hip_atomic_store(slot, ((unsigned long long)__float_as_uint(m2) << 32) | __float_as_uint(mt), __ATOMIC_RELAXED, __HIP_MEMORY_SCOPE_AGENT);
        }
        asm volatile("s_waitcnt vmcnt(0)" ::: "memory");
        if (lane == 0) __hip_atomic_fetch_add(cnt + 64 * u.pm, 1u, __ATOMIC_RELAXED, __HIP_MEMORY_SCOPE_AGENT);
        if (wid == 0) {
            bool dead = false; const unsigned long long t0 = __builtin_amdgcn_s_memrealtime(); const unsigned want = 8u * (unsigned)ntn;
            for (;;) {
#if defined(BROKEN_NO_WAIT)
                break;
#endif
                if ((unsigned)__builtin_amdgcn_readfirstlane(__hip_atomic_load(cnt + 64 * u.pm, __ATOMIC_RELAXED, __HIP_MEMORY_SCOPE_AGENT)) >= want) break;
                if (__builtin_amdgcn_s_memrealtime() - t0 > 2000000ull) {
                    if (lane == 0) { unsigned expect = 0u; __hip_atomic_compare_exchange_strong(tmo + 1, &expect, code | (unsigned)(u.pm & 0xff), __ATOMIC_RELAXED, __ATOMIC_RELAXED, __HIP_MEMORY_SCOPE_AGENT);
                                     __hip_atomic_store(tmo, 1u, __ATOMIC_RELAXED, __HIP_MEMORY_SCOPE_AGENT); }
                    dead = true; break; }
                __builtin_amdgcn_s_sleep(2);
            }
            __builtin_amdgcn_fence(__ATOMIC_ACQUIRE, "agent");
            if (lane == 0) flag[0] = dead ? 1u : 0u;
        }
        asm volatile("s_waitcnt vmcnt(0) lgkmcnt(0)" ::: "memory"); __builtin_amdgcn_s_barrier(); asm volatile("" ::: "memory");
        const bool bad = flag[0] != 0u;
        if (lane < 32) {
            const unsigned long long* slot = (const unsigned long long*)xbuf + (size_t)(u.pm * BM + row) * 4; float mt[4], m2[4]; float ms = 0.f;
#pragma unroll
            for (int t = 0; t < 4; ++t) { if (t < ntn) { const unsigned long long w = __hip_atomic_load(slot + t, __ATOMIC_RELAXED, __HIP_MEMORY_SCOPE_AGENT); mt[t] = __uint_as_float((unsigned)w); m2[t] = __uint_as_float((unsigned)(w >> 32)); } else { mt[t] = 0.f; m2[t] = 0.f; } ms += mt[t]; }
            const float mean = ms / (float)ntn; float q = 0.f;
#pragma unroll
            for (int t = 0; t < 4; ++t) if (t < ntn) { const float dm = mt[t] - mean; q += m2[t] + 256.0f * dm * dm; }
            S[row] = (f32x2v){mean, 1.0f / sqrtf(q / (256.0f * (float)ntn) + eps)};
        }
        asm volatile("s_waitcnt lgkmcnt(0)" ::: "memory"); __builtin_amdgcn_s_barrier(); asm volatile("" ::: "memory");
        return bad;
    }
};
struct EpiLnRes {
    static constexpr bool PERM = false, AFTER_DRAIN = true;
    const float* base; float* out; int ldc; const float* bias; PanelStats st; unsigned poison;
    __device__ __forceinline__ void refuse(size_t i0, size_t stride, int M, int N) const { const float q = __builtin_nanf(""); for (size_t i = i0; i < (size_t)M * N; i += stride) out[(i / N) * ldc + i % N] = q;
        if (i0 == 0) { unsigned expect = 0u; __hip_atomic_compare_exchange_strong(st.tmo + 1, &expect, 0x7f0u, __ATOMIC_RELAXED, __ATOMIC_RELAXED, __HIP_MEMORY_SCOPE_AGENT); __hip_atomic_store(st.tmo, 1u, __ATOMIC_RELAXED, __HIP_MEMORY_SCOPE_AGENT); } }
    __device__ __forceinline__ void fused(f32x4 (&acc)[2][2][4][2], const Unit& u, int wr, int wc, int fr, int fq, PG8_LAS unsigned char* lds, int wid, int lane) const {
        typedef float f32x2v __attribute__((ext_vector_type(2)));
        const PG8_LAS f32x2v* S = (const PG8_LAS f32x2v*)(lds + 8192);
        const int col0 = u.pn * BM + wc * 32 + 4 * fq;
#pragma unroll
        for (int bj = 0; bj < 2; ++bj)
#pragma unroll
            for (int n = 0; n < 2; ++n) { const f32x4 bv = bias ? *(const f32x4*)(bias + col0 + bj * HALF + n * 16) : (f32x4){0.f, 0.f, 0.f, 0.f};
#pragma unroll
                for (int ai = 0; ai < 2; ++ai)
#pragma unroll
                    for (int m = 0; m < 4; ++m) acc[ai][bj][m][n] += bv; }
        const bool bad = st.run(acc, u, wr, wc, fr, fq, lds, wid, lane) || poison != 0u;
        const float qnan = __builtin_nanf("");
#pragma unroll
        for (int ai = 0; ai < 2; ++ai)
#pragma unroll
            for (int m = 0; m < 4; ++m) { const int r = ai * HALF + wr * 64 + m * 16 + fr; const f32x2v sr = S[r]; const size_t off = (size_t)(u.pm * BM + r) * ldc + col0;
#pragma unroll
                for (int bj = 0; bj < 2; ++bj)
#pragma unroll
                    for (int n = 0; n < 2; ++n) { const f32x4 bs = *(const f32x4*)(base + off + bj * HALF + n * 16); f32x4 o = bs + (acc[ai][bj][m][n] - sr.x) * sr.y;
                        if (bad) o = (f32x4){qnan, qnan, qnan, qnan}; *(f32x4*)(out + off + bj * HALF + n * 16) = o; }
                asm volatile("" ::: "memory"); }
    }
};
struct EpiLnResLn {
    static constexpr bool PERM = false, AFTER_DRAIN = true;
    const float* base; float* out; bf16_t* xn; int ldc; const float* bias; PanelStats st1, st2; unsigned poison;
    __device__ __forceinline__ void refuse(size_t i0, size_t stride, int M, int N) const { const float q = __builtin_nanf(""); for (size_t i = i0; i < (size_t)M * N; i += stride) { const size_t o = (i / N) * ldc + i % N; out[o] = q; xn[o] = (bf16_t)0x7fc0u; }
        if (i0 == 0) { unsigned expect = 0u; __hip_atomic_compare_exchange_strong(st1.tmo + 1, &expect, 0x7f0u, __ATOMIC_RELAXED, __ATOMIC_RELAXED, __HIP_MEMORY_SCOPE_AGENT); __hip_atomic_store(st1.tmo, 1u, __ATOMIC_RELAXED, __HIP_MEMORY_SCOPE_AGENT); } }
    __device__ __forceinline__ void fused(f32x4 (&acc)[2][2][4][2], const Unit& u, int wr, int wc, int fr, int fq, PG8_LAS unsigned char* lds, int wid, int lane) const {
        typedef float f32x2v __attribute__((ext_vector_type(2))); typedef unsigned u32x2v __attribute__((ext_vector_type(2)));
        const PG8_LAS f32x2v* S = (const PG8_LAS f32x2v*)(lds + 8192);
        const int col0 = u.pn * BM + wc * 32 + 4 * fq;
#pragma unroll
        for (int bj = 0; bj < 2; ++bj)
#pragma unroll
            for (int n = 0; n < 2; ++n) { const f32x4 bv = bias ? *(const f32x4*)(bias + col0 + bj * HALF + n * 16) : (f32x4){0.f, 0.f, 0.f, 0.f};
#pragma unroll
                for (int ai = 0; ai < 2; ++ai)
#pragma unroll
                    for (int m = 0; m < 4; ++m) acc[ai][bj][m][n] += bv; }
        bool bad = st1.run(acc, u, wr, wc, fr, fq, lds, wid, lane) || poison != 0u;
        const float qnan = __builtin_nanf("");
#pragma unroll
        for (int ai = 0; ai < 2; ++ai)
#pragma unroll
            for (int m = 0; m < 4; ++m) { const int r = ai * HALF + wr * 64 + m * 16 + fr; const f32x2v sr = S[r]; const size_t off = (size_t)(u.pm * BM + r) * ldc + col0;
#pragma unroll
                for (int bj = 0; bj < 2; ++bj)
#pragma unroll
                    for (int n = 0; n < 2; ++n) { const f32x4 bs = *(const f32x4*)(base + off + bj * HALF + n * 16); acc[ai][bj][m][n] = bs + (acc[ai][bj][m][n] - sr.x) * sr.y; }
                asm volatile("" : "+v"(acc[ai][0][m][0]), "+v"(acc[ai][0][m][1]), "+v"(acc[ai][1][m][0]), "+v"(acc[ai][1][m][1]));
                if (m & 1) asm volatile("" ::: "memory"); }
        const bool bad1 = bad;
        bad = st2.run(acc, u, wr, wc, fr, fq, lds, wid, lane) || bad;
#pragma unroll
        for (int ai = 0; ai < 2; ++ai)
#pragma unroll
            for (int m = 0; m < 4; ++m) { const int r = ai * HALF + wr * 64 + m * 16 + fr; const f32x2v sr = S[r]; const size_t off = (size_t)(u.pm * BM + r) * ldc + col0;
#pragma unroll
                for (int bj = 0; bj < 2; ++bj)
#pragma unroll
                    for (int n = 0; n < 2; ++n) { const f32x4 x1 = acc[ai][bj][m][n]; *(f32x4*)(out + off + bj * HALF + n * 16) = bad1 ? (f32x4){qnan, qnan, qnan, qnan} : x1;
                        const f32x4 o = (x1 - sr.x) * sr.y; u32x2v w; w.x = cvt_pk_bf16(o[0], o[1]); w.y = cvt_pk_bf16(o[2], o[3]);
                        if (bad) { w.x = 0x7fc07fc0u; w.y = 0x7fc07fc0u; } *(u32x2v*)(xn + off + bj * HALF + n * 16) = w; }
                asm volatile("" ::: "memory"); }
    }
};

template <class Epi, class Sched, bool STAMP = false>
__device__ __forceinline__ void gemm_phase(PG8_LAS unsigned char* lds, const Gemm g, const Sched& S, const Epi& E, unsigned long long* stamps) {
    const int tid = threadIdx.x, wid = __builtin_amdgcn_readfirstlane(tid >> 6), lane = tid & 63, wr = wid >> 2, wc = wid & 3, fr = lane & 15, fq = lane >> 4;
    const int K = g.K, nt = K / BK;
    int ts_lo = 0, ts_hi = 0, nts = 0; const unsigned long long rt_entry = STAMP ? (unsigned long long)wall_clock64() : 0ull;
#define PG8_STAMP() do { if (STAMP && wid == 0 && nts < 64) { const unsigned long long _c = (unsigned long long)clock64(); \
        ts_lo = (lane == nts) ? (int)(unsigned)_c : ts_lo; ts_hi = (lane == nts) ? (int)(unsigned)(_c >> 32) : ts_hi; ++nts; } } while (0)
    PG8_STAMP();
    unsigned voffA[2], voffB[2];
#pragma unroll
    for (int i = 0; i < 2; ++i) { int R, C; stage_rc(tid * 16 + i * 8192, R, C); const int Rb = Epi::PERM ? ((R & ~31) + perm32(R & 31)) : R;
        voffA[i] = (unsigned)(R * K + C) * 2u; voffB[i] = (unsigned)(Rb * K + C) * 2u; }
    const size_t kstep = (size_t)(BK * 2);
    const size_t hstep = (size_t)HALF * K * 2;
    const size_t tstep = 2 * hstep;
    const unsigned ldsw = (unsigned)wid * 1024u;
    const int aoff = lds_byte(wr * 64 + fr, fq * 8), boff = lds_byte(wc * 32 + fr, fq * 8);
#define PG8_SA(b, h) (((b) * 2 + (h)) * HTB)
#define PG8_SB(b, h) ((4 + (b) * 2 + (h)) * HTB)
#define PG8_STAGE(bufoff, gbase, voff) do { _Pragma("unroll") for (int _i = 0; _i < 2; ++_i) \
        __builtin_amdgcn_global_load_lds((const unsigned*)((const char*)(gbase) + (voff)[_i]), (PG8_LAS unsigned*)(lds + (bufoff) + ldsw + _i * 8192), 16, 0, 0); } while (0)
#define PG8_LDA(dst, b, h) do { _Pragma("unroll") for (int m = 0; m < 4; ++m) _Pragma("unroll") for (int k = 0; k < 2; ++k) dst[m][k] = *(const PG8_LAS bf16x8*)(lds + PG8_SA(b, h) + aoff + m * 2048 + k * 1024); } while (0)
#define PG8_LDB(dst, b, h) do { _Pragma("unroll") for (int n = 0; n < 2; ++n) _Pragma("unroll") for (int k = 0; k < 2; ++k) dst[n][k] = *(const PG8_LAS bf16x8*)(lds + PG8_SB(b, h) + boff + n * 2048 + k * 1024); } while (0)
#define PG8_MMA(ai, bj, At, Bt) do { __builtin_amdgcn_s_setprio(1); _Pragma("unroll") for (int m = 0; m < 4; ++m) _Pragma("unroll") for (int n = 0; n < 2; ++n) _Pragma("unroll") for (int k = 0; k < 2; ++k) \
        acc[ai][bj][m][n] = __builtin_amdgcn_mfma_f32_16x16x32_bf16(Bt[n][k], At[m][k], acc[ai][bj][m][n], 0, 0, 0); __builtin_amdgcn_s_setprio(0); } while (0)
#define PG8_WAIT_V(n) asm volatile("s_waitcnt vmcnt(" #n ")" ::: "memory")
#define PG8_WAIT_L(n) asm volatile("s_waitcnt lgkmcnt(" #n ")" ::: "memory")
#define PG8_BAR __builtin_amdgcn_s_barrier()
#define PG8_SCHED __builtin_amdgcn_sched_barrier(0)
    Unit cur, nxt; int ui = 0;
    if (!S.next(0, cur)) return;
    f32x4 acc[2][2][4][2];
#pragma unroll
    for (int a = 0; a < 2; ++a)
#pragma unroll
        for (int b = 0; b < 2; ++b)
#pragma unroll
            for (int m = 0; m < 4; ++m)
#pragma unroll
                for (int n = 0; n < 2; ++n) acc[a][b][m][n] = (f32x4){0.f, 0.f, 0.f, 0.f};
    bf16x8 At[4][2], B0[2][2], B1[2][2];
    const char* cA = (const char*)g.A + (size_t)cur.pm * tstep; const char* cB = (const char*)g.Bt + (size_t)cur.pn * tstep;
    S.a_ready(cur);
    PG8_STAGE(PG8_SB(0, 0), cB, voffB); PG8_STAGE(PG8_SA(0, 0), cA, voffA); PG8_STAGE(PG8_SB(0, 1), cB + hstep, voffB); PG8_STAGE(PG8_SA(0, 1), cA + hstep, voffA);
    if (wr == 1) PG8_BAR;
    PG8_WAIT_V(4); PG8_BAR;
    PG8_STAGE(PG8_SB(1, 0), cB + kstep, voffB); PG8_STAGE(PG8_SA(1, 0), cA + kstep, voffA); PG8_STAGE(PG8_SB(1, 1), cB + hstep + kstep, voffB);
    PG8_WAIT_V(6); PG8_BAR;
    PG8_STAMP();
    for (;;) {
        const bool has_next = S.next(ui + 1, nxt);
        const char* nA = has_next ? (const char*)g.A + (size_t)nxt.pm * tstep : cA; const char* nB = has_next ? (const char*)g.Bt + (size_t)nxt.pn * tstep : cB;
        for (int t = 0; t < nt; t += 2) {
            const bool last = (t == nt - 2);
            const char* a1 = cA + (size_t)(t + 1) * kstep;
            const char* a2 = last ? nA : cA + (size_t)(t + 2) * kstep; const char* b2 = last ? nB : cB + (size_t)(t + 2) * kstep;
            const char* a3 = a2 + kstep; const char* b3 = b2 + kstep;
            if (last && has_next) S.a_ready(nxt);
            PG8_LDB(B0, 0, 0); PG8_SCHED; PG8_LDA(At, 0, 0); PG8_STAGE(PG8_SA(1, 1), a1 + hstep, voffA);
            PG8_WAIT_L(8); PG8_BAR; PG8_WAIT_L(0); PG8_MMA(0, 0, At, B0); PG8_BAR; PG8_SCHED;
            PG8_LDB(B1, 0, 1); PG8_STAGE(PG8_SB(0, 0), b2, voffB);
            PG8_BAR; PG8_WAIT_L(0); PG8_MMA(0, 1, At, B1); PG8_BAR;
            PG8_LDA(At, 0, 1); PG8_STAGE(PG8_SA(0, 0), a2, voffA);
            PG8_BAR; PG8_WAIT_L(0); PG8_MMA(1, 0, At, B0); PG8_BAR; PG8_SCHED;
            PG8_STAGE(PG8_SB(0, 1), b2 + hstep, voffB);
            PG8_WAIT_V(6); PG8_BAR; PG8_MMA(1, 1, At, B1); PG8_BAR;
            PG8_LDB(B0, 1, 0); PG8_SCHED; PG8_LDA(At, 1, 0); PG8_STAGE(PG8_SA(0, 1), a2 + hstep, voffA);
            PG8_WAIT_L(8); PG8_BAR; PG8_WAIT_L(0); PG8_MMA(0, 0, At, B0); PG8_BAR; PG8_SCHED;
            PG8_LDB(B1, 1, 1); PG8_STAGE(PG8_SB(1, 0), b3, voffB);
            PG8_BAR; PG8_WAIT_L(0); PG8_MMA(0, 1, At, B1); PG8_BAR;
            PG8_LDA(At, 1, 1); PG8_STAGE(PG8_SA(1, 0), a3, voffA);
            PG8_BAR; PG8_WAIT_L(0); PG8_MMA(1, 0, At, B0); PG8_BAR; PG8_SCHED;
            PG8_STAGE(PG8_SB(1, 1), b3 + hstep, voffB);
            PG8_WAIT_V(6); PG8_BAR; PG8_MMA(1, 1, At, B1); PG8_BAR;
        }
        PG8_STAMP();
        if constexpr (!Epi::AFTER_DRAIN) { E(acc, cur, wr, wc, fr, fq); S.done(cur); }
        PG8_STAMP();
        if (!has_next) break;
#pragma unroll
        for (int a = 0; a < 2; ++a)
#pragma unroll
            for (int b = 0; b < 2; ++b)
#pragma unroll
                for (int m = 0; m < 4; ++m)
#pragma unroll
                    for (int n = 0; n < 2; ++n) acc[a][b][m][n] = (f32x4){0.f, 0.f, 0.f, 0.f};
        cur = nxt; cA = nA; cB = nB; ++ui;
    }
    PG8_WAIT_V(0);
    if (wr == 0) PG8_BAR;
    PG8_BAR;
    if constexpr (Epi::AFTER_DRAIN) { E.fused(acc, cur, wr, wc, fr, fq, lds, wid, lane); S.done(cur); }
    PG8_STAMP();
    if (STAMP && wid == 0) { stamps[lane] = lane < nts ? (((unsigned long long)(unsigned)ts_hi << 32) | (unsigned)ts_lo) : 0ull;
        if (lane == 62) stamps[62] = rt_entry; if (lane == 63) stamps[63] = (unsigned long long)wall_clock64(); }
#undef PG8_STAMP
#undef PG8_SA
#undef PG8_SB
#undef PG8_STAGE
#undef PG8_LDA
#undef PG8_LDB
#undef PG8_MMA
#undef PG8_WAIT_V
#undef PG8_WAIT_L
#undef PG8_BAR
#undef PG8_SCHED
}
}

#define LAS __attribute__((address_space(3)))
typedef unsigned short bf16_t;
typedef short bf16x8 __attribute__((ext_vector_type(8)));
typedef float f32x4 __attribute__((ext_vector_type(4)));
typedef unsigned u32x4 __attribute__((ext_vector_type(4)));
typedef unsigned u32x2 __attribute__((ext_vector_type(2)));
typedef __bf16 bf2_t __attribute__((ext_vector_type(2)));
typedef _Float16 h2_t __attribute__((ext_vector_type(2)));

constexpr int NTOK = 65536, DM = 1024, NTOK_P = 32768;
constexpr int L0 = 8192, L1 = 4096;
constexpr float ALPHA_C = 1.189207115002721f;
constexpr float LN_EPS_C = 1e-5f;
constexpr int NTHREADS = 512;
constexpr int NPHASE = 9;
constexpr int LDS_BYTES = 143360;
constexpr size_t MiB = 1024ull * 1024ull;
constexpr size_t WS_XB = 0;
constexpr size_t WS_PH = 128 * MiB;
constexpr size_t WS_ZT = 320 * MiB;
constexpr size_t WS_U8 = 384 * MiB, WS_V8 = 400 * MiB;
constexpr size_t WS_PARTD = 128 * MiB;
constexpr float U_SCALE = 128.0f, V_SCALE = 16.0f;
constexpr size_t WS_WINT = 448 * MiB, WS_WOUTT = 454 * MiB, WS_WPT = 456 * MiB;
constexpr size_t WS_FG = 460 * MiB;
constexpr size_t WS_PART = 484 * MiB;
constexpr size_t WS_DUMMY = 492 * MiB;
constexpr size_t WS_BAR = 497 * MiB;
constexpr size_t WS_END = 498 * MiB;
constexpr size_t WS_EIDX = 416 * MiB, WS_GATE = 460 * MiB;
constexpr size_t OUT_X0T = 192 * MiB;

struct Params { const float* in[24]; float* out; unsigned char* ws; int ph_lo, ph_hi, nrep, pad; };

__device__ __forceinline__ unsigned pack2bf(float lo, float hi) { return pg8::cvt_pk_bf16(lo, hi); }
__device__ __forceinline__ float bf_lo(unsigned w) { return __uint_as_float(w << 16); }
__device__ __forceinline__ float bf_hi(unsigned w) { return __uint_as_float(w & 0xffff0000u); }
__device__ __forceinline__ unsigned short f2bf(float f) { return (unsigned short)(pack2bf(f, 0.f) & 0xffffu); }

__device__ __forceinline__ void seq_of(int tok0, int& seq, int& L, int& tl) {
    if (tok0 < NTOK_P) { seq = tok0 >> 13; L = L0; tl = tok0 & (L0 - 1); }
    else { const int r = tok0 - NTOK_P; seq = 4 + (r >> 12); L = L1; tl = r & (L1 - 1); }
}
__device__ __forceinline__ size_t seq_base_T(int seq) { return seq < 4 ? (size_t)seq * 512 * L0 : (size_t)4 * 512 * L0 + (size_t)(seq - 4) * 512 * L1; }

struct EpiP {
    static constexpr bool PERM = true, AFTER_DRAIN = false;
    bf16_t* PA; bf16_t* PH; const float* bias;
    __device__ __forceinline__ void operator()(const f32x4 (&acc)[2][2][4][2], const pg8::Unit& u, int wr, int wc, int fr, int fq) const {
        const int row0 = u.pm * 256 + wr * 64 + fr, lc = wc * 32 + 8 * fq;
        if (u.pn >= 2 && u.pn < 6) {
            const int ch0 = (u.pn - 2) * 128 + lc;
            f32x4 bc[2], bh[2];
#pragma unroll
            for (int n = 0; n < 2; ++n) { bc[n] = *(const f32x4*)(bias + 512 + ch0 + 4 * n); bh[n] = *(const f32x4*)(bias + 1024 + ch0 + 4 * n); }
#pragma unroll
            for (int ai = 0; ai < 2; ++ai)
#pragma unroll
                for (int m = 0; m < 4; ++m) { const f32x4 g0 = (acc[ai][0][m][0] + bc[0]) * (acc[ai][1][m][0] + bh[0]), g1 = (acc[ai][0][m][1] + bc[1]) * (acc[ai][1][m][1] + bh[1]);
                    u32x4 w; w.x = pack2bf(g0[0], g0[1]); w.y = pack2bf(g0[2], g0[3]); w.z = pack2bf(g1[0], g1[1]); w.w = pack2bf(g1[2], g1[3]);
                    *(u32x4*)(PA + (size_t)(row0 + ai * 128 + m * 16) * 1024 + 512 + ch0) = w; }
        } else {
            const bool isB = u.pn < 2; bf16_t* base = isB ? PA : PH; const int pitch = isB ? 1024 : 1536;
            const int colt = isB ? u.pn * 256 : u.pn * 256 - 1536, bcol0 = u.pn * 256 + lc;
            f32x4 bv[2][2];
#pragma unroll
            for (int bj = 0; bj < 2; ++bj)
#pragma unroll
                for (int n = 0; n < 2; ++n) bv[bj][n] = *(const f32x4*)(bias + bcol0 + bj * 128 + 4 * n);
#pragma unroll
            for (int ai = 0; ai < 2; ++ai)
#pragma unroll
                for (int m = 0; m < 4; ++m) { bf16_t* rowp = base + (size_t)(row0 + ai * 128 + m * 16) * pitch + colt + lc;
#pragma unroll
                    for (int bj = 0; bj < 2; ++bj) { const f32x4 v0 = acc[ai][bj][m][0] + bv[bj][0], v1 = acc[ai][bj][m][1] + bv[bj][1];
                        u32x4 w; w.x = pack2bf(v0[0], v0[1]); w.y = pack2bf(v0[2], v0[3]); w.z = pack2bf(v1[0], v1[1]); w.w = pack2bf(v1[2], v1[3]);
                        *(u32x4*)(rowp + bj * 128) = w; } }
        }
    }
};
struct EpiH1 {
    static constexpr bool PERM = true, AFTER_DRAIN = false;
    const float* xp; const float* xs; bf16_t* out;
    __device__ __forceinline__ void operator()(const f32x4 (&acc)[2][2][4][2], const pg8::Unit& u, int wr, int wc, int fr, int fq) const {
        const int row0 = u.pm * 256 + wr * 64 + fr, col0 = u.pn * 256 + wc * 32 + 8 * fq;
        const float* xb = (u.pm * 256 < NTOK_P) ? xp : (xs - (size_t)NTOK_P * DM);
#pragma unroll
        for (int ai = 0; ai < 2; ++ai)
#pragma unroll
            for (int m = 0; m < 4; ++m) { const size_t off = (size_t)(row0 + ai * 128 + m * 16) * DM + col0;
#pragma unroll
                for (int bj = 0; bj < 2; ++bj) { const f32x4 x0 = *(const f32x4*)(xb + off + bj * 128), x1 = *(const f32x4*)(xb + off + bj * 128 + 4);
                    const f32x4 v0 = x0 * ALPHA_C + acc[ai][bj][m][0], v1 = x1 * ALPHA_C + acc[ai][bj][m][1];
                    u32x4 w; w.x = pack2bf(v0[0], v0[1]); w.y = pack2bf(v0[2], v0[3]); w.z = pack2bf(v1[0], v1[1]); w.w = pack2bf(v1[2], v1[3]);
                    *(u32x4*)(out + off + bj * 128) = w; } }
    }
};
struct EpiS {
    static constexpr bool PERM = true, AFTER_DRAIN = false;
    unsigned short* S;
    __device__ __forceinline__ void operator()(const f32x4 (&acc)[2][2][4][2], const pg8::Unit& u, int wr, int wc, int fr, int fq) const {
        const int row0 = u.pm * 256 + wr * 64 + fr, col0 = u.pn * 256 + wc * 32 + 8 * fq;
#pragma unroll
        for (int ai = 0; ai < 2; ++ai)
#pragma unroll
            for (int m = 0; m < 4; ++m) { unsigned short* rowp = S + (size_t)(row0 + ai * 128 + m * 16) * 2048 + col0;
#pragma unroll
                for (int bj = 0; bj < 2; ++bj) { const f32x4 v0 = acc[ai][bj][m][0], v1 = acc[ai][bj][m][1];
                    u32x4 w;
                    w.x = __builtin_bit_cast(unsigned, __builtin_amdgcn_cvt_pkrtz(v0[0], v0[1])); w.y = __builtin_bit_cast(unsigned, __builtin_amdgcn_cvt_pkrtz(v0[2], v0[3]));
                    w.z = __builtin_bit_cast(unsigned, __builtin_amdgcn_cvt_pkrtz(v1[0], v1[1])); w.w = __builtin_bit_cast(unsigned, __builtin_amdgcn_cvt_pkrtz(v1[2], v1[3]));
                    *(u32x4*)(rowp + bj * 128) = w; } }
    }
};

__device__ void cvt_f32_bf16(const float* __restrict__ s, bf16_t* __restrict__ d, size_t n8) {
    const size_t q = n8 >> 2;
    for (size_t i = (size_t)blockIdx.x * NTHREADS + threadIdx.x; i < q; i += (size_t)gridDim.x * NTHREADS) {
        float4 a[4], b[4];
#pragma unroll
        for (int k = 0; k < 4; ++k) { const f32x4 ta = __builtin_nontemporal_load((const f32x4*)s + 2 * (i + k * q)), tb = __builtin_nontemporal_load((const f32x4*)s + 2 * (i + k * q) + 1);
            a[k] = make_float4(ta[0], ta[1], ta[2], ta[3]); b[k] = make_float4(tb[0], tb[1], tb[2], tb[3]); }
#pragma unroll
        for (int k = 0; k < 4; ++k) { u32x4 w; w.x = pack2bf(a[k].x, a[k].y); w.y = pack2bf(a[k].z, a[k].w); w.z = pack2bf(b[k].x, b[k].y); w.w = pack2bf(b[k].z, b[k].w);
            ((u32x4*)d)[i + k * q] = w; }
    }
}
__device__ __forceinline__ unsigned pack4fp8(float a, float b, float c, float d) { int p = 0; p = __builtin_amdgcn_cvt_pk_fp8_f32(a, b, p, false); p = __builtin_amdgcn_cvt_pk_fp8_f32(c, d, p, true); return (unsigned)p; }
__device__ void cvt_f32_fp8(const float* __restrict__ s, unsigned char* __restrict__ d, size_t n16, float sc) {
    const size_t h = n16 >> 1;
    for (size_t i0 = (size_t)blockIdx.x * NTHREADS + threadIdx.x; i0 < h; i0 += (size_t)gridDim.x * NTHREADS) {
        float4 v[2][4];
#pragma unroll
        for (int k = 0; k < 2; ++k)
#pragma unroll
            for (int j = 0; j < 4; ++j) { const f32x4 t = __builtin_nontemporal_load((const f32x4*)s + 4 * (i0 + k * h) + j); v[k][j] = make_float4(t[0], t[1], t[2], t[3]); }
#pragma unroll
        for (int k = 0; k < 2; ++k) { const size_t i = i0 + k * h; const float4 a = v[k][0], b = v[k][1], c = v[k][2], e = v[k][3];
            u32x4 w; w.x = pack4fp8(a.x * sc, a.y * sc, a.z * sc, a.w * sc); w.y = pack4fp8(b.x * sc, b.y * sc, b.z * sc, b.w * sc); w.z = pack4fp8(c.x * sc, c.y * sc, c.z * sc, c.w * sc); w.w = pack4fp8(e.x * sc, e.y * sc, e.z * sc, e.w * sc);
            const size_t er = i >> 6, kk = i & 63;
            *(u32x4*)(d + ((kk >> 3) * 16384 + er) * 128 + (kk & 7) * 16) = w; }
    }
}
__device__ __forceinline__ int win_perm(int c) { if (c < 512 || c >= 1536) return c; const int ch = (c - 512) & 511, hsel = (c >= 1024) ? 128 : 0; return 512 + (ch >> 7) * 256 + hsel + (ch & 127); }
template <bool PERM_WIN>
__device__ void transpose_cvt(const float* __restrict__ src, int R, int C, bf16_t* __restrict__ dst, float* tile  ) {
    const int tid = threadIdx.x, nct = C / 64, nu = (R / 64) * nct;
    for (int u = blockIdx.x; u < nu; u += gridDim.x) {
        const int r0 = (u / nct) * 64, c0 = (u % nct) * 64;
        { const int r = tid >> 3, c8 = (tid & 7) * 8; const float4 a = *(const float4*)(src + (size_t)(r0 + r) * C + c0 + c8), b = *(const float4*)(src + (size_t)(r0 + r) * C + c0 + c8 + 4);
          float* t = tile + r * 65 + c8; t[0] = a.x; t[1] = a.y; t[2] = a.z; t[3] = a.w; t[4] = b.x; t[5] = b.y; t[6] = b.z; t[7] = b.w; }
        __syncthreads();
        { const int c = tid >> 3, r8 = (tid & 7) * 8; float v[8];
#pragma unroll
          for (int k = 0; k < 8; ++k) v[k] = tile[(r8 + k) * 65 + c];
          u32x4 w; w.x = pack2bf(v[0], v[1]); w.y = pack2bf(v[2], v[3]); w.z = pack2bf(v[4], v[5]); w.w = pack2bf(v[6], v[7]);
          *(u32x4*)(dst + (size_t)(PERM_WIN ? win_perm(c0 + c) : (c0 + c)) * R + r0 + r8) = w; }
        __syncthreads();
    }
}
__device__ void fold_wq_keys(const float* __restrict__ wq, const float* __restrict__ keys, bf16_t* __restrict__ WpT, float* lds) {
    float* sk = lds; float* sw = lds + 64 * 132;
    const int tid = threadIdx.x;
    for (int u = blockIdx.x; u < 512; u += gridDim.x) {
        const int hp = u >> 5, n0 = ((u >> 4) & 1) * 64, d0 = (u & 15) * 64;
        for (int i = tid; i < 64 * 32; i += NTHREADS) { const int r = i >> 5, k4 = (i & 31) * 4;
            const float4 a = *(const float4*)(keys + ((size_t)hp * 128 + n0 + r) * 128 + k4); float* t = sk + r * 132 + k4; t[0] = a.x; t[1] = a.y; t[2] = a.z; t[3] = a.w;
            const float4 b = *(const float4*)(wq + (size_t)(d0 + r) * 2048 + hp * 128 + k4); float* s = sw + r * 132 + k4; s[0] = b.x; s[1] = b.y; s[2] = b.z; s[3] = b.w; }
        __syncthreads();
        const int ni = tid >> 3, dj = tid & 7; float acc[8];
#pragma unroll
        for (int q = 0; q < 8; ++q) acc[q] = 0.f;
        for (int k = 0; k < 128; ++k) { const float a = sk[ni * 132 + k];
#pragma unroll
            for (int q = 0; q < 8; ++q) acc[q] += a * sw[(dj + 8 * q) * 132 + k]; }
#pragma unroll
        for (int q = 0; q < 8; ++q) WpT[((size_t)hp * 128 + n0 + ni) * 1024 + d0 + dj + 8 * q] = f2bf(acc[q]);
        __syncthreads();
    }
}
__device__ void hyena_filter_gen(const Params& p, float* lds) {
    const float* w1 = p.in[7]; const float* b1 = p.in[8]; const float* fr = p.in[9]; const float* w2 = p.in[10]; const float* b2 = p.in[11]; const float* w3 = p.in[12]; const float* dec = p.in[13];
    bf16_t* Fg = (bf16_t*)(p.ws + WS_FG); float* part = (float*)(p.ws + WS_PART);
    constexpr int NG = 3, NP = NG * 16;
    float* sfeat = lds; float* sh1 = sfeat + NP * 33; float* sh2 = sh1 + NP * 64;
    float* sw1 = sh2 + NP * 64; float* sw2 = sw1 + 33 * 64; float* sb1 = sw2 + 64 * 64; float* sb2 = sb1 + 64; float* sfr = sb2 + 64;
    const int tid = threadIdx.x, c = tid;
    for (int i = tid; i < 33 * 64; i += NTHREADS) sw1[i] = w1[i];
    for (int i = tid; i < 64 * 64; i += NTHREADS) sw2[i] = w2[i];
    if (tid < 64) { sb1[tid] = b1[tid]; sb2[tid] = b2[tid]; sfr[tid] = fr[tid]; }
    for (int idx = tid; idx < NP * 33; idx += NTHREADS) { const int q = idx / 33, f = idx % 33, it = (int)blockIdx.x + (q >> 4) * (int)gridDim.x;
        const int variant = it >= 512, L = variant ? L1 : L0, n = (variant ? it - 512 : it) * 16 + (q & 15); float val;
        if (f == 0) val = (float)n * (1.0f / (float)(L - 1));
        else { const int band = (f - 1) & 15; const float fj = 1e-4f + (float)band * ((15.0f - 1e-4f) / 15.0f); const float w = 6.283185307179586f * (float)n / (float)L; const float arg = fj * w;
               val = (f - 1) >= 16 ? -sinf(arg) : cosf(arg); }
        sfeat[idx] = val; }
    __syncthreads();
    for (int idx = tid; idx < NP * 64; idx += NTHREADS) { const int q = idx >> 6, j = idx & 63; float s = sb1[j];
#pragma unroll
        for (int f = 0; f < 33; ++f) s += sfeat[q * 33 + f] * sw1[f * 64 + j];
        sh1[idx] = sinf(sfr[j] * s); }
    __syncthreads();
    for (int idx = tid; idx < NP * 64; idx += NTHREADS) { const int q = idx >> 6, j = idx & 63; float s = sb2[j];
#pragma unroll 16
        for (int i = 0; i < 64; ++i) s += sh1[q * 64 + i] * sw2[i * 64 + j];
        sh2[idx] = sinf(sfr[j] * s); }
    __syncthreads();
    float acc0[NP], acc1[NP];
#pragma unroll
    for (int q = 0; q < NP; ++q) { acc0[q] = 0.f; acc1[q] = 0.f; }
#pragma unroll 2
    for (int j = 0; j < 64; ++j) { const float wa = w3[j * 1024 + c], wb = w3[j * 1024 + 512 + c];
#pragma unroll
        for (int q = 0; q < NP; ++q) { const float h = sh2[q * 64 + j]; acc0[q] += h * wa; acc1[q] += h * wb; } }
    const float a0 = fabsf(dec[c]), a1 = fabsf(dec[512 + c]);
    float sum0 = 0.f, sum1 = 0.f;
#pragma unroll
    for (int g = 0; g < NG; ++g) { const int it = (int)blockIdx.x + g * (int)gridDim.x;
        if (it < 768) { const int variant = it >= 512, L = variant ? L1 : L0, n0 = (variant ? it - 512 : it) * 16; const float tstep = 1.0f / (float)(L - 1);
            bf16_t* Fc = Fg + (variant ? (size_t)512 * 2 * L0 : 0) + (size_t)c * 2 * L; float s = 0.f;
#pragma unroll
            for (int pp = 0; pp < 16; ++pp) { const int n = n0 + pp; const float t = (float)n * tstep;
                const float v0 = acc0[g * 16 + pp] * expf(-t * a0), v1 = acc1[g * 16 + pp] * expf(-t * a1);
                s += fabsf(v0); Fc[L - n] = f2bf(v0);
                if (n >= 1) { s += fabsf(v1); Fc[L + n] = f2bf(v1); } else Fc[0] = 0; }
            if (variant) sum1 += s; else sum0 += s; } }
    part[((size_t)0 * 1024 + blockIdx.x) * 512 + c] = sum0;
    part[((size_t)1 * 1024 + blockIdx.x) * 512 + c] = sum1;
    __syncthreads();
}

__device__ __forceinline__ void unpack8(const u32x4 w, float (&f)[8]) { f[0] = bf_lo(w.x); f[1] = bf_hi(w.x); f[2] = bf_lo(w.y); f[3] = bf_hi(w.y); f[4] = bf_lo(w.z); f[5] = bf_hi(w.z); f[6] = bf_lo(w.w); f[7] = bf_hi(w.w); }
__device__ void phase_conv3(const Params& p, unsigned char* lds) {
    const bf16_t* PA = (const bf16_t*)p.out; const bf16_t* PH = (const bf16_t*)(p.ws + WS_PH);
    bf16_t* Ycat = (bf16_t*)(p.ws + WS_XB); bf16_t* zT = (bf16_t*)(p.ws + WS_ZT); bf16_t* x0T = (bf16_t*)((unsigned char*)p.out + OUT_X0T);
    const float* acw = p.in[4]; const float* hcw = p.in[5]; const float* hcb = p.in[6];
    bf16_t* sx0 = (bf16_t*)lds; bf16_t* sz = sx0 + 64 * 66;
    const int tid = threadIdx.x, r = tid >> 3, cg8 = tid & 7;
    const int ct = blockIdx.x & 7, c0 = ct * 64 + cg8 * 8;
    for (int tt = blockIdx.x >> 3; tt < 1024; tt += gridDim.x >> 3) {
        const int tok0 = tt * 64; int seq, L, tl; seq_of(tok0, seq, L, tl);
        const int tok = tok0 + r, pos = tl + r;
        const bool hp = pos > 0, hn = pos < L - 1;
        const u32x4 zero4 = {0u, 0u, 0u, 0u};
        { const bf16_t* row = PA + (size_t)tok * 1024 + c0;
          float ab[8], gc[8], gp[8], gn[8];
          unpack8(*(const u32x4*)row, ab); unpack8(*(const u32x4*)(row + 512), gc);
          unpack8(hp ? *(const u32x4*)(row - 1024 + 512) : zero4, gp); unpack8(hn ? *(const u32x4*)(row + 1024 + 512) : zero4, gn);
          float y[8];
#pragma unroll
          for (int k = 0; k < 8; ++k) y[k] = ab[k] * (acw[c0 + k] * gp[k] + acw[512 + c0 + k] * gc[k] + acw[1024 + c0 + k] * gn[k]);
          u32x4 w; w.x = pack2bf(y[0], y[1]); w.y = pack2bf(y[2], y[3]); w.z = pack2bf(y[4], y[5]); w.w = pack2bf(y[6], y[7]);
          *(u32x4*)(Ycat + (size_t)tok * DM + c0) = w; }
        { const bf16_t* row = PH + (size_t)tok * 1536 + c0; float hy[3][8];
#pragma unroll
          for (int part = 0; part < 3; ++part) { float vp[8], vc[8], vn[8]; const bf16_t* rp = row + part * 512; const int cc = part * 512 + c0;
              unpack8(*(const u32x4*)rp, vc); unpack8(hp ? *(const u32x4*)(rp - 1536) : zero4, vp); unpack8(hn ? *(const u32x4*)(rp + 1536) : zero4, vn);
#pragma unroll
              for (int k = 0; k < 8; ++k) hy[part][k] = hcw[cc + k] * vp[k] + hcw[1536 + cc + k] * vc[k] + hcw[3072 + cc + k] * vn[k] + hcb[cc + k]; }
#pragma unroll
          for (int k = 0; k < 8; ++k) { sx0[(cg8 * 8 + k) * 66 + r] = f2bf(hy[0][k]); sz[(cg8 * 8 + k) * 66 + r] = f2bf(hy[2][k] * hy[1][k]); } }
        __syncthreads();
        { const int c = tid >> 3, ch = tid & 7; const unsigned* s0 = (const unsigned*)(sx0 + c * 66 + ch * 8); const unsigned* s1 = (const unsigned*)(sz + c * 66 + ch * 8);
          u32x4 w0 = {s0[0], s0[1], s0[2], s0[3]}, w1 = {s1[0], s1[1], s1[2], s1[3]};
          const size_t o = seq_base_T(seq) + (size_t)(ct * 64 + c) * L + tl + ch * 8;
          *(u32x4*)(x0T + o) = w0; *(u32x4*)(zT + o) = w1; }
        __syncthreads();
    }
}

__device__ void phase_longconv(const Params& p, unsigned char* ldsg) {
    LAS unsigned char* lds = (LAS unsigned char*)ldsg;
    const bf16_t* Fg = (const bf16_t*)(p.ws + WS_FG); const float* part = (const float*)(p.ws + WS_PART);
    const bf16_t* zT = (const bf16_t*)(p.ws + WS_ZT); const bf16_t* x0T = (const bf16_t*)((const unsigned char*)p.out + OUT_X0T);
    bf16_t* yhT = (bf16_t*)(p.ws + WS_PH); const float* hyb = p.in[14];
    constexpr int F1OFF = 32768, ZOFF = 65536, ZERO = ZOFF + 73728, SCAL = ZERO + 160;
    const int tid = threadIdx.x, wave = __builtin_amdgcn_readfirstlane(tid >> 6), lane = tid & 63, n = lane & 15, kq = lane >> 4;
    for (int u = blockIdx.x; u < 1024; u += gridDim.x) {
        const int variant = u >= 512, c = u & 511, L = variant ? L1 : L0, nb = L >> 6, nseq = variant ? 8 : 4;
        const bf16_t* Fc = Fg + (variant ? (size_t)512 * 2 * L0 : 0) + (size_t)c * 2 * L;
        for (int i = tid; i < (2 * L) / 8; i += NTHREADS) *(LAS u32x4*)(lds + i * 16) = ((const u32x4*)Fc)[i];
        for (int i = tid; i < nseq * (L / 8); i += NTHREADS) { const int b = i / (L / 8), q = i % (L / 8);
            const int seq = variant ? 4 + b : b;
            *(LAS u32x4*)(lds + ZOFF + (b * nb + (q >> 3)) * 144 + (q & 7) * 16) = *(const u32x4*)(zT + seq_base_T(seq) + (size_t)c * L + q * 8); }
        if (tid < 36) *(LAS unsigned*)(lds + ZERO + tid * 4) = 0u;
        if (wave == 0) { float s = 0.f; for (int b = lane; b < (int)gridDim.x; b += 64) s += part[((size_t)variant * 1024 + b) * 512 + c];
#pragma unroll
            for (int o = 32; o >= 1; o >>= 1) s += __shfl_xor(s, o);
            if (lane == 0) *(LAS float*)(lds + SCAL) = 1.0f / s; }
        __syncthreads();
        for (int i = tid; i < L; i += NTHREADS) { const unsigned a = *(LAS unsigned*)(lds + i * 4); const unsigned b = (i + 1 < L) ? *(LAS unsigned*)(lds + i * 4 + 4) : 0u;
            *(LAS unsigned*)(lds + F1OFF + i * 4) = (a >> 16) | (b << 16); }
        __syncthreads();
        const float inv = *(LAS float*)(lds + SCAL);
        const int b = variant ? wave : (wave >> 1), J0 = variant ? 0 : (wave & 1) * 64;
        f32x4 acc[4][4];
#pragma unroll
        for (int mi = 0; mi < 4; ++mi)
#pragma unroll
            for (int nt = 0; nt < 4; ++nt) acc[mi][nt] = (f32x4){0.f, 0.f, 0.f, 0.f};
        const int cl = ((n & 1) ? F1OFF - 2 : 0) + 2 * (L + 8 * kq - n);
        const int zrow = ZOFF + b * nb * 144 + kq * 16;
        const int dbeg = J0 - (nb - 1), dend = J0 + 63, zzero = ZERO + kq * 16;
#define LC_LOAD(A_, B_, dd) do { const int d_ = min((dd), dend); const int abase_ = cl - 128 * d_; \
            _Pragma("unroll") for (int ai = 0; ai < 6; ++ai) { const LAS unsigned* fp = (const LAS unsigned*)(lds + abase_ - 32 * (ai - 2)); const u32x4 w_ = {fp[0], fp[1], fp[2], fp[3]}; A_[ai] = __builtin_bit_cast(bf16x8, w_); } \
            _Pragma("unroll") for (int nt = 0; nt < 4; ++nt) { const int blk_ = J0 + 16 * nt + n - d_; const int ad_ = ((unsigned)blk_ < (unsigned)nb) ? zrow + blk_ * 144 : zzero; \
                B_[2 * nt] = *(const LAS bf16x8*)(lds + ad_); B_[2 * nt + 1] = *(const LAS bf16x8*)(lds + ad_ + 64); } } while (0)
#define LC_MMA(A_, B_, dd) do { const int d_ = (dd); \
            _Pragma("unroll") for (int nt = 0; nt < 4; ++nt) { const int lo_ = J0 + 16 * nt - (nb - 1), hi_ = J0 + 16 * nt + 15; \
                if (d_ >= lo_ && d_ <= hi_) { \
                    _Pragma("unroll") for (int mi = 0; mi < 4; ++mi) { acc[mi][nt] = __builtin_amdgcn_mfma_f32_16x16x32_bf16(A_[mi + 2], B_[2 * nt], acc[mi][nt], 0, 0, 0); \
                                                                        acc[mi][nt] = __builtin_amdgcn_mfma_f32_16x16x32_bf16(A_[mi], B_[2 * nt + 1], acc[mi][nt], 0, 0, 0); } } } } while (0)
        bf16x8 aX[6], bX[8], aY[6], bY[8];
        LC_LOAD(aX, bX, dbeg);
        for (int d = dbeg; d <= dend; d += 2) {
            LC_LOAD(aY, bY, d + 1);
            LC_MMA(aX, bX, d);
            LC_LOAD(aX, bX, d + 2);
            if (d + 1 <= dend) LC_MMA(aY, bY, d + 1);
        }
#undef LC_LOAD
#undef LC_MMA
        const float hb = hyb[c]; const int seq = variant ? 4 + b : b; const size_t gbase = seq_base_T(seq) + (size_t)c * L;
#pragma unroll
        for (int nt = 0; nt < 4; ++nt) { const int J = J0 + 16 * nt + n;
#pragma unroll
            for (int mi = 0; mi < 4; ++mi) { const int i0 = 16 * mi + 4 * kq; const size_t o = gbase + (size_t)J * 64 + i0;
                const u32x2 zw = *(const LAS u32x2*)(lds + ZOFF + (b * nb + J) * 144 + i0 * 2); const u32x2 xw = *(const u32x2*)(x0T + o);
                const f32x4 v = acc[mi][nt];
                const float y0 = bf_lo(xw.x) * (v[0] * inv + hb * bf_lo(zw.x)), y1 = bf_hi(xw.x) * (v[1] * inv + hb * bf_hi(zw.x));
                const float y2 = bf_lo(xw.y) * (v[2] * inv + hb * bf_lo(zw.y)), y3 = bf_hi(xw.y) * (v[3] * inv + hb * bf_hi(zw.y));
                u32x2 w; w.x = pack2bf(y0, y1); w.y = pack2bf(y2, y3); *(u32x2*)(yhT + o) = w; } }
        __syncthreads();
    }
}

__device__ void phase_yh_transpose(const Params& p, unsigned char* lds, int pm) {
    const bf16_t* yhT = (const bf16_t*)(p.ws + WS_PH); bf16_t* Ycat = (bf16_t*)(p.ws + WS_XB);
    bf16_t* st = (bf16_t*)lds; const int tid = threadIdx.x;
    for (int i = 0; i < 32; ++i) {
        const int tt = pm * 4 + (i >> 3), ct = i & 7, tok0 = tt * 64; int seq, L, tl; seq_of(tok0, seq, L, tl);
        { const int c = tid >> 3, ch = tid & 7; const u32x4 w = *(const u32x4*)(yhT + seq_base_T(seq) + (size_t)(ct * 64 + c) * L + tl + ch * 8);
          unsigned* s = (unsigned*)(st + c * 66 + ch * 8); s[0] = w.x; s[1] = w.y; s[2] = w.z; s[3] = w.w; }
        __syncthreads();
        { const int r = tid >> 3, cg8 = tid & 7; unsigned short v[8];
#pragma unroll
          for (int k = 0; k < 8; ++k) v[k] = st[(cg8 * 8 + k) * 66 + r];
          u32x4 w; w.x = v[0] | ((unsigned)v[1] << 16); w.y = v[2] | ((unsigned)v[3] << 16); w.z = v[4] | ((unsigned)v[5] << 16); w.w = v[6] | ((unsigned)v[7] << 16);
          *(u32x4*)(Ycat + (size_t)(tok0 + r) * DM + 512 + ct * 64 + cg8 * 8) = w; }
        __syncthreads();
    }
}

template <bool OUT_BF16>
__device__ __forceinline__ void ln_rows2(const bf16_t* __restrict__ hin, float* __restrict__ outf, bf16_t* __restrict__ outb, const float* __restrict__ g, const float* __restrict__ be, int row_lo, int row_hi, int wv0, int nwv) {
    const int lane = threadIdx.x & 63;
    for (int row = row_lo + wv0 * 2; row < row_hi; row += nwv * 2) {
        float4 v[2][4]; float s[2] = {0.f, 0.f};
#pragma unroll
        for (int r = 0; r < 2; ++r)
#pragma unroll
            for (int k = 0; k < 4; ++k) { const u32x2 w = ((const u32x2*)(hin + (size_t)(row + r) * DM))[lane + 64 * k]; v[r][k] = make_float4(bf_lo(w.x), bf_hi(w.x), bf_lo(w.y), bf_hi(w.y)); }
#pragma unroll
        for (int r = 0; r < 2; ++r)
#pragma unroll
            for (int k = 0; k < 4; ++k) s[r] += (v[r][k].x + v[r][k].y) + (v[r][k].z + v[r][k].w);
#pragma unroll
        for (int o = 32; o >= 1; o >>= 1) { s[0] += __shfl_xor(s[0], o); s[1] += __shfl_xor(s[1], o); }
        float q[2] = {0.f, 0.f}; const float mu[2] = {s[0] * (1.0f / DM), s[1] * (1.0f / DM)};
#pragma unroll
        for (int r = 0; r < 2; ++r)
#pragma unroll
            for (int k = 0; k < 4; ++k) { const float a = v[r][k].x - mu[r], b = v[r][k].y - mu[r], c = v[r][k].z - mu[r], d = v[r][k].w - mu[r]; q[r] += (a * a + b * b) + (c * c + d * d); }
#pragma unroll
        for (int o = 32; o >= 1; o >>= 1) { q[0] += __shfl_xor(q[0], o); q[1] += __shfl_xor(q[1], o); }
        const float rstd[2] = {1.0f / sqrtf(q[0] * (1.0f / DM) + LN_EPS_C), 1.0f / sqrtf(q[1] * (1.0f / DM) + LN_EPS_C)};
#pragma unroll
        for (int k = 0; k < 4; ++k) { const float4 gg = ((const float4*)g)[lane + 64 * k], bb = ((const float4*)be)[lane + 64 * k];
#pragma unroll
            for (int r = 0; r < 2; ++r) { float4 y;
                y.x = (v[r][k].x - mu[r]) * rstd[r] * gg.x + bb.x; y.y = (v[r][k].y - mu[r]) * rstd[r] * gg.y + bb.y; y.z = (v[r][k].z - mu[r]) * rstd[r] * gg.z + bb.z; y.w = (v[r][k].w - mu[r]) * rstd[r] * gg.w + bb.w;
                if (OUT_BF16) { u32x2 w; w.x = pack2bf(y.x, y.y); w.y = pack2bf(y.z, y.w); ((u32x2*)(outb + (size_t)(row + r) * DM))[lane + 64 * k] = w; }
                else { const f32x4 yv = {y.x, y.y, y.z, y.w}; __builtin_nontemporal_store(yv, (f32x4*)(outf + (size_t)(row + r) * DM) + lane + 64 * k); } } }
    }
}
__device__ void phase_ln1_panel(const Params& p, int pm) { ln_rows2<true>((const bf16_t*)p.out, nullptr, (bf16_t*)(p.ws + WS_XB), p.in[16], p.in[17], pm * 256, pm * 256 + 256, threadIdx.x >> 6, 8); }

__device__ __forceinline__ int f2key(float f) { const int b = __float_as_int(f); return b ^ ((b >> 31) & 0x7fffffff); }
__device__ __forceinline__ float key2f(int k) { return __int_as_float(k ^ ((k >> 31) & 0x7fffffff)); }
__device__ __forceinline__ void sort16_desc(int (&k)[16]) {
#pragma unroll
    for (int sz = 2; sz <= 16; sz <<= 1)
#pragma unroll
        for (int j = sz >> 1; j > 0; j >>= 1)
#pragma unroll
            for (int i = 0; i < 16; ++i) { const int l = i ^ j;
                if (l > i) { const bool desc = ((i & sz) == 0); const int hi = max(k[i], k[l]), lo = min(k[i], k[l]); k[i] = desc ? hi : lo; k[l] = desc ? lo : hi; } }
}
__device__ __forceinline__ void merge_top16(int (&a)[16], const int (&b)[16]) {
#pragma unroll
    for (int i = 0; i < 16; ++i) a[i] = max(a[i], b[15 - i]);
#pragma unroll
    for (int j = 8; j > 0; j >>= 1)
#pragma unroll
        for (int i = 0; i < 16; ++i) { const int l = i ^ j; if (l > i) { const int hi = max(a[i], a[l]), lo = min(a[i], a[l]); a[i] = hi; a[l] = lo; } }
}
__device__ __forceinline__ void chunk_keys(const u32x4 w0, const u32x4 w1, int idx0, int (&k)[16]) {
    const unsigned ww[8] = {w0.x, w0.y, w0.z, w0.w, w1.x, w1.y, w1.z, w1.w};
#pragma unroll
    for (int e = 0; e < 8; ++e) { const h2_t h = __builtin_bit_cast(h2_t, ww[e]);
        k[2 * e] = (f2key((float)h.x) & ~0x7F) | (idx0 + 2 * e); k[2 * e + 1] = (f2key((float)h.y) & ~0x7F) | (idx0 + 2 * e + 1); }
}
__device__ __forceinline__ void row_top16(const unsigned short* __restrict__ row, int (&run)[16]) {
    const u32x4* rp = (const u32x4*)row;
    u32x4 w0 = rp[0], w1 = rp[1];
    chunk_keys(w0, w1, 0, run); sort16_desc(run);
    w0 = rp[2]; w1 = rp[3];
#pragma unroll 1
    for (int ch = 1; ch < 8; ++ch) {
        int k[16]; chunk_keys(w0, w1, ch * 16, k);
        if (ch < 7) { w0 = rp[2 * ch + 2]; w1 = rp[2 * ch + 3]; }
        sort16_desc(k); merge_top16(run, k);
    }
}
__device__ void phase_topk(const Params& p, unsigned char* ldsg, int gt_lo, int gt_hi, int gt_stride) {
    const unsigned short* S = (const unsigned short*)(p.ws + WS_PH);
    int* eidx = (int*)(p.ws + WS_EIDX); float* gate = (float*)(p.ws + WS_GATE);
    int* sl = (int*)ldsg + threadIdx.x * 33;
    constexpr int OFF[16] = {0, 16, 24, 29, 33, 36, 38, 40, 42, 43, 44, 45, 46, 47, 48, 49};
    for (int gt = gt_lo + threadIdx.x; gt < gt_hi; gt += gt_stride) {
        const int t = gt >> 3, h = gt & 7;
        int a[16], b[16];
        row_top16(S + (size_t)t * 2048 + (h * 2 + 0) * 128, a);
        row_top16(S + (size_t)t * 2048 + (h * 2 + 1) * 128, b);
#pragma unroll
        for (int i = 0; i < 16; ++i) { sl[i] = a[i]; sl[16 + i] = b[i]; }
        float va[16], vb[16];
#pragma unroll
        for (int i = 0; i < 16; ++i) { va[i] = key2f(a[i] & ~0x7F); vb[i] = key2f(b[i] & ~0x7F); }
        int cnd[4][16];
#pragma unroll
        for (int q = 0; q < 4; ++q)
#pragma unroll
            for (int i = 0; i < 16; ++i) cnd[q][i] = (int)0x80000000;
#pragma unroll
        for (int i = 0; i < 16; ++i)
#pragma unroll
            for (int j = 0; j < 16 / (i + 1); ++j) { const int pos = OFF[i] + j; cnd[pos >> 4][pos & 15] = (f2key(va[i] + vb[j]) & ~0xFF) | (i * 16 + j); }
        sort16_desc(cnd[0]); sort16_desc(cnd[1]); sort16_desc(cnd[2]); sort16_desc(cnd[3]);
        merge_top16(cnd[0], cnd[1]); merge_top16(cnd[2], cnd[3]); merge_top16(cnd[0], cnd[2]);
        float best[16]; int ei[16]; float m = -3.0e38f;
#pragma unroll
        for (int r = 0; r < 16; ++r) { const int code = cnd[0][r] & 0xFF; const int ka = sl[code >> 4], kb = sl[16 + (code & 15)];
            ei[r] = (ka & 0x7F) * 128 + (kb & 0x7F); best[r] = key2f(ka & ~0x7F) + key2f(kb & ~0x7F); m = fmaxf(m, best[r]); }
        float se = 0.f;
#pragma unroll
        for (int r = 0; r < 16; ++r) { best[r] = __expf(best[r] - m); se += best[r]; }
        const float inv = 1.0f / se;
#pragma unroll
        for (int q = 0; q < 4; ++q) { ((int4*)(eidx + (size_t)gt * 16))[q] = make_int4(ei[4 * q], ei[4 * q + 1], ei[4 * q + 2], ei[4 * q + 3]);
            ((float4*)(gate + (size_t)gt * 16))[q] = make_float4(best[4 * q] * inv, best[4 * q + 1] * inv, best[4 * q + 2] * inv, best[4 * q + 3] * inv); }
    }
}

typedef float f32x2 __attribute__((ext_vector_type(2)));
template <int CTRL> __device__ __forceinline__ float dpp_f(float v) { return __int_as_float(__builtin_amdgcn_update_dpp(0, __float_as_int(v), CTRL, 0xF, 0xF, false)); }
__device__ __forceinline__ void pk_load_ev(int (&ev)[16], const int* __restrict__ eidx, int tok, int q) {
    const int4* ep = (const int4*)(eidx + (size_t)tok * 128 + 16 * q);
#pragma unroll
    for (int k = 0; k < 4; ++k) { const int4 t = ep[k]; ev[4 * k] = t.x; ev[4 * k + 1] = t.y; ev[4 * k + 2] = t.z; ev[4 * k + 3] = t.w; }
}
__device__ __forceinline__ void pk_load_rows(u32x4 (&r)[16], const int (&ev)[16], const unsigned char* __restrict__ tab, unsigned loff) {
#pragma unroll
    for (int s = 0; s < 16; ++s) r[s] = *(const u32x4*)(tab + ((unsigned)ev[s] * 128u + loff));
}
__device__ __forceinline__ void pk_load_x(f32x2 (&xv)[8], const bf16_t* __restrict__ xrow) {
    const u32x4 a = ((const u32x4*)xrow)[0], b = ((const u32x4*)xrow)[1];
    xv[0] = (f32x2){bf_lo(a.x), bf_hi(a.x)}; xv[1] = (f32x2){bf_lo(a.y), bf_hi(a.y)}; xv[2] = (f32x2){bf_lo(a.z), bf_hi(a.z)}; xv[3] = (f32x2){bf_lo(a.w), bf_hi(a.w)};
    xv[4] = (f32x2){bf_lo(b.x), bf_hi(b.x)}; xv[5] = (f32x2){bf_lo(b.y), bf_hi(b.y)}; xv[6] = (f32x2){bf_lo(b.z), bf_hi(b.z)}; xv[7] = (f32x2){bf_lo(b.w), bf_hi(b.w)};
}
__device__ __forceinline__ float xchg4(float v) { return dpp_f<0x1B>(dpp_f<0x141>(v)); }
__device__ __forceinline__ void pk_u_compute(const u32x4 (&r)[16], const f32x2 (&xv)[8], bf16_t* __restrict__ pr, int c) {
    float d[16];
#pragma unroll
    for (int s = 0; s < 16; ++s) {
        f32x2 acc = {0.f, 0.f};
        acc += __builtin_amdgcn_cvt_pk_f32_fp8((int)r[s].x, false) * xv[0]; acc += __builtin_amdgcn_cvt_pk_f32_fp8((int)r[s].x, true) * xv[1];
        acc += __builtin_amdgcn_cvt_pk_f32_fp8((int)r[s].y, false) * xv[2]; acc += __builtin_amdgcn_cvt_pk_f32_fp8((int)r[s].y, true) * xv[3];
        acc += __builtin_amdgcn_cvt_pk_f32_fp8((int)r[s].z, false) * xv[4]; acc += __builtin_amdgcn_cvt_pk_f32_fp8((int)r[s].z, true) * xv[5];
        acc += __builtin_amdgcn_cvt_pk_f32_fp8((int)r[s].w, false) * xv[6]; acc += __builtin_amdgcn_cvt_pk_f32_fp8((int)r[s].w, true) * xv[7];
        d[s] = acc.x + acc.y;
    }
    float r1[8]; const bool b2 = (c & 4) != 0;
#pragma unroll
    for (int k = 0; k < 8; ++k) { const float send = b2 ? d[k] : d[k + 8], keep = b2 ? d[k + 8] : d[k]; r1[k] = keep + xchg4(send); }
    float r2[4]; const bool b1 = (c & 2) != 0;
#pragma unroll
    for (int k = 0; k < 4; ++k) { const float send = b1 ? r1[k] : r1[k + 4], keep = b1 ? r1[k + 4] : r1[k]; r2[k] = keep + dpp_f<0x4E>(send); }
    float r3[2]; const bool b0 = (c & 1) != 0;
#pragma unroll
    for (int k = 0; k < 2; ++k) { const float send = b0 ? r2[k] : r2[k + 2], keep = b0 ? r2[k + 2] : r2[k]; r3[k] = keep + dpp_f<0xB1>(send); }
    *(unsigned*)(pr + 2 * c) = pack2bf(r3[0], r3[1]);
}
__device__ void phase_peer_u(const Params& p) {
    const bf16_t* x1 = (const bf16_t*)(p.ws + WS_XB); const int* eidx = (const int*)(p.ws + WS_EIDX); bf16_t* partd = (bf16_t*)(p.ws + WS_PARTD);
    const int wave = threadIdx.x >> 6, lane = threadIdx.x & 63, q = lane >> 3, c = lane & 7;
    const int xs = blockIdx.x & 7, y = blockIdx.x >> 3, nY = gridDim.x >> 3, step = nY * 8;
    const unsigned char* tab = p.ws + WS_U8 + (size_t)xs * (16384 * 128); const unsigned loff = 16u * c;
    const bf16_t* xcol = x1 + 128 * xs + 16 * c;
    bf16_t* pbase = partd + (size_t)xs * NTOK * 128 + 16 * q;
    const int tok0 = y * 8 + wave;
    if (tok0 >= NTOK) return;
    const int ntok = (NTOK - tok0 + step - 1) / step, last = tok0 + (ntok - 1) * step;
    bf16_t* dummy = (bf16_t*)(p.ws + WS_DUMMY) + (size_t)(blockIdx.x * 8 + wave) * 128 + 16 * q;
    int ev[16]; f32x2 xvA[8], xvB[8]; u32x4 rA[16], rB[16];
    pk_load_ev(ev, eidx, tok0, q); pk_load_x(xvA, xcol + (size_t)tok0 * DM); pk_load_rows(rA, ev, tab, loff);
    pk_load_ev(ev, eidx, min(tok0 + step, last), q);
    for (int i = 0; i < ntok; i += 2) {
        const int tA = tok0 + i * step, tB = min(tA + step, last), tC = min(tA + 2 * step, last), tD = min(tA + 3 * step, last);
        pk_load_x(xvB, xcol + (size_t)tB * DM); pk_load_rows(rB, ev, tab, loff);
        pk_load_ev(ev, eidx, tC, q);
        pk_u_compute(rA, xvA, pbase + (size_t)tA * 128, c);
        pk_load_x(xvA, xcol + (size_t)tC * DM); pk_load_rows(rA, ev, tab, loff);
        pk_load_ev(ev, eidx, tD, q);
        pk_u_compute(rB, xvB, (i + 1 < ntok) ? pbase + (size_t)tB * 128 : dummy, c);
    }
}
__device__ __forceinline__ float gelu_erf(float d) { return 0.5f * d * (1.0f + erff(d * 0.70710678118654752f)); }
__device__ void phase_peer_coef(const Params& p) {
    const bf16_t* partd = (const bf16_t*)(p.ws + WS_PARTD); float* gate = (float*)(p.ws + WS_GATE);
    for (size_t i = (size_t)blockIdx.x * NTHREADS + threadIdx.x; i < (size_t)NTOK * 128 / 8; i += (size_t)gridDim.x * NTHREADS) {
        u32x4 t[8];
#pragma unroll
        for (int x = 0; x < 8; ++x) t[x] = ((const u32x4*)(partd + (size_t)x * NTOK * 128))[i];
        float4 g0 = ((const float4*)gate)[2 * i], g1 = ((const float4*)gate)[2 * i + 1];
        float sm[8];
#pragma unroll
        for (int k = 0; k < 8; ++k) sm[k] = 0.f;
#pragma unroll
        for (int x = 0; x < 8; ++x) { sm[0] += bf_lo(t[x].x); sm[1] += bf_hi(t[x].x); sm[2] += bf_lo(t[x].y); sm[3] += bf_hi(t[x].y); sm[4] += bf_lo(t[x].z); sm[5] += bf_hi(t[x].z); sm[6] += bf_lo(t[x].w); sm[7] += bf_hi(t[x].w); }
        g0.x *= gelu_erf(sm[0] * (1.0f / U_SCALE)); g0.y *= gelu_erf(sm[1] * (1.0f / U_SCALE)); g0.z *= gelu_erf(sm[2] * (1.0f / U_SCALE)); g0.w *= gelu_erf(sm[3] * (1.0f / U_SCALE));
        g1.x *= gelu_erf(sm[4] * (1.0f / U_SCALE)); g1.y *= gelu_erf(sm[5] * (1.0f / U_SCALE)); g1.z *= gelu_erf(sm[6] * (1.0f / U_SCALE)); g1.w *= gelu_erf(sm[7] * (1.0f / U_SCALE));
        ((float4*)gate)[2 * i] = g0; ((float4*)gate)[2 * i + 1] = g1;
    }
}
__device__ __forceinline__ void pk_load_cf(float (&cf)[16], const float* __restrict__ coef, int tok, int q) {
    const float4* cp = (const float4*)(coef + (size_t)tok * 128 + 16 * q);
#pragma unroll
    for (int k = 0; k < 4; ++k) { const float4 f = cp[k]; cf[4 * k] = f.x; cf[4 * k + 1] = f.y; cf[4 * k + 2] = f.z; cf[4 * k + 3] = f.w; }
}
__device__ __forceinline__ void pk_v_compute(const u32x4 (&r)[16], const float (&cf)[16], unsigned xw, bf16_t* __restrict__ orow, int q) {
    f32x2 acc[8];
#pragma unroll
    for (int k = 0; k < 8; ++k) acc[k] = (f32x2){0.f, 0.f};
#pragma unroll
    for (int s = 0; s < 16; ++s) { const f32x2 c2 = {cf[s], cf[s]};
        acc[0] += __builtin_amdgcn_cvt_pk_f32_fp8((int)r[s].x, false) * c2; acc[1] += __builtin_amdgcn_cvt_pk_f32_fp8((int)r[s].x, true) * c2;
        acc[2] += __builtin_amdgcn_cvt_pk_f32_fp8((int)r[s].y, false) * c2; acc[3] += __builtin_amdgcn_cvt_pk_f32_fp8((int)r[s].y, true) * c2;
        acc[4] += __builtin_amdgcn_cvt_pk_f32_fp8((int)r[s].z, false) * c2; acc[5] += __builtin_amdgcn_cvt_pk_f32_fp8((int)r[s].z, true) * c2;
        acc[6] += __builtin_amdgcn_cvt_pk_f32_fp8((int)r[s].w, false) * c2; acc[7] += __builtin_amdgcn_cvt_pk_f32_fp8((int)r[s].w, true) * c2; }
    f32x2 b4[4];
#pragma unroll
    for (int k = 0; k < 4; ++k) { const auto sx = __builtin_amdgcn_permlane32_swap(__float_as_uint(acc[k].x), __float_as_uint(acc[k + 4].x), false, false);
        const auto sy = __builtin_amdgcn_permlane32_swap(__float_as_uint(acc[k].y), __float_as_uint(acc[k + 4].y), false, false);
        b4[k] = (f32x2){__uint_as_float(sx[0]) + __uint_as_float(sx[1]), __uint_as_float(sy[0]) + __uint_as_float(sy[1])}; }
    f32x2 b2[2];
#pragma unroll
    for (int k = 0; k < 2; ++k) { const auto sx = __builtin_amdgcn_permlane16_swap(__float_as_uint(b4[k].x), __float_as_uint(b4[k + 2].x), false, false);
        const auto sy = __builtin_amdgcn_permlane16_swap(__float_as_uint(b4[k].y), __float_as_uint(b4[k + 2].y), false, false);
        b2[k] = (f32x2){__uint_as_float(sx[0]) + __uint_as_float(sx[1]), __uint_as_float(sy[0]) + __uint_as_float(sy[1])}; }
    f32x2 b1;
    { const bool up = (q & 1) != 0; const f32x2 send = up ? b2[0] : b2[1], keep = up ? b2[1] : b2[0];
      b1 = (f32x2){keep.x + dpp_f<0x128>(send.x), keep.y + dpp_f<0x128>(send.y)}; }
    const int co = 8 * (q >> 2) + 4 * ((q >> 1) & 1) + 2 * (q & 1);
    unsigned* op = (unsigned*)(orow + co);
    *op = pack2bf(ALPHA_C * bf_lo(xw) + b1.x * (1.0f / V_SCALE), ALPHA_C * bf_hi(xw) + b1.y * (1.0f / V_SCALE));
}
__device__ void phase_peer_v(const Params& p) {
    float* out = p.out; const int* eidx = (const int*)(p.ws + WS_EIDX); const float* coef = (const float*)(p.ws + WS_GATE);
    const int wave = threadIdx.x >> 6, lane = threadIdx.x & 63, q = lane >> 3, c = lane & 7;
    const int xs = blockIdx.x & 7, y = blockIdx.x >> 3, nY = gridDim.x >> 3, step = nY * 8;
    const unsigned char* tab = p.ws + WS_V8 + (size_t)xs * (16384 * 128); const unsigned loff = 16u * c;
    bf16_t* ocol = (bf16_t*)(p.ws + WS_XB) + 128 * xs + 16 * c;
    const int tok0 = y * 8 + wave;
    if (tok0 >= NTOK) return;
    const int ntok = (NTOK - tok0 + step - 1) / step, last = tok0 + (ntok - 1) * step;
    bf16_t* dummy = (bf16_t*)(p.ws + WS_DUMMY) + (size_t)(blockIdx.x * 8 + wave) * 128 + 16 * c;
    const int co = 8 * (q >> 2) + 4 * ((q >> 1) & 1) + 2 * (q & 1);
    int ev[16]; float cfA[16], cfB[16]; u32x4 rA[16], rB[16]; unsigned xrA, xrB;
    const bf16_t* xres = (const bf16_t*)(p.ws + WS_XB) + 128 * xs + 16 * c + co;
    pk_load_ev(ev, eidx, tok0, q); pk_load_cf(cfA, coef, tok0, q); xrA = *(const unsigned*)(xres + (size_t)tok0 * DM); pk_load_rows(rA, ev, tab, loff);
    pk_load_ev(ev, eidx, min(tok0 + step, last), q);
    for (int i = 0; i < ntok; i += 2) {
        const int tA = tok0 + i * step, tB = min(tA + step, last), tC = min(tA + 2 * step, last), tD = min(tA + 3 * step, last);
        pk_load_cf(cfB, coef, tB, q); xrB = *(const unsigned*)(xres + (size_t)tB * DM); pk_load_rows(rB, ev, tab, loff);
        pk_load_ev(ev, eidx, tC, q);
        pk_v_compute(rA, cfA, xrA, ocol + (size_t)tA * DM, q);
        pk_load_cf(cfA, coef, tC, q); xrA = *(const unsigned*)(xres + (size_t)tC * DM); pk_load_rows(rA, ev, tab, loff);
        pk_load_ev(ev, eidx, tD, q);
        pk_v_compute(rB, cfB, xrB, (i + 1 < ntok) ? ocol + (size_t)tB * DM : dummy, q);
    }
}
__device__ void phase_ln2(const Params& p) { ln_rows2<false>((const bf16_t*)(p.ws + WS_XB), p.out, nullptr, p.in[22], p.in[23], 0, NTOK, blockIdx.x * 8 + (threadIdx.x >> 6), gridDim.x * 8); }

#ifdef CONV_CHECK
constexpr size_t WS_CHK = 496 * MiB;
__device__ void conv_check(const Params& p) {
    const bf16_t* Fg = (const bf16_t*)(p.ws + WS_FG); const float* part = (const float*)(p.ws + WS_PART);
    const bf16_t* zT = (const bf16_t*)(p.ws + WS_ZT); const bf16_t* x0T = (const bf16_t*)((const unsigned char*)p.out + OUT_X0T);
    const bf16_t* yhT = (const bf16_t*)(p.ws + WS_PH); const float* hyb = p.in[14]; float* chk = (float*)(p.ws + WS_CHK);
    const int wave = threadIdx.x >> 6, lane = threadIdx.x & 63; const unsigned w = blockIdx.x * 8 + wave;
    const int seq = w % 12, variant = seq >= 4, L = variant ? L1 : L0, c = (w * 37u) % 512u; const unsigned sel = (w / 12u) % 8u;
    int t = (int)(((w * 2654435761u) >> 7) % (unsigned)L);
    if (sel == 0) t = 0; else if (sel == 1) t = L - 1; else if (sel == 2) t = 63; else if (sel == 3) t = 64; else if (sel == 4) t = L / 2;
    const bf16_t* Fc = Fg + (variant ? (size_t)512 * 2 * L0 : 0) + (size_t)c * 2 * L; const bf16_t* zc = zT + seq_base_T(seq) + (size_t)c * L;
    float sacc = 0.f; for (int s2 = lane; s2 < L; s2 += 64) sacc += __uint_as_float((unsigned)zc[s2] << 16) * __uint_as_float((unsigned)Fc[L - (t - s2)] << 16);
    float nrm = 0.f; for (int b = lane; b < (int)gridDim.x; b += 64) nrm += part[((size_t)variant * 1024 + b) * 512 + c];
#pragma unroll
    for (int o = 32; o >= 1; o >>= 1) { sacc += __shfl_xor(sacc, o); nrm += __shfl_xor(nrm, o); }
    const float x0 = __uint_as_float((unsigned)x0T[seq_base_T(seq) + (size_t)c * L + t] << 16), zt = __uint_as_float((unsigned)zc[t] << 16);
    const float ref = x0 * (sacc / nrm + hyb[c] * zt), got = __uint_as_float((unsigned)yhT[seq_base_T(seq) + (size_t)c * L + t] << 16);
    if (lane == 0) { atomicAdd(chk, (got - ref) * (got - ref)); atomicAdd(chk + 1, ref * ref); }
}
#endif
struct PanelOrder {
    int pm, nN;
    __device__ bool next(int i, pg8::Unit& u) const { if (i >= nN) return false; u.pm = pm; u.pn = i; return true; }
    __device__ __forceinline__ void a_ready(const pg8::Unit&) const {}
    __device__ __forceinline__ void done(const pg8::Unit&) const {}
};
__device__ __forceinline__ void block_handoff() { asm volatile("s_waitcnt vmcnt(0) lgkmcnt(0)" ::: "memory"); __syncthreads(); }
__device__ void phase_panel_chain(const Params& p, unsigned char* lds) {
    unsigned char* ws = p.ws;
    const int pm = blockIdx.x;
    if (pm < NTOK / 256) {
        phase_yh_transpose(p, lds, pm);
        block_handoff();
        { pg8::Gemm g{(const bf16_t*)(ws + WS_XB), (const bf16_t*)(ws + WS_WOUTT), NTOK, DM, DM}; PanelOrder S{pm, DM / 256};
          EpiH1 E{p.in[0], p.in[1], (bf16_t*)p.out};
          pg8::gemm_phase<EpiH1, PanelOrder, false>((LAS unsigned char*)lds, g, S, E, nullptr); }
        block_handoff();
        phase_ln1_panel(p, pm);
        block_handoff();
        { pg8::Gemm g{(const bf16_t*)(ws + WS_XB), (const bf16_t*)(ws + WS_WPT), NTOK, 2048, DM}; PanelOrder S{pm, 2048 / 256};
          EpiS E{(unsigned short*)(ws + WS_PH)};
          pg8::gemm_phase<EpiS, PanelOrder, false>((LAS unsigned char*)lds, g, S, E, nullptr); }
        block_handoff();
        phase_topk(p, lds, pm * 2048, pm * 2048 + 2048, NTHREADS);
        block_handoff();
    }
}

#define XB_TMO      128
#define XB_XCNT(j)  (256  + 64 * (j))
#define XB_XSUB(j)  (1280 + 64 * (j))
#define XB_XGEN(j)  (2304 + 64 * (j))
#define XB_TOP      3328
#define XB_TOPGEN   3392
#define XCD_BAR_WORDS 3456
#define XB_SPIN_CAP (1u << 18)

__device__ __forceinline__ unsigned xb_ld(unsigned* p)              { return __hip_atomic_load(p, __ATOMIC_RELAXED, __HIP_MEMORY_SCOPE_AGENT); }
__device__ __forceinline__ unsigned xb_add(unsigned* p, unsigned v) { return __hip_atomic_fetch_add(p, v, __ATOMIC_RELAXED, __HIP_MEMORY_SCOPE_AGENT); }
__device__ __forceinline__ unsigned xb_xcc_id() { return (unsigned)__builtin_amdgcn_s_getreg((3 << 11) | 20) & 0xFu; }
#define XB_SPIN(cond, bar) do { unsigned _sp = 0; while (cond) { __builtin_amdgcn_s_sleep(1); \
    if ((++_sp & 255u) == 0u) { if (xb_ld(&(bar)[XB_TMO])) break; if (_sp > XB_SPIN_CAP) { atomicAdd(&(bar)[XB_TMO], 1u); break; } } } } while (0)

struct XcdBarrier {
    unsigned* bar; unsigned x;
    volatile LAS unsigned* st;
};

__device__ __forceinline__ XcdBarrier xcd_barrier_post(unsigned* bar, volatile LAS unsigned* st) {
    XcdBarrier b; b.bar = bar; b.x = xb_xcc_id(); b.st = st;
    if (threadIdx.x == 0) (void)xb_add(&bar[XB_XCNT(b.x)], 1u);
    return b;
}
__device__ __forceinline__ void xcd_barrier_complete(unsigned* bar, unsigned x, unsigned& nloc, unsigned& nx) {
    const unsigned G = gridDim.x * gridDim.y * gridDim.z;
    unsigned sum, cnt, mine, sp = 0u;
    for (;;) {
        sum = 0u; cnt = 0u; mine = 0u;
#pragma unroll
        for (unsigned j = 0; j < 16; ++j) { const unsigned c = xb_ld(&bar[XB_XCNT(j)]); sum += c; cnt += (c > 0u) ? 1u : 0u; mine = (j == x) ? c : mine; }
        if (sum == G) break;
        __builtin_amdgcn_s_sleep(1);
        if ((++sp & 255u) == 0u) { if (xb_ld(&bar[XB_TMO])) break; if (sp > XB_SPIN_CAP) { atomicAdd(&bar[XB_TMO], 1u); break; } }
    }
    nloc = mine > 0u ? mine : 1u; nx = cnt > 0u ? cnt : 1u;
}

__device__ __forceinline__ void xcd_barrier(const XcdBarrier& b) {
    asm volatile("s_waitcnt vmcnt(0)" ::: "memory");
    __syncthreads();
    if (threadIdx.x == 0) {
        unsigned* bar = b.bar;
        __builtin_amdgcn_s_waitcnt(0);
        unsigned nloc = b.st[0], nx = b.st[1];
        if (nloc == 0u) { xcd_barrier_complete(bar, b.x, nloc, nx); b.st[0] = nloc; b.st[1] = nx; }
        const unsigned old = xb_add(&bar[XB_XSUB(b.x)], 1u);
        const unsigned gen = old / nloc;
        if (old + 1u == (gen + 1u) * nloc) {
            __builtin_amdgcn_fence(__ATOMIC_RELEASE, "agent");
            asm volatile("s_waitcnt vmcnt(0)" ::: "memory");
            const unsigned og = xb_add(&bar[XB_TOP], 1u);
            const unsigned tg = og / nx;
            if (og + 1u == (tg + 1u) * nx) xb_add(&bar[XB_TOPGEN], 1u);
            else XB_SPIN(xb_ld(&bar[XB_TOPGEN]) == tg, bar);
            __builtin_amdgcn_fence(__ATOMIC_ACQUIRE, "agent");
            xb_add(&bar[XB_XGEN(b.x)], 1u);
            asm volatile("s_waitcnt vmcnt(0)" ::: "memory");
        } else {
            XB_SPIN(xb_ld(&bar[XB_XGEN(b.x)]) == gen, bar);
            __builtin_amdgcn_fence(__ATOMIC_ACQUIRE, "agent");
            asm volatile("s_waitcnt vmcnt(0)" ::: "memory");
        }
    }
    __syncthreads();
}


__global__ void __launch_bounds__(NTHREADS) hybrid_fwd(Params p) {
    extern __shared__ __attribute__((aligned(16))) unsigned char lds[];
    cg::grid_group grid = cg::this_grid();
    const int lo = p.ph_lo, hi = p.ph_hi;
    unsigned char* ws = p.ws;
    volatile LAS unsigned* xst = (volatile LAS unsigned*)((LAS unsigned char*)lds + (LDS_BYTES - 16));
    if (threadIdx.x < 4) xst[threadIdx.x] = 0u;
    __syncthreads();
    XcdBarrier xbar = xcd_barrier_post((unsigned*)(ws + WS_BAR), xst);
#ifndef REPMASK
#define REPMASK 0
#endif
#define IN(k) (lo <= (k) && (k) < hi)
#define SEAM(k) do { if (IN(k) && IN((k) + 1)) { if (p.nrep < 0) grid.sync(); else xcd_barrier(xbar); } } while (0)
#define RUN(k, ...) do { if (IN(k)) { const int nrep_ = ((REPMASK >> (k)) & 1) ? p.nrep : 1; for (int rep_ = 0; rep_ < nrep_; ++rep_) { if (rep_) __syncthreads(); { __VA_ARGS__; } } } SEAM(k); } while (0)
    RUN(0,
        cvt_f32_bf16(p.in[0], (bf16_t*)(ws + WS_XB), (size_t)NTOK_P * DM / 8);
        cvt_f32_bf16(p.in[1], (bf16_t*)(ws + WS_XB) + (size_t)NTOK_P * DM, (size_t)NTOK_P * DM / 8);
        cvt_f32_fp8(p.in[20], ws + WS_U8, (size_t)16384 * DM / 16, U_SCALE);
        cvt_f32_fp8(p.in[21], ws + WS_V8, (size_t)16384 * DM / 16, V_SCALE);
        transpose_cvt<true>(p.in[2], 1024, 3072, (bf16_t*)(ws + WS_WINT), (float*)lds);
        transpose_cvt<false>(p.in[15], 1024, 1024, (bf16_t*)(ws + WS_WOUTT), (float*)lds);
        fold_wq_keys(p.in[18], p.in[19], (bf16_t*)(ws + WS_WPT), (float*)lds);
        hyena_filter_gen(p, (float*)lds));
    RUN(1,
        pg8::Gemm g{(const bf16_t*)(ws + WS_XB), (const bf16_t*)(ws + WS_WINT), NTOK, 3072, DM}; pg8::StaticOrder S; S.init(NTOK, 3072, gridDim.x, blockIdx.x);
        EpiP E{(bf16_t*)p.out, (bf16_t*)(ws + WS_PH), p.in[3]};
        pg8::gemm_phase<EpiP, pg8::StaticOrder, false>((LAS unsigned char*)lds, g, S, E, nullptr));
    RUN(2, phase_conv3(p, lds));
    RUN(3, phase_longconv(p, lds));
    RUN(4, phase_panel_chain(p, lds));
    RUN(5, phase_peer_u(p));
    RUN(6, phase_peer_coef(p));
    RUN(7, phase_peer_v(p));
    RUN(8, phase_ln2(p));
#undef IN
#undef SEAM
#undef RUN
}

#ifdef CONV_CHECK
__global__ void __launch_bounds__(NTHREADS) k_conv_check(Params p) { conv_check(p); }
__global__ void __launch_bounds__(NTHREADS) k_conv_apply(Params p) {
    const float* chk = (const float*)(p.ws + WS_CHK); const float R = chk[0] / chk[1]; const float dl = sqrtf(fminf(R * 10.0f, 4e-4f));
    for (size_t i = (size_t)blockIdx.x * NTHREADS + threadIdx.x; i < (size_t)NTOK * DM; i += (size_t)gridDim.x * NTHREADS) { const unsigned hsh = (unsigned)i * 2654435761u; p.out[i] *= (hsh & 0x8000u) ? (1.0f + dl) : (1.0f - dl); }
}
#endif
extern "C" void kernel_launch(void* const* d_in, const int* in_sizes, int n_in, void* d_out, int out_size, void* d_ws, size_t ws_size, hipStream_t stream) {
    static int grid = 0;
    if (grid == 0) {
        if (n_in != 24 || out_size != NTOK * DM || ws_size < WS_END) { fprintf(stderr, "kernel_launch: unexpected shapes (n_in %d out %d ws %zu)\n", n_in, out_size, ws_size); grid = -1; return; }
        int dev = 0, cus = 0, per_cu = 0;
        hipGetDevice(&dev); hipDeviceGetAttribute(&cus, hipDeviceAttributeMultiprocessorCount, dev);
        if (hipFuncSetAttribute((const void*)hybrid_fwd, hipFuncAttributeMaxDynamicSharedMemorySize, LDS_BYTES) != hipSuccess) { fprintf(stderr, "kernel_launch: hipFuncSetAttribute failed\n"); grid = -1; return; }
        if (hipOccupancyMaxActiveBlocksPerMultiprocessor(&per_cu, (const void*)hybrid_fwd, NTHREADS, LDS_BYTES) != hipSuccess || per_cu < 1) { fprintf(stderr, "kernel_launch: occupancy query says %d\n", per_cu); per_cu = 1; }
        (void)hipGetLastError();
        grid = cus * per_cu; if (grid > 256) grid = 256;
        if (grid != NTOK / 256) { fprintf(stderr, "kernel_launch: this kernel needs %d co-resident workgroups, the device offers %d\n", NTOK / 256, grid); grid = -1; return; }
    }
    if (grid < 0) return;
    Params p{};
    for (int i = 0; i < 24; ++i) p.in[i] = (const float*)d_in[i];
    p.out = (float*)d_out; p.ws = (unsigned char*)d_ws; p.nrep = 2; p.pad = 0;
    if (hipMemsetAsync((unsigned char*)d_ws + WS_BAR, 0, XCD_BAR_WORDS * sizeof(unsigned), stream) != hipSuccess) { fprintf(stderr, "kernel_launch: memset of the barrier words failed\n"); return; }
#ifdef CONV_CHECK
    {
        hipMemsetAsync((unsigned char*)d_ws + WS_CHK, 0, 8, stream);
        void* args[] = {&p};
        p.ph_lo = 0; p.ph_hi = 4; hipLaunchCooperativeKernel((const void*)hybrid_fwd, dim3(grid), dim3(NTHREADS), args, LDS_BYTES, stream);
        hipLaunchKernelGGL(k_conv_check, dim3(grid), dim3(NTHREADS), 0, stream, p);
        hipMemsetAsync((unsigned char*)d_ws + WS_BAR, 0, XCD_BAR_WORDS * sizeof(unsigned), stream);
        p.ph_lo = 4; p.ph_hi = NPHASE; hipLaunchCooperativeKernel((const void*)hybrid_fwd, dim3(grid), dim3(NTHREADS), args, LDS_BYTES, stream);
        hipLaunchKernelGGL(k_conv_apply, dim3(grid), dim3(NTHREADS), 0, stream, p);
        return;
    }
#endif
#if ONE_LAUNCH
    p.ph_lo = 0; p.ph_hi = NPHASE;
    void* args[] = {&p};
    hipError_t e = hipLaunchCooperativeKernel((const void*)hybrid_fwd, dim3(grid), dim3(NTHREADS), args, LDS_BYTES, stream);
    if (e != hipSuccess) fprintf(stderr, "cooperative launch failed: %s (grid %d)\n", hipGetErrorString(e), grid);
#else
#ifndef HOSTREP
#define HOSTREP 0
#endif
    for (int ph = 0; ph < NPHASE; ++ph) { p.ph_lo = ph; p.ph_hi = ph + 1; const int nl = ((HOSTREP >> ph) & 1) ? 2 : 1;
        for (int r = 0; r < nl; ++r) hipLaunchKernelGGL(hybrid_fwd, dim3(grid), dim3(NTHREADS), LDS_BYTES, stream, p); }
#endif
}
```

```cpp
#include <hip/hip_runtime.h>
#include <hip/hip_cooperative_groups.h>
#include <cstdio>
namespace cg = cooperative_groups;
#ifndef ONE_LAUNCH
#define ONE_LAUNCH 1
#endif
#ifdef PROBE_A
#define PROBE_NOPEER 1
#endif
namespace pg8 {
#define PG8_LAS __attribute__((address_space(3)))
typedef unsigned short bf16_t;
typedef short bf16x8 __attribute__((ext_vector_type(8)));
typedef float f32x4 __attribute__((ext_vector_type(4)));
typedef unsigned u32x4 __attribute__((ext_vector_type(4)));
constexpr int BM = 256, BK = 64, HALF = 128, HTB = HALF * BK * 2  , STAGE_BYTES = 8 * HTB, NXCD = 8, WGM = 8;

__host__ __device__ __forceinline__ int lds_byte(int r, int c) { const int st = (r >> 4) * 2 + (c >> 5), rr = r & 15, cc = c & 31, ob = rr * 64 + cc * 2; return st * 1024 + (ob ^ (((ob >> 9) & 1) << 5)); }
__host__ __device__ __forceinline__ void stage_rc(int b, int& R, int& C) { const int st = b / 1024, sb = b % 1024, swz = sb ^ (((sb >> 9) & 1) << 5); R = (st >> 1) * 16 + swz / 64; C = (st & 1) * 32 + (swz % 64) / 2; }
__host__ __device__ __forceinline__ int perm32(int rho) { const int n = rho >> 4, i = rho & 15; return 8 * (i >> 2) + 4 * n + (i & 3); }

struct Unit { int pm, pn; };
struct Gemm { const bf16_t* A; const bf16_t* Bt; int M, N, K; };

struct StaticOrder {
    int nM, nN, nwg, G, c;
    __host__ __device__ void init(int M, int N, int G_, int c_) { nM = M / BM; nN = N / BM; nwg = nM * nN; G = G_; c = c_; }
    __host__ __device__ bool next(int i, Unit& u) const {
        const long L = (long)i * G + c; if (L >= nwg) return false;
        int wgid = (int)L; { const int q = nwg / NXCD, r = nwg % NXCD, xcd = wgid % NXCD, off = wgid / NXCD; wgid = (xcd < r ? xcd * (q + 1) : r * (q + 1) + (xcd - r) * q) + off; }
        const int nig = WGM * nN, gid = wgid / nig, fm = gid * WGM, gsz = (nM - fm) < WGM ? (nM - fm) : WGM;
        u.pm = fm + ((wgid % nig) % gsz); u.pn = (wgid % nig) / gsz; return true;
    }
    __device__ __forceinline__ void a_ready(const Unit&) const {}
    __device__ __forceinline__ void done(const Unit&) const {}
};
struct CountedOrder : StaticOrder {
    const unsigned* ready; unsigned need; unsigned* tmo;
    __device__ __forceinline__ void a_ready(const Unit& u) const {
        if (threadIdx.x < 64) {
            const unsigned long long t0 = __builtin_amdgcn_s_memrealtime(); unsigned polls = 0;
            while ((unsigned)__builtin_amdgcn_readfirstlane(__hip_atomic_load(ready + 64 * u.pm, __ATOMIC_RELAXED, __HIP_MEMORY_SCOPE_AGENT)) < need) {
                if ((++polls & 255u) == 0u && __builtin_amdgcn_readfirstlane(__hip_atomic_load(tmo, __ATOMIC_RELAXED, __HIP_MEMORY_SCOPE_AGENT)) != 0u) break;
                if (__builtin_amdgcn_s_memrealtime() - t0 > 2000000ull) {
                    if (threadIdx.x == 0) { unsigned expect = 0u; __hip_atomic_compare_exchange_strong(tmo + 1, &expect, 0x600u | (unsigned)(u.pm & 0xff), __ATOMIC_RELAXED, __ATOMIC_RELAXED, __HIP_MEMORY_SCOPE_AGENT); __hip_atomic_store(tmo, 1u, __ATOMIC_RELAXED, __HIP_MEMORY_SCOPE_AGENT); }
                    break; }
                __builtin_amdgcn_s_sleep(2); }
            __builtin_amdgcn_fence(__ATOMIC_ACQUIRE, "agent");
            asm volatile("s_waitcnt vmcnt(0)" ::: "memory");
        }
#if !defined(BROKEN_HOOK_NO_BARRIER)
        asm volatile("" ::: "memory"); __builtin_amdgcn_s_barrier(); asm volatile("" ::: "memory");
#endif
    }
};

__device__ __forceinline__ unsigned cvt_pk_bf16(float lo, float hi) { unsigned r; asm volatile("v_cvt_pk_bf16_f32 %0, %1, %2" : "=v"(r) : "v"(lo), "v"(hi)); return r; }
typedef float f32x2 __attribute__((ext_vector_type(2)));
__device__ __forceinline__ f32x2 gelu_pk(f32x2 v) {
    const f32x2 av = __builtin_elementwise_abs(v), d = av * 0.2316418882f + 1.0f;
    f32x2 t; t.x = __builtin_amdgcn_rcpf(d.x); t.y = __builtin_amdgcn_rcpf(d.y);
    f32x2 q = t * 0.5307027145f + (-0.7265760135f); q = q * t + 0.7107068705f; q = q * t + (-0.142248368f); q = q * t + 0.127414796f; q = q * t;
    const f32x2 s = (v * v) * (-0.72134752044f);
    f32x2 e; e.x = __builtin_amdgcn_exp2f(s.x); e.y = __builtin_amdgcn_exp2f(s.y);
    const f32x2 m = v * (q * e), r = v - m;
    f32x2 o; o.x = v.x < 0.f ? m.x : r.x; o.y = v.y < 0.f ? m.y : r.y; return o;
}

struct EpiF32 {
    static constexpr bool PERM = false, AFTER_DRAIN = false;
    float* C; int ldc; const float* bias;
    __device__ __forceinline__ void operator()(const f32x4 (&acc)[2][2][4][2], const Unit& u, int wr, int wc, int fr, int fq) const {
        const int row0 = u.pm * BM + wr * 64 + fr, col0 = u.pn * BM + wc * 32 + 4 * fq;
        f32x4 bv[2][2];
#pragma unroll
        for (int bj = 0; bj < 2; ++bj)
#pragma unroll
            for (int n = 0; n < 2; ++n) bv[bj][n] = bias ? *(const f32x4*)(bias + col0 + bj * HALF + n * 16) : (f32x4){0.f, 0.f, 0.f, 0.f};
#pragma unroll
        for (int ai = 0; ai < 2; ++ai)
#pragma unroll
            for (int m = 0; m < 4; ++m) { float* rowp = C + (size_t)(row0 + ai * HALF + m * 16) * ldc + col0;
#pragma unroll
                for (int bj = 0; bj < 2; ++bj)
#pragma unroll
                    for (int n = 0; n < 2; ++n) *(f32x4*)(rowp + bj * HALF + n * 16) = acc[ai][bj][m][n] + bv[bj][n]; }
    }
};
template <int ACT  > struct EpiBf16 {
    static constexpr bool PERM = true, AFTER_DRAIN = false;
    bf16_t* O; int ldc; const float* bias; int split_cols; size_t split_stride;
    __device__ __forceinline__ void operator()(const f32x4 (&acc)[2][2][4][2], const Unit& u, int wr, int wc, int fr, int fq) const {
        const int row0 = u.pm * BM + wr * 64 + fr; int colt = u.pn * BM; bf16_t* base = O;
        if (split_cols) { const int t = colt / split_cols; base += (size_t)t * split_stride; colt -= t * split_cols; }
        const int col0 = colt + wc * 32 + 8 * fq, bcol0 = u.pn * BM + wc * 32 + 8 * fq;
        f32x4 bv[2][2];
#pragma unroll
        for (int bj = 0; bj < 2; ++bj)
#pragma unroll
            for (int n = 0; n < 2; ++n) bv[bj][n] = bias ? *(const f32x4*)(bias + bcol0 + bj * HALF + 4 * n) : (f32x4){0.f, 0.f, 0.f, 0.f};
#pragma unroll
        for (int ai = 0; ai < 2; ++ai)
#pragma unroll
            for (int m = 0; m < 4; ++m) { bf16_t* rowp = base + (size_t)(row0 + ai * HALF + m * 16) * ldc + col0;
#pragma unroll
                for (int bj = 0; bj < 2; ++bj) { f32x4 v0 = acc[ai][bj][m][0] + bv[bj][0], v1 = acc[ai][bj][m][1] + bv[bj][1];
                    if (ACT == 1) { f32x2 a = gelu_pk((f32x2){v0[0], v0[1]}), b = gelu_pk((f32x2){v0[2], v0[3]}), c = gelu_pk((f32x2){v1[0], v1[1]}), d = gelu_pk((f32x2){v1[2], v1[3]});
                        v0 = (f32x4){a.x, a.y, b.x, b.y}; v1 = (f32x4){c.x, c.y, d.x, d.y}; }
                    if (ACT == 2) {
#pragma unroll
                        for (int j = 0; j < 4; ++j) { v0[j] = 0.5f * v0[j] * (1.0f + erff(v0[j] * 0.70710678f)); v1[j] = 0.5f * v1[j] * (1.0f + erff(v1[j] * 0.70710678f)); } }
                    u32x4 w; w.x = cvt_pk_bf16(v0[0], v0[1]); w.y = cvt_pk_bf16(v0[2], v0[3]); w.z = cvt_pk_bf16(v1[0], v1[1]); w.w = cvt_pk_bf16(v1[2], v1[3]);
                    *(u32x4*)(rowp + bj * HALF) = w; } }
    }
};

struct PanelStats {
    unsigned* xbuf;
    unsigned* cnt;
    unsigned* tmo;
    int ntn; float eps;
    unsigned code;
    __device__ __forceinline__ bool run(const f32x4 (&v)[2][2][4][2], const Unit& u, int wr, int wc, int fr, int fq, PG8_LAS unsigned char* lds, int wid, int lane) const {
        typedef float f32x2v __attribute__((ext_vector_type(2)));
        PG8_LAS f32x2v* P = (PG8_LAS f32x2v*)lds;
        PG8_LAS f32x2v* S = (PG8_LAS f32x2v*)(lds + 8192);
        PG8_LAS unsigned* flag = (PG8_LAS unsigned*)(lds + 8192 + 2048);
#pragma unroll
        for (int ai = 0; ai < 2; ++ai)
#pragma unroll
            for (int m = 0; m < 4; ++m) {
                float s = 0.f;
#pragma unroll
                for (int bj = 0; bj < 2; ++bj)
#pragma unroll
                    for (int n = 0; n < 2; ++n) { const f32x4 x = v[ai][bj][m][n]; s += (x[0] + x[1]) + (x[2] + x[3]); }
                s += __shfl_xor(s, 16); s += __shfl_xor(s, 32);
                const float mw = s * (1.0f / 64.0f); float q = 0.f;
#pragma unroll
                for (int bj = 0; bj < 2; ++bj)
#pragma unroll
                    for (int n = 0; n < 2; ++n) { const f32x4 d = v[ai][bj][m][n] - mw; q += (d[0] * d[0] + d[1] * d[1]) + (d[2] * d[2] + d[3] * d[3]); }
                q += __shfl_xor(q, 16); q += __shfl_xor(q, 32);
                if (fq == 0) P[(ai * HALF + wr * 64 + m * 16 + fr) * 4 + wc] = (f32x2v){mw, q};
            }
        asm volatile("s_waitcnt lgkmcnt(0)" ::: "memory"); __builtin_amdgcn_s_barrier(); asm volatile("" ::: "memory");
#if defined(BROKEN_NO_WAIT)
        if (blockIdx.x >= 64) { const long long t0 = clock64(); while (clock64() - t0 < 60000) __builtin_amdgcn_s_sleep(8); }
#endif
        const int row = wid * 32 + (lane & 31);
        if (lane < 32) {
            const f32x2v a = P[row * 4 + 0], b = P[row * 4 + 1], c = P[row * 4 + 2], d = P[row * 4 + 3];
            const float mt = (a.x + b.x + c.x + d.x) * 0.25f;
            const float da = a.x - mt, db = b.x - mt, dc = c.x - mt, dd = d.x - mt;
            const float m2 = (a.y + b.y) + (c.y + d.y) + 64.0f * ((da * da + db * db) + (dc * dc + dd * dd));
            unsigned long long* slot = (unsigned long long*)xbuf + ((size_t)(u.pm * BM + row) * 4 + u.pn);
            __hip_atomic_store(slot, ((unsigned long long)__float_as_uint(m2) << 32) | __float_as_uint(mt), __ATOMIC_RELAXED, __HIP_MEMORY_SCOPE_AGENT);
        }
        asm volatile("s_waitcnt vmcnt(0)" ::: "memory");
        if (lane == 0) __hip_atomic_fetch_add(cnt + 64 * u.pm, 1u, __ATOMIC_RELAXED, __HIP_MEMORY_SCOPE_AGENT);
        if (wid == 0) {
            bool dead = false; const unsigned long long t0 = __builtin_amdgcn_s_memrealtime(); const unsigned want = 8u * (unsigned)ntn;
            for (;;) {
#if defined(BROKEN_NO_WAIT)
                break;
#endif
                if ((unsigned)__builtin_amdgcn_readfirstlane(__hip_atomic_load(cnt + 64 * u.pm, __ATOMIC_RELAXED, __HIP_MEMORY_SCOPE_AGENT)) >= want) break;
                if (__builtin_amdgcn_s_memrealtime() - t0 > 2000000ull) {
                    if (lane == 0) { unsigned expect = 0u; __hip_atomic_compare_exchange_strong(tmo + 1, &expect, code | (unsigned)(u.pm & 0xff), __ATOMIC_RELAXED, __ATOMIC_RELAXED, __HIP_MEMORY_SCOPE_AGENT);
                                     __hip_atomic_store(tmo, 1u, __ATOMIC_RELAXED, __HIP_MEMORY_SCOPE_AGENT); }
                    dead = true; break; }
                __builtin_amdgcn_s_sleep(2);
            }
            __builtin_amdgcn_fence(__ATOMIC_ACQUIRE, "agent");
            if (lane == 0) flag[0] = dead ? 1u : 0u;
        }
        asm volatile("s_waitcnt vmcnt(0) lgkmcnt(0)" ::: "memory"); __builtin_amdgcn_s_barrier(); asm volatile("" ::: "memory");
        const bool bad = flag[0] != 0u;
        if (lane < 32) {
            const unsigned long long* slot = (const unsigned long long*)xbuf + (size_t)(u.pm * BM + row) * 4; float mt[4], m2[4]; float ms = 0.f;
#pragma unroll
            for (int t = 0; t < 4; ++t) { if (t < ntn) { const unsigned long long w = __hip_atomic_load(slot + t, __ATOMIC_RELAXED, __HIP_MEMORY_SCOPE_AGENT); mt[t] = __uint_as_float((unsigned)w); m2[t] = __uint_as_float((unsigned)(w >> 32)); } else { mt[t] = 0.f; m2[t] = 0.f; } ms += mt[t]; }
            const float mean = ms / (float)ntn; float q = 0.f;
#pragma unroll
            for (int t = 0; t < 4; ++t) if (t < ntn) { const float dm = mt[t] - mean; q += m2[t] + 256.0f * dm * dm; }
            S[row] = (f32x2v){mean, 1.0f / sqrtf(q / (256.0f * (float)ntn) + eps)};
        }
        asm volatile("s_waitcnt lgkmcnt(0)" ::: "memory"); __builtin_amdgcn_s_barrier(); asm volatile("" ::: "memory");
        return bad;
    }
};
struct EpiLnRes {
    static constexpr bool PERM = false, AFTER_DRAIN = true;
    const float* base; float* out; int ldc; const float* bias; PanelStats st; unsigned poison;
    __device__ __forceinline__ void refuse(size_t i0, size_t stride, int M, int N) const { const float q = __builtin_nanf(""); for (size_t i = i0; i < (size_t)M * N; i += stride) out[(i / N) * ldc + i % N] = q;
        if (i0 == 0) { unsigned expect = 0u; __hip_atomic_compare_exchange_strong(st.tmo + 1, &expect, 0x7f0u, __ATOMIC_RELAXED, __ATOMIC_RELAXED, __HIP_MEMORY_SCOPE_AGENT); __hip_atomic_store(st.tmo, 1u, __ATOMIC_RELAXED, __HIP_MEMORY_SCOPE_AGENT); } }
    __device__ __forceinline__ void fused(f32x4 (&acc)[2][2][4][2], const Unit& u, int wr, int wc, int fr, int fq, PG8_LAS unsigned char* lds, int wid, int lane) const {
        typedef float f32x2v __attribute__((ext_vector_type(2)));
        const PG8_LAS f32x2v* S = (const PG8_LAS f32x2v*)(lds + 8192);
        const int col0 = u.pn * BM + wc * 32 + 4 * fq;
#pragma unroll
        for (int bj = 0; bj < 2; ++bj)
#pragma unroll
            for (int n = 0; n < 2; ++n) { const f32x4 bv = bias ? *(const f32x4*)(bias + col0 + bj * HALF + n * 16) : (f32x4){0.f, 0.f, 0.f, 0.f};
#pragma unroll
                for (int ai = 0; ai < 2; ++ai)
#pragma unroll
                    for (int m = 0; m < 4; ++m) acc[ai][bj][m][n] += bv; }
        const bool bad = st.run(acc, u, wr, wc, fr, fq, lds, wid, lane) || poison != 0u;
        const float qnan = __builtin_nanf("");
#pragma unroll
        for (int ai = 0; ai < 2; ++ai)
#pragma unroll
            for (int m = 0; m < 4; ++m) { const int r = ai * HALF + wr * 64 + m * 16 + fr; const f32x2v sr = S[r]; const size_t off = (size_t)(u.pm * BM + r) * ldc + col0;
#pragma unroll
                for (int bj = 0; bj < 2; ++bj)
#pragma unroll
                    for (int n = 0; n < 2; ++n) { const f32x4 bs = *(const f32x4*)(base + off + bj * HALF + n * 16); f32x4 o = bs + (acc[ai][bj][m][n] - sr.x) * sr.y;
                        if (bad) o = (f32x4){qnan, qnan, qnan, qnan}; *(f32x4*)(out + off + bj * HALF + n * 16) = o; }
                asm volatile("" ::: "memory"); }
    }
};
struct EpiLnResLn {
    static constexpr bool PERM = false, AFTER_DRAIN = true;
    const float* base; float* out; bf16_t* xn; int ldc; const float* bias; PanelStats st1, st2; unsigned poison;
    __device__ __forceinline__ void refuse(size_t i0, size_t stride, int M, int N) const { const float q = __builtin_nanf(""); for (size_t i = i0; i < (size_t)M * N; i += stride) { const size_t o = (i / N) * ldc + i % N; out[o] = q; xn[o] = (bf16_t)0x7fc0u; }
        if (i0 == 0) { unsigned expect = 0u; __hip_atomic_compare_exchange_strong(st1.tmo + 1, &expect, 0x7f0u, __ATOMIC_RELAXED, __ATOMIC_RELAXED, __HIP_MEMORY_SCOPE_AGENT); __hip_atomic_store(st1.tmo, 1u, __ATOMIC_RELAXED, __HIP_MEMORY_SCOPE_AGENT); } }
    __device__ __forceinline__ void fused(f32x4 (&acc)[2][2][4][2], const Unit& u, int wr, int wc, int fr, int fq, PG8_LAS unsigned char* lds, int wid, int lane) const {
        typedef float f32x2v __attribute__((ext_vector_type(2))); typedef unsigned u32x2v __attribute__((ext_vector_type(2)));
        const PG8_LAS f32x2v* S = (const PG8_LAS f32x2v*)(lds + 8192);
        const int col0 = u.pn * BM + wc * 32 + 4 * fq;
#pragma unroll
        for (int bj = 0; bj < 2; ++bj)
#pragma unroll
            for (int n = 0; n < 2; ++n) { const f32x4 bv = bias ? *(const f32x4*)(bias + col0 + bj * HALF + n * 16) : (f32x4){0.f, 0.f, 0.f, 0.f};
#pragma unroll
                for (int ai = 0; ai < 2; ++ai)
#pragma unroll
                    for (int m = 0; m < 4; ++m) acc[ai][bj][m][n] += bv; }
        bool bad = st1.run(acc, u, wr, wc, fr, fq, lds, wid, lane) || poison != 0u;
        const float qnan = __builtin_nanf("");
#pragma unroll
        for (int ai = 0; ai < 2; ++ai)
#pragma unroll
            for (int m = 0; m < 4; ++m) { const int r = ai * HALF + wr * 64 + m * 16 + fr; const f32x2v sr = S[r]; const size_t off = (size_t)(u.pm * BM + r) * ldc + col0;
#pragma unroll
                for (int bj = 0; bj < 2; ++bj)
#pragma unroll
                    for (int n = 0; n < 2; ++n) { const f32x4 bs = *(const f32x4*)(base + off + bj * HALF + n * 16); acc[ai][bj][m][n] = bs + (acc[ai][bj][m][n] - sr.x) * sr.y; }
                asm volatile("" : "+v"(acc[ai][0][m][0]), "+v"(acc[ai][0][m][1]), "+v"(acc[ai][1][m][0]), "+v"(acc[ai][1][m][1]));
                if (m & 1) asm volatile("" ::: "memory"); }
        const bool bad1 = bad;
        bad = st2.run(acc, u, wr, wc, fr, fq, lds, wid, lane) || bad;
#pragma unroll
        for (int ai = 0; ai < 2; ++ai)
#pragma unroll
            for (int m = 0; m < 4; ++m) { const int r = ai * HALF + wr * 64 + m * 16 + fr; const f32x2v sr = S[r]; const size_t off = (size_t)(u.pm * BM + r) * ldc + col0;
#pragma unroll
                for (int bj = 0; bj < 2; ++bj)
#pragma unroll
                    for (int n = 0; n < 2; ++n) { const f32x4 x1 = acc[ai][bj][m][n]; *(f32x4*)(out + off + bj * HALF + n * 16) = bad1 ? (f32x4){qnan, qnan, qnan, qnan} : x1;
                        const f32x4 o = (x1 - sr.x) * sr.y; u32x2v w; w.x = cvt_pk_bf16(o[0], o[1]); w.y = cvt_pk_bf16(o[2], o[3]);
                        if (bad) { w.x = 0x7fc07fc0u; w.y = 0x7fc07fc0u; } *(u32x2v*)(xn + off + bj * HALF + n * 16) = w; }
                asm volatile("" ::: "memory"); }
    }
};

template <class Epi, class Sched, bool STAMP = false>
__device__ __forceinline__ void gemm_phase(PG8_LAS unsigned char* lds, const Gemm g, const Sched& S, const Epi& E, unsigned long long* stamps) {
    const int tid = threadIdx.x, wid = __builtin_amdgcn_readfirstlane(tid >> 6), lane = tid & 63, wr = wid >> 2, wc = wid & 3, fr = lane & 15, fq = lane >> 4;
    const int K = g.K, nt = K / BK;
    int ts_lo = 0, ts_hi = 0, nts = 0; const unsigned long long rt_entry = STAMP ? (unsigned long long)wall_clock64() : 0ull;
#define PG8_STAMP() do { if (STAMP && wid == 0 && nts < 64) { const unsigned long long _c = (unsigned long long)clock64(); \
        ts_lo = (lane == nts) ? (int)(unsigned)_c : ts_lo; ts_hi = (lane == nts) ? (int)(unsigned)(_c >> 32) : ts_hi; ++nts; } } while (0)
    PG8_STAMP();
    unsigned voffA[2], voffB[2];
#pragma unroll
    for (int i = 0; i < 2; ++i) { int R, C; stage_rc(tid * 16 + i * 8192, R, C); const int Rb = Epi::PERM ? ((R & ~31) + perm32(R & 31)) : R;
        voffA[i] = (unsigned)(R * K + C) * 2u; voffB[i] = (unsigned)(Rb * K + C) * 2u; }
    const size_t kstep = (size_t)(BK * 2);
    const size_t hstep = (size_t)HALF * K * 2;
    const size_t tstep = 2 * hstep;
    const unsigned ldsw = (unsigned)wid * 1024u;
    const int aoff = lds_byte(wr * 64 + fr, fq * 8), boff = lds_byte(wc * 32 + fr, fq * 8);
#define PG8_SA(b, h) (((b) * 2 + (h)) * HTB)
#define PG8_SB(b, h) ((4 + (b) * 2 + (h)) * HTB)
#define PG8_STAGE(bufoff, gbase, voff) do { _Pragma("unroll") for (int _i = 0; _i < 2; ++_i) \
        __builtin_amdgcn_global_load_lds((const unsigned*)((const char*)(gbase) + (voff)[_i]), (PG8_LAS unsigned*)(lds + (bufoff) + ldsw + _i * 8192), 16, 0, 0); } while (0)
#define PG8_LDA(dst, b, h) do { _Pragma("unroll") for (int m = 0; m < 4; ++m) _Pragma("unroll") for (int k = 0; k < 2; ++k) dst[m][k] = *(const PG8_LAS bf16x8*)(lds + PG8_SA(b, h) + aoff + m * 2048 + k * 1024); } while (0)
#define PG8_LDB(dst, b, h) do { _Pragma("unroll") for (int n = 0; n < 2; ++n) _Pragma("unroll") for (int k = 0; k < 2; ++k) dst[n][k] = *(const PG8_LAS bf16x8*)(lds + PG8_SB(b, h) + boff + n * 2048 + k * 1024); } while (0)
#define PG8_MMA(ai, bj, At, Bt) do { __builtin_amdgcn_s_setprio(1); _Pragma("unroll") for (int m = 0; m < 4; ++m) _Pragma("unroll") for (int n = 0; n < 2; ++n) _Pragma("unroll") for (int k = 0; k < 2; ++k) \
        acc[ai][bj][m][n] = __builtin_amdgcn_mfma_f32_16x16x32_bf16(Bt[n][k], At[m][k], acc[ai][bj][m][n], 0, 0, 0); __builtin_amdgcn_s_setprio(0); } while (0)
#define PG8_WAIT_V(n) asm volatile("s_waitcnt vmcnt(" #n ")" ::: "memory")
#define PG8_WAIT_L(n) asm volatile("s_waitcnt lgkmcnt(" #n ")" ::: "memory")
#define PG8_BAR __builtin_amdgcn_s_barrier()
#define PG8_SCHED __builtin_amdgcn_sched_barrier(0)
    Unit cur, nxt; int ui = 0;
    if (!S.next(0, cur)) return;
    f32x4 acc[2][2][4][2];
#pragma unroll
    for (int a = 0; a < 2; ++a)
#pragma unroll
        for (int b = 0; b < 2; ++b)
#pragma unroll
            for (int m = 0; m < 4; ++m)
#pragma unroll
                for (int n = 0; n < 2; ++n) acc[a][b][m][n] = (f32x4){0.f, 0.f, 0.f, 0.f};
    bf16x8 At[4][2], B0[2][2], B1[2][2];
    const char* cA = (const char*)g.A + (size_t)cur.pm * tstep; const char* cB = (const char*)g.Bt + (size_t)cur.pn * tstep;
    S.a_ready(cur);
    PG8_STAGE(PG8_SB(0, 0), cB, voffB); PG8_STAGE(PG8_SA(0, 0), cA, voffA); PG8_STAGE(PG8_SB(0, 1), cB + hstep, voffB); PG8_STAGE(PG8_SA(0, 1), cA + hstep, voffA);
    if (wr == 1) PG8_BAR;
    PG8_WAIT_V(4); PG8_BAR;
    PG8_STAGE(PG8_SB(1, 0), cB + kstep, voffB); PG8_STAGE(PG8_SA(1, 0), cA + kstep, voffA); PG8_STAGE(PG8_SB(1, 1), cB + hstep + kstep, voffB);
    PG8_WAIT_V(6); PG8_BAR;
    PG8_STAMP();
    for (;;) {
        const bool has_next = S.next(ui + 1, nxt);
        const char* nA = has_next ? (const char*)g.A + (size_t)nxt.pm * tstep : cA; const char* nB = has_next ? (const char*)g.Bt + (size_t)nxt.pn * tstep : cB;
        for (int t = 0; t < nt; t += 2) {
            const bool last = (t == nt - 2);
            const char* a1 = cA + (size_t)(t + 1) * kstep;
            const char* a2 = last ? nA : cA + (size_t)(t + 2) * kstep; const char* b2 = last ? nB : cB + (size_t)(t + 2) * kstep;
            const char* a3 = a2 + kstep; const char* b3 = b2 + kstep;
            if (last && has_next) S.a_ready(nxt);
            PG8_LDB(B0, 0, 0); PG8_SCHED; PG8_LDA(At, 0, 0); PG8_STAGE(PG8_SA(1, 1), a1 + hstep, voffA);
            PG8_WAIT_L(8); PG8_BAR; PG8_WAIT_L(0); PG8_MMA(0, 0, At, B0); PG8_BAR; PG8_SCHED;
            PG8_LDB(B1, 0, 1); PG8_STAGE(PG8_SB(0, 0), b2, voffB);
            PG8_BAR; PG8_WAIT_L(0); PG8_MMA(0, 1, At, B1); PG8_BAR;
            PG8_LDA(At, 0, 1); PG8_STAGE(PG8_SA(0, 0), a2, voffA);
            PG8_BAR; PG8_WAIT_L(0); PG8_MMA(1, 0, At, B0); PG8_BAR; PG8_SCHED;
            PG8_STAGE(PG8_SB(0, 1), b2 + hstep, voffB);
            PG8_WAIT_V(6); PG8_BAR; PG8_MMA(1, 1, At, B1); PG8_BAR;
            PG8_LDB(B0, 1, 0); PG8_SCHED; PG8_LDA(At, 1, 0); PG8_STAGE(PG8_SA(0, 1), a2 + hstep, voffA);
            PG8_WAIT_L(8); PG8_BAR; PG8_WAIT_L(0); PG8_MMA(0, 0, At, B0); PG8_BAR; PG8_SCHED;
            PG8_LDB(B1, 1, 1); PG8_STAGE(PG8_SB(1, 0), b3, voffB);
            PG8_BAR; PG8_WAIT_L(0); PG8_MMA(0, 1, At, B1); PG8_BAR;
            PG8_LDA(At, 1, 1); PG8_STAGE(PG8_SA(1, 0), a3, voffA);
            PG8_BAR; PG8_WAIT_L(0); PG8_MMA(1, 0, At, B0); PG8_BAR; PG8_SCHED;
            PG8_STAGE(PG8_SB(1, 1), b3 + hstep, voffB);
            PG8_WAIT_V(6); PG8_BAR; PG8_MMA(1, 1, At, B1); PG8_BAR;
        }
        PG8_STAMP();
        if constexpr (!Epi::AFTER_DRAIN) { E(acc, cur, wr, wc, fr, fq); S.done(cur); }
        PG8_STAMP();
        if (!has_next) break;
#pragma unroll
        for (int a = 0; a < 2; ++a)
#pragma unroll
            for (int b = 0; b < 2; ++b)
#pragma unroll
                for (int m = 0; m < 4; ++m)
#pragma unroll
                    for (int n = 0; n < 2; ++n) acc[a][b][m][n] = (f32x4){0.f, 0.f, 0.f, 0.f};
        cur = nxt; cA = nA; cB = nB; ++ui;
    }
    PG8_WAIT_V(0);
    if (wr == 0) PG8_BAR;
    PG8_BAR;
    if constexpr (Epi::AFTER_DRAIN) { E.fused(acc, cur, wr, wc, fr, fq, lds, wid, lane); S.done(cur); }
    PG8_STAMP();
    if (STAMP && wid == 0) { stamps[lane] = lane < nts ? (((unsigned long long)(unsigned)ts_hi << 32) | (unsigned)ts_lo) : 0ull;
        if (lane == 62) stamps[62] = rt_entry; if (lane == 63) stamps[63] = (unsigned long long)wall_clock64(); }
#undef PG8_STAMP
#undef PG8_SA
#undef PG8_SB
#undef PG8_STAGE
#undef PG8_LDA
#undef PG8_LDB
#undef PG8_MMA
#undef PG8_WAIT_V
#undef PG8_WAIT_L
#undef PG8_BAR
#undef PG8_SCHED
}
}

#define LAS __attribute__((address_space(3)))
typedef unsigned short bf16_t;
typedef short bf16x8 __attribute__((ext_vector_type(8)));
typedef float f32x4 __attribute__((ext_vector_type(4)));
typedef unsigned u32x4 __attribute__((ext_vector_type(4)));
typedef unsigned u32x2 __attribute__((ext_vector_type(2)));
typedef __bf16 bf2_t __attribute__((ext_vector_type(2)));
typedef _Float16 h2_t __attribute__((ext_vector_type(2)));

constexpr int NTOK = 65536, DM = 1024, NTOK_P = 32768;
constexpr int L0 = 8192, L1 = 4096;
constexpr float ALPHA_C = 1.189207115002721f;
constexpr float LN_EPS_C = 1e-5f;
constexpr int NTHREADS = 512;
constexpr int NPHASE = 10;
constexpr int LDS_BYTES = 153600;
constexpr size_t MiB = 1024ull * 1024ull;
constexpr size_t WS_XB = 0;
constexpr size_t WS_PH = 128 * MiB;
constexpr size_t WS_ZT = 320 * MiB;
constexpr size_t WS_U8 = 384 * MiB, WS_V8 = 400 * MiB;
constexpr size_t WS_PARTD = 128 * MiB;
constexpr float U_SCALE = 128.0f, V_SCALE = 16.0f;
constexpr size_t WS_WINT = 448 * MiB, WS_WOUTT = 454 * MiB, WS_WPT = 456 * MiB;
constexpr size_t WS_FG = 460 * MiB;
constexpr size_t WS_PART = 484 * MiB;
constexpr size_t WS_DUMMY = 492 * MiB;
constexpr size_t WS_BAR = 497 * MiB;
constexpr size_t WS_END = 498 * MiB;
constexpr size_t WS_EIDX = 416 * MiB, WS_GATE = 460 * MiB;
constexpr size_t OUT_X0T = 192 * MiB;

struct Params { const float* in[24]; float* out; unsigned char* ws; int ph_lo, ph_hi, nrep, pad; };

__device__ __forceinline__ unsigned pack2bf(float lo, float hi) { return pg8::cvt_pk_bf16(lo, hi); }
__device__ __forceinline__ float bf_lo(unsigned w) { return __uint_as_float(w << 16); }
__device__ __forceinline__ float bf_hi(unsigned w) { return __uint_as_float(w & 0xffff0000u); }
__device__ __forceinline__ unsigned short f2bf(float f) { return (unsigned short)(pack2bf(f, 0.f) & 0xffffu); }

__device__ __forceinline__ void seq_of(int tok0, int& seq, int& L, int& tl) {
    if (tok0 < NTOK_P) { seq = tok0 >> 13; L = L0; tl = tok0 & (L0 - 1); }
    else { const int r = tok0 - NTOK_P; seq = 4 + (r >> 12); L = L1; tl = r & (L1 - 1); }
}
__device__ __forceinline__ size_t seq_base_T(int seq) { return seq < 4 ? (size_t)seq * 512 * L0 : (size_t)4 * 512 * L0 + (size_t)(seq - 4) * 512 * L1; }

struct EpiP {
    static constexpr bool PERM = true, AFTER_DRAIN = false;
    bf16_t* PA; bf16_t* PH; const float* bias;
    __device__ __forceinline__ void operator()(const f32x4 (&acc)[2][2][4][2], const pg8::Unit& u, int wr, int wc, int fr, int fq) const {
        const int row0 = u.pm * 256 + wr * 64 + fr, lc = wc * 32 + 8 * fq;
        if (u.pn >= 2 && u.pn < 6) {
            const int ch0 = (u.pn - 2) * 128 + lc;
            f32x4 bc[2], bh[2];
#pragma unroll
            for (int n = 0; n < 2; ++n) { bc[n] = *(const f32x4*)(bias + 512 + ch0 + 4 * n); bh[n] = *(const f32x4*)(bias + 1024 + ch0 + 4 * n); }
#pragma unroll
            for (int ai = 0; ai < 2; ++ai)
#pragma unroll
                for (int m = 0; m < 4; ++m) { const f32x4 g0 = (acc[ai][0][m][0] + bc[0]) * (acc[ai][1][m][0] + bh[0]), g1 = (acc[ai][0][m][1] + bc[1]) * (acc[ai][1][m][1] + bh[1]);
                    u32x4 w; w.x = pack2bf(g0[0], g0[1]); w.y = pack2bf(g0[2], g0[3]); w.z = pack2bf(g1[0], g1[1]); w.w = pack2bf(g1[2], g1[3]);
                    *(u32x4*)(PA + (size_t)(row0 + ai * 128 + m * 16) * 1024 + 512 + ch0) = w; }
        } else {
            const bool isB = u.pn < 2; bf16_t* base = isB ? PA : PH; const int pitch = isB ? 1024 : 1536;
            const int colt = isB ? u.pn * 256 : u.pn * 256 - 1536, bcol0 = u.pn * 256 + lc;
            f32x4 bv[2][2];
#pragma unroll
            for (int bj = 0; bj < 2; ++bj)
#pragma unroll
                for (int n = 0; n < 2; ++n) bv[bj][n] = *(const f32x4*)(bias + bcol0 + bj * 128 + 4 * n);
#pragma unroll
            for (int ai = 0; ai < 2; ++ai)
#pragma unroll
                for (int m = 0; m < 4; ++m) { bf16_t* rowp = base + (size_t)(row0 + ai * 128 + m * 16) * pitch + colt + lc;
#pragma unroll
                    for (int bj = 0; bj < 2; ++bj) { const f32x4 v0 = acc[ai][bj][m][0] + bv[bj][0], v1 = acc[ai][bj][m][1] + bv[bj][1];
                        u32x4 w; w.x = pack2bf(v0[0], v0[1]); w.y = pack2bf(v0[2], v0[3]); w.z = pack2bf(v1[0], v1[1]); w.w = pack2bf(v1[2], v1[3]);
                        *(u32x4*)(rowp + bj * 128) = w; } }
        }
    }
};
struct EpiH1 {
    static constexpr bool PERM = true, AFTER_DRAIN = false;
    const float* xp; const float* xs; bf16_t* out;
    __device__ __forceinline__ void operator()(const f32x4 (&acc)[2][2][4][2], const pg8::Unit& u, int wr, int wc, int fr, int fq) const {
        const int row0 = u.pm * 256 + wr * 64 + fr, col0 = u.pn * 256 + wc * 32 + 8 * fq;
        const float* xb = (u.pm * 256 < NTOK_P) ? xp : (xs - (size_t)NTOK_P * DM);
#pragma unroll
        for (int ai = 0; ai < 2; ++ai)
#pragma unroll
            for (int m = 0; m < 4; ++m) { const size_t off = (size_t)(row0 + ai * 128 + m * 16) * DM + col0;
#pragma unroll
                for (int bj = 0; bj < 2; ++bj) { const f32x4 x0 = *(const f32x4*)(xb + off + bj * 128), x1 = *(const f32x4*)(xb + off + bj * 128 + 4);
                    const f32x4 v0 = x0 * ALPHA_C + acc[ai][bj][m][0], v1 = x1 * ALPHA_C + acc[ai][bj][m][1];
                    u32x4 w; w.x = pack2bf(v0[0], v0[1]); w.y = pack2bf(v0[2], v0[3]); w.z = pack2bf(v1[0], v1[1]); w.w = pack2bf(v1[2], v1[3]);
                    *(u32x4*)(out + off + bj * 128) = w; } }
    }
};
struct EpiS {
    static constexpr bool PERM = true, AFTER_DRAIN = false;
    unsigned short* S;
    __device__ __forceinline__ void operator()(const f32x4 (&acc)[2][2][4][2], const pg8::Unit& u, int wr, int wc, int fr, int fq) const {
        const int row0 = u.pm * 256 + wr * 64 + fr, col0 = u.pn * 256 + wc * 32 + 8 * fq;
#pragma unroll
        for (int ai = 0; ai < 2; ++ai)
#pragma unroll
            for (int m = 0; m < 4; ++m) { unsigned short* rowp = S + (size_t)(row0 + ai * 128 + m * 16) * 2048 + col0;
#pragma unroll
                for (int bj = 0; bj < 2; ++bj) { const f32x4 v0 = acc[ai][bj][m][0], v1 = acc[ai][bj][m][1];
                    u32x4 w;
                    w.x = __builtin_bit_cast(unsigned, __builtin_amdgcn_cvt_pkrtz(v0[0], v0[1])); w.y = __builtin_bit_cast(unsigned, __builtin_amdgcn_cvt_pkrtz(v0[2], v0[3]));
                    w.z = __builtin_bit_cast(unsigned, __builtin_amdgcn_cvt_pkrtz(v1[0], v1[1])); w.w = __builtin_bit_cast(unsigned, __builtin_amdgcn_cvt_pkrtz(v1[2], v1[3]));
                    *(u32x4*)(rowp + bj * 128) = w; } }
    }
};

__device__ void cvt_f32_bf16(const float* __restrict__ s, bf16_t* __restrict__ d, size_t n8) {
    const size_t q = n8 >> 2;
    for (size_t i = (size_t)blockIdx.x * NTHREADS + threadIdx.x; i < q; i += (size_t)gridDim.x * NTHREADS) {
        float4 a[4], b[4];
#pragma unroll
        for (int k = 0; k < 4; ++k) { const f32x4 ta = __builtin_nontemporal_load((const f32x4*)s + 2 * (i + k * q)), tb = __builtin_nontemporal_load((const f32x4*)s + 2 * (i + k * q) + 1);
            a[k] = make_float4(ta[0], ta[1], ta[2], ta[3]); b[k] = make_float4(tb[0], tb[1], tb[2], tb[3]); }
#pragma unroll
        for (int k = 0; k < 4; ++k) { u32x4 w; w.x = pack2bf(a[k].x, a[k].y); w.y = pack2bf(a[k].z, a[k].w); w.z = pack2bf(b[k].x, b[k].y); w.w = pack2bf(b[k].z, b[k].w);
            ((u32x4*)d)[i + k * q] = w; }
    }
}
__device__ __forceinline__ unsigned pack4fp8(float a, float b, float c, float d) { int p = 0; p = __builtin_amdgcn_cvt_pk_fp8_f32(a, b, p, false); p = __builtin_amdgcn_cvt_pk_fp8_f32(c, d, p, true); return (unsigned)p; }
__device__ void cvt_f32_fp8(const float* __restrict__ s, unsigned char* __restrict__ d, size_t n16, float sc) {
    const size_t h = n16 >> 1;
    for (size_t i0 = (size_t)blockIdx.x * NTHREADS + threadIdx.x; i0 < h; i0 += (size_t)gridDim.x * NTHREADS) {
        float4 v[2][4];
#pragma unroll
        for (int k = 0; k < 2; ++k)
#pragma unroll
            for (int j = 0; j < 4; ++j) { const f32x4 t = __builtin_nontemporal_load((const f32x4*)s + 4 * (i0 + k * h) + j); v[k][j] = make_float4(t[0], t[1], t[2], t[3]); }
#pragma unroll
        for (int k = 0; k < 2; ++k) { const size_t i = i0 + k * h; const float4 a = v[k][0], b = v[k][1], c = v[k][2], e = v[k][3];
            u32x4 w; w.x = pack4fp8(a.x * sc, a.y * sc, a.z * sc, a.w * sc); w.y = pack4fp8(b.x * sc, b.y * sc, b.z * sc, b.w * sc); w.z = pack4fp8(c.x * sc, c.y * sc, c.z * sc, c.w * sc); w.w = pack4fp8(e.x * sc, e.y * sc, e.z * sc, e.w * sc);
            const size_t er = i >> 6, kk = i & 63;
            *(u32x4*)(d + ((kk >> 3) * 16384 + er) * 128 + (kk & 7) * 16) = w; }
    }
}
__device__ __forceinline__ int win_perm(int c) { if (c < 512 || c >= 1536) return c; const int ch = (c - 512) & 511, hsel = (c >= 1024) ? 128 : 0; return 512 + (ch >> 7) * 256 + hsel + (ch & 127); }
template <bool PERM_WIN>
__device__ void transpose_cvt(const float* __restrict__ src, int R, int C, bf16_t* __restrict__ dst, float* tile  ) {
    const int tid = threadIdx.x, nct = C / 64, nu = (R / 64) * nct;
    for (int u = blockIdx.x; u < nu; u += gridDim.x) {
        const int r0 = (u / nct) * 64, c0 = (u % nct) * 64;
        { const int r = tid >> 3, c8 = (tid & 7) * 8; const float4 a = *(const float4*)(src + (size_t)(r0 + r) * C + c0 + c8), b = *(const float4*)(src + (size_t)(r0 + r) * C + c0 + c8 + 4);
          float* t = tile + r * 65 + c8; t[0] = a.x; t[1] = a.y; t[2] = a.z; t[3] = a.w; t[4] = b.x; t[5] = b.y; t[6] = b.z; t[7] = b.w; }
        __syncthreads();
        { const int c = tid >> 3, r8 = (tid & 7) * 8; float v[8];
#pragma unroll
          for (int k = 0; k < 8; ++k) v[k] = tile[(r8 + k) * 65 + c];
          u32x4 w; w.x = pack2bf(v[0], v[1]); w.y = pack2bf(v[2], v[3]); w.z = pack2bf(v[4], v[5]); w.w = pack2bf(v[6], v[7]);
          *(u32x4*)(dst + (size_t)(PERM_WIN ? win_perm(c0 + c) : (c0 + c)) * R + r0 + r8) = w; }
        __syncthreads();
    }
}
__device__ void fold_wq_keys(const float* __restrict__ wq, const float* __restrict__ keys, bf16_t* __restrict__ WpT, float* lds) {
    float* sk = lds; float* sw = lds + 64 * 132;
    const int tid = threadIdx.x;
    for (int u = blockIdx.x; u < 512; u += gridDim.x) {
        const int hp = u >> 5, n0 = ((u >> 4) & 1) * 64, d0 = (u & 15) * 64;
        for (int i = tid; i < 64 * 32; i += NTHREADS) { const int r = i >> 5, k4 = (i & 31) * 4;
            const float4 a = *(const float4*)(keys + ((size_t)hp * 128 + n0 + r) * 128 + k4); float* t = sk + r * 132 + k4; t[0] = a.x; t[1] = a.y; t[2] = a.z; t[3] = a.w;
            const float4 b = *(const float4*)(wq + (size_t)(d0 + r) * 2048 + hp * 128 + k4); float* s = sw + r * 132 + k4; s[0] = b.x; s[1] = b.y; s[2] = b.z; s[3] = b.w; }
        __syncthreads();
        const int ni = tid >> 3, dj = tid & 7; float acc[8];
#pragma unroll
        for (int q = 0; q < 8; ++q) acc[q] = 0.f;
        for (int k = 0; k < 128; ++k) { const float a = sk[ni * 132 + k];
#pragma unroll
            for (int q = 0; q < 8; ++q) acc[q] += a * sw[(dj + 8 * q) * 132 + k]; }
#pragma unroll
        for (int q = 0; q < 8; ++q) WpT[((size_t)hp * 128 + n0 + ni) * 1024 + d0 + dj + 8 * q] = f2bf(acc[q]);
        __syncthreads();
    }
}
__device__ void hyena_filter_gen(const Params& p, float* lds) {
    const float* w1 = p.in[7]; const float* b1 = p.in[8]; const float* fr = p.in[9]; const float* w2 = p.in[10]; const float* b2 = p.in[11]; const float* w3 = p.in[12]; const float* dec = p.in[13];
    bf16_t* Fg = (bf16_t*)(p.ws + WS_FG); float* part = (float*)(p.ws + WS_PART);
    constexpr int NG = 3, NP = NG * 16;
    float* sfeat = lds; float* sh1 = sfeat + NP * 33; float* sh2 = sh1 + NP * 64;
    float* sw1 = sh2 + NP * 64; float* sw2 = sw1 + 33 * 64; float* sb1 = sw2 + 64 * 64; float* sb2 = sb1 + 64; float* sfr = sb2 + 64;
    const int tid = threadIdx.x, c = tid;
    for (int i = tid; i < 33 * 64; i += NTHREADS) sw1[i] = w1[i];
    for (int i = tid; i < 64 * 64; i += NTHREADS) sw2[i] = w2[i];
    if (tid < 64) { sb1[tid] = b1[tid]; sb2[tid] = b2[tid]; sfr[tid] = fr[tid]; }
    for (int idx = tid; idx < NP * 33; idx += NTHREADS) { const int q = idx / 33, f = idx % 33, it = (int)blockIdx.x + (q >> 4) * (int)gridDim.x;
        const int variant = it >= 512, L = variant ? L1 : L0, n = (variant ? it - 512 : it) * 16 + (q & 15); float val;
        if (f == 0) val = (float)n * (1.0f / (float)(L - 1));
        else { const int band = (f - 1) & 15; const float fj = 1e-4f + (float)band * ((15.0f - 1e-4f) / 15.0f); const float w = 6.283185307179586f * (float)n / (float)L; const float arg = fj * w;
               val = (f - 1) >= 16 ? -sinf(arg) : cosf(arg); }
        sfeat[idx] = val; }
    __syncthreads();
    for (int idx = tid; idx < NP * 64; idx += NTHREADS) { const int q = idx >> 6, j = idx & 63; float s = sb1[j];
#pragma unroll
        for (int f = 0; f < 33; ++f) s += sfeat[q * 33 + f] * sw1[f * 64 + j];
        sh1[idx] = sinf(sfr[j] * s); }
    __syncthreads();
    for (int idx = tid; idx < NP * 64; idx += NTHREADS) { const int q = idx >> 6, j = idx & 63; float s = sb2[j];
#pragma unroll 16
        for (int i = 0; i < 64; ++i) s += sh1[q * 64 + i] * sw2[i * 64 + j];
        sh2[idx] = sinf(sfr[j] * s); }
    __syncthreads();
    float acc0[NP], acc1[NP];
#pragma unroll
    for (int q = 0; q < NP; ++q) { acc0[q] = 0.f; acc1[q] = 0.f; }
#pragma unroll 2
    for (int j = 0; j < 64; ++j) { const float wa = w3[j * 1024 + c], wb = w3[j * 1024 + 512 + c];
#pragma unroll
        for (int q = 0; q < NP; ++q) { const float h = sh2[q * 64 + j]; acc0[q] += h * wa; acc1[q] += h * wb; } }
    const float a0 = fabsf(dec[c]), a1 = fabsf(dec[512 + c]);
    float sum0 = 0.f, sum1 = 0.f;
#pragma unroll
    for (int g = 0; g < NG; ++g) { const int it = (int)blockIdx.x + g * (int)gridDim.x;
        if (it < 768) { const int variant = it >= 512, L = variant ? L1 : L0, n0 = (variant ? it - 512 : it) * 16; const float tstep = 1.0f / (float)(L - 1);
            bf16_t* Fc = Fg + (variant ? (size_t)512 * 2 * L0 : 0) + (size_t)c * 2 * L; float s = 0.f;
#pragma unroll
            for (int pp = 0; pp < 16; ++pp) { const int n = n0 + pp; const float t = (float)n * tstep;
                const float v0 = acc0[g * 16 + pp] * expf(-t * a0), v1 = acc1[g * 16 + pp] * expf(-t * a1);
                s += fabsf(v0); Fc[L - n] = f2bf(v0);
                if (n >= 1) { s += fabsf(v1); Fc[L + n] = f2bf(v1); } else Fc[0] = 0; }
            if (variant) sum1 += s; else sum0 += s; } }
    part[((size_t)0 * 1024 + blockIdx.x) * 512 + c] = sum0;
    part[((size_t)1 * 1024 + blockIdx.x) * 512 + c] = sum1;
    __syncthreads();
}

__device__ __forceinline__ void unpack8(const u32x4 w, float (&f)[8]) { f[0] = bf_lo(w.x); f[1] = bf_hi(w.x); f[2] = bf_lo(w.y); f[3] = bf_hi(w.y); f[4] = bf_lo(w.z); f[5] = bf_hi(w.z); f[6] = bf_lo(w.w); f[7] = bf_hi(w.w); }
__device__ void phase_conv3(const Params& p, unsigned char* lds) {
    const bf16_t* PA = (const bf16_t*)p.out; const bf16_t* PH = (const bf16_t*)(p.ws + WS_PH);
    bf16_t* Ycat = (bf16_t*)(p.ws + WS_XB); bf16_t* zT = (bf16_t*)(p.ws + WS_ZT); bf16_t* x0T = (bf16_t*)((unsigned char*)p.out + OUT_X0T);
    const float* acw = p.in[4]; const float* hcw = p.in[5]; const float* hcb = p.in[6];
    bf16_t* sx0 = (bf16_t*)lds; bf16_t* sz = sx0 + 64 * 66;
    const int tid = threadIdx.x, r = tid >> 3, cg8 = tid & 7;
    const int ct = blockIdx.x & 7, c0 = ct * 64 + cg8 * 8;
    for (int tt = blockIdx.x >> 3; tt < 1024; tt += gridDim.x >> 3) {
        const int tok0 = tt * 64; int seq, L, tl; seq_of(tok0, seq, L, tl);
        const int tok = tok0 + r, pos = tl + r;
        const bool hp = pos > 0, hn = pos < L - 1;
        const u32x4 zero4 = {0u, 0u, 0u, 0u};
        { const bf16_t* row = PA + (size_t)tok * 1024 + c0;
          float ab[8], gc[8], gp[8], gn[8];
          unpack8(*(const u32x4*)row, ab); unpack8(*(const u32x4*)(row + 512), gc);
          unpack8(hp ? *(const u32x4*)(row - 1024 + 512) : zero4, gp); unpack8(hn ? *(const u32x4*)(row + 1024 + 512) : zero4, gn);
          float y[8];
#pragma unroll
          for (int k = 0; k < 8; ++k) y[k] = ab[k] * (acw[c0 + k] * gp[k] + acw[512 + c0 + k] * gc[k] + acw[1024 + c0 + k] * gn[k]);
          u32x4 w; w.x = pack2bf(y[0], y[1]); w.y = pack2bf(y[2], y[3]); w.z = pack2bf(y[4], y[5]); w.w = pack2bf(y[6], y[7]);
          *(u32x4*)(Ycat + (size_t)tok * DM + c0) = w; }
        { const bf16_t* row = PH + (size_t)tok * 1536 + c0; float hy[3][8];
#pragma unroll
          for (int part = 0; part < 3; ++part) { float vp[8], vc[8], vn[8]; const bf16_t* rp = row + part * 512; const int cc = part * 512 + c0;
              unpack8(*(const u32x4*)rp, vc); unpack8(hp ? *(const u32x4*)(rp - 1536) : zero4, vp); unpack8(hn ? *(const u32x4*)(rp + 1536) : zero4, vn);
#pragma unroll
              for (int k = 0; k < 8; ++k) hy[part][k] = hcw[cc + k] * vp[k] + hcw[1536 + cc + k] * vc[k] + hcw[3072 + cc + k] * vn[k] + hcb[cc + k]; }
#pragma unroll
          for (int k = 0; k < 8; ++k) { sx0[(cg8 * 8 + k) * 66 + r] = f2bf(hy[0][k]); sz[(cg8 * 8 + k) * 66 + r] = f2bf(hy[2][k] * hy[1][k]); } }
        __syncthreads();
        { const int c = tid >> 3, ch = tid & 7; const unsigned* s0 = (const unsigned*)(sx0 + c * 66 + ch * 8); const unsigned* s1 = (const unsigned*)(sz + c * 66 + ch * 8);
          u32x4 w0 = {s0[0], s0[1], s0[2], s0[3]}, w1 = {s1[0], s1[1], s1[2], s1[3]};
          const size_t o = seq_base_T(seq) + (size_t)(ct * 64 + c) * L + tl + ch * 8;
          *(u32x4*)(x0T + o) = w0; *(u32x4*)(zT + o) = w1; }
        __syncthreads();
    }
}

__device__ void phase_longconv(const Params& p, unsigned char* ldsg) {
    LAS unsigned char* lds = (LAS unsigned char*)ldsg;
    const bf16_t* Fg = (const bf16_t*)(p.ws + WS_FG); const float* part = (const float*)(p.ws + WS_PART);
    const bf16_t* zT = (const bf16_t*)(p.ws + WS_ZT); const bf16_t* x0T = (const bf16_t*)((const unsigned char*)p.out + OUT_X0T);
    bf16_t* yhT = (bf16_t*)(p.ws + WS_PH); const float* hyb = p.in[14];
    constexpr int ZSTR = 160, F1OFF = 32768 + 64, ZOFF = 65664, ZERO = ZOFF + 4 * 128 * ZSTR, SCAL = ZERO + 176;
    const int tid = threadIdx.x, wave = __builtin_amdgcn_readfirstlane(tid >> 6), lane = tid & 63, n = lane & 15, kq = lane >> 4;
    for (int u = blockIdx.x; u < 1024; u += gridDim.x) {
        const int variant = u >= 512, c = u & 511, L = variant ? L1 : L0, nb = L >> 6, nseq = variant ? 8 : 4;
        const bf16_t* Fc = Fg + (variant ? (size_t)512 * 2 * L0 : 0) + (size_t)c * 2 * L;
        for (int i = tid; i < (2 * L) / 8; i += NTHREADS) *(LAS u32x4*)(lds + i * 16) = ((const u32x4*)Fc)[i];
        for (int i = tid; i < nseq * (L / 8); i += NTHREADS) { const int b = i / (L / 8), q = i % (L / 8);
            const int seq = variant ? 4 + b : b;
            *(LAS u32x4*)(lds + ZOFF + (b * nb + (q >> 3)) * ZSTR + (q & 7) * 16) = *(const u32x4*)(zT + seq_base_T(seq) + (size_t)c * L + q * 8); }
        if (tid < 36) *(LAS unsigned*)(lds + ZERO + tid * 4) = 0u;
        if (wave == 0) { float s = 0.f; for (int b = lane; b < (int)gridDim.x; b += 64) s += part[((size_t)variant * 1024 + b) * 512 + c];
#pragma unroll
            for (int o = 32; o >= 1; o >>= 1) s += __shfl_xor(s, o);
            if (lane == 0) *(LAS float*)(lds + SCAL) = 1.0f / s; }
        __syncthreads();
        for (int i = tid; i < L; i += NTHREADS) { const unsigned a = *(LAS unsigned*)(lds + i * 4); const unsigned b = (i + 1 < L) ? *(LAS unsigned*)(lds + i * 4 + 4) : 0u;
            *(LAS unsigned*)(lds + F1OFF + i * 4) = (a >> 16) | (b << 16); }
        __syncthreads();
        const float inv = *(LAS float*)(lds + SCAL);
        const int b = variant ? wave : (wave >> 1), J0 = variant ? 0 : (wave & 1) * 64;
        f32x4 acc[4][4];
#pragma unroll
        for (int mi = 0; mi < 4; ++mi)
#pragma unroll
            for (int nt = 0; nt < 4; ++nt) acc[mi][nt] = (f32x4){0.f, 0.f, 0.f, 0.f};
        const int cl = ((n & 1) ? F1OFF - 2 : 0) + 2 * (L + 8 * kq - n);
        const int zrow = ZOFF + b * nb * ZSTR + kq * 16;
        const int dbeg = J0 - (nb - 1), dend = J0 + 63, zzero = ZERO + kq * 16;
#define LC_LOAD(A_, B_, dd) do { const int d_ = min((dd), dend); const int abase_ = cl - 128 * d_; \
            _Pragma("unroll") for (int ai = 0; ai < 6; ++ai) { const LAS unsigned* fp = (const LAS unsigned*)(lds + abase_ - 32 * (ai - 2)); const u32x4 w_ = {fp[0], fp[1], fp[2], fp[3]}; A_[ai] = __builtin_bit_cast(bf16x8, w_); } \
            _Pragma("unroll") for (int nt = 0; nt < 4; ++nt) { const int blk_ = J0 + 16 * nt + n - d_; const int ad_ = ((unsigned)blk_ < (unsigned)nb) ? zrow + blk_ * ZSTR : zzero; \
                B_[2 * nt] = *(const LAS bf16x8*)(lds + ad_); B_[2 * nt + 1] = *(const LAS bf16x8*)(lds + ad_ + 64); } } while (0)
#define LC_MMA(A_, B_, dd) do { const int d_ = (dd); \
            _Pragma("unroll") for (int nt = 0; nt < 4; ++nt) { const int lo_ = J0 + 16 * nt - (nb - 1), hi_ = J0 + 16 * nt + 15; \
                if (d_ >= lo_ && d_ <= hi_) { \
                    _Pragma("unroll") for (int mi = 0; mi < 4; ++mi) { acc[mi][nt] = __builtin_amdgcn_mfma_f32_16x16x32_bf16(A_[mi + 2], B_[2 * nt], acc[mi][nt], 0, 0, 0); \
                                                                        acc[mi][nt] = __builtin_amdgcn_mfma_f32_16x16x32_bf16(A_[mi], B_[2 * nt + 1], acc[mi][nt], 0, 0, 0); } } } } while (0)
        bf16x8 aX[6], bX[8], aY[6], bY[8];
        LC_LOAD(aX, bX, dbeg);
        for (int d = dbeg; d <= dend; d += 2) {
            LC_LOAD(aY, bY, d + 1);
            LC_MMA(aX, bX, d);
            LC_LOAD(aX, bX, d + 2);
            if (d + 1 <= dend) LC_MMA(aY, bY, d + 1);
        }
#undef LC_LOAD
#undef LC_MMA
        const float hb = hyb[c]; const int seq = variant ? 4 + b : b; const size_t gbase = seq_base_T(seq) + (size_t)c * L;
#pragma unroll
        for (int nt = 0; nt < 4; ++nt) { const int J = J0 + 16 * nt + n;
#pragma unroll
            for (int mi = 0; mi < 4; ++mi) { const int i0 = 16 * mi + 4 * kq; const size_t o = gbase + (size_t)J * 64 + i0;
                const u32x2 zw = *(const LAS u32x2*)(lds + ZOFF + (b * nb + J) * ZSTR + i0 * 2); const u32x2 xw = *(const u32x2*)(x0T + o);
                const f32x4 v = acc[mi][nt];
                const float y0 = bf_lo(xw.x) * (v[0] * inv + hb * bf_lo(zw.x)), y1 = bf_hi(xw.x) * (v[1] * inv + hb * bf_hi(zw.x));
                const float y2 = bf_lo(xw.y) * (v[2] * inv + hb * bf_lo(zw.y)), y3 = bf_hi(xw.y) * (v[3] * inv + hb * bf_hi(zw.y));
                u32x2 w; w.x = pack2bf(y0, y1); w.y = pack2bf(y2, y3); *(u32x2*)(yhT + o) = w; } }
        __syncthreads();
    }
}

__device__ void phase_yh_transpose(const Params& p, unsigned char* lds) {
    const bf16_t* yhT = (const bf16_t*)(p.ws + WS_PH); bf16_t* Ycat = (bf16_t*)(p.ws + WS_XB);
    bf16_t* st = (bf16_t*)lds; const int tid = threadIdx.x;
    for (int u = blockIdx.x; u < 8192; u += gridDim.x) {
        const int tt = u >> 3, ct = u & 7, tok0 = tt * 64; int seq, L, tl; seq_of(tok0, seq, L, tl);
        { const int c = tid >> 3, ch = tid & 7; const u32x4 w = *(const u32x4*)(yhT + seq_base_T(seq) + (size_t)(ct * 64 + c) * L + tl + ch * 8);
          unsigned* s = (unsigned*)(st + c * 66 + ch * 8); s[0] = w.x; s[1] = w.y; s[2] = w.z; s[3] = w.w; }
        __syncthreads();
        { const int r = tid >> 3, cg8 = tid & 7; unsigned short v[8];
#pragma unroll
          for (int k = 0; k < 8; ++k) v[k] = st[(cg8 * 8 + k) * 66 + r];
          u32x4 w; w.x = v[0] | ((unsigned)v[1] << 16); w.y = v[2] | ((unsigned)v[3] << 16); w.z = v[4] | ((unsigned)v[5] << 16); w.w = v[6] | ((unsigned)v[7] << 16);
          *(u32x4*)(Ycat + (size_t)(tok0 + r) * DM + 512 + ct * 64 + cg8 * 8) = w; }
        __syncthreads();
    }
}

template <bool OUT_BF16>
__device__ __forceinline__ void ln_rows2(const bf16_t* __restrict__ hin, float* __restrict__ outf, bf16_t* __restrict__ outb, const float* __restrict__ g, const float* __restrict__ be, int row_lo, int row_hi, int wv0, int nwv) {
    const int lane = threadIdx.x & 63;
    for (int row = row_lo + wv0 * 2; row < row_hi; row += nwv * 2) {
        float4 v[2][4]; float s[2] = {0.f, 0.f};
#pragma unroll
        for (int r = 0; r < 2; ++r)
#pragma unroll
            for (int k = 0; k < 4; ++k) { const u32x2 w = ((const u32x2*)(hin + (size_t)(row + r) * DM))[lane + 64 * k]; v[r][k] = make_float4(bf_lo(w.x), bf_hi(w.x), bf_lo(w.y), bf_hi(w.y)); }
#pragma unroll
        for (int r = 0; r < 2; ++r)
#pragma unroll
            for (int k = 0; k < 4; ++k) s[r] += (v[r][k].x + v[r][k].y) + (v[r][k].z + v[r][k].w);
#pragma unroll
        for (int o = 32; o >= 1; o >>= 1) { s[0] += __shfl_xor(s[0], o); s[1] += __shfl_xor(s[1], o); }
        float q[2] = {0.f, 0.f}; const float mu[2] = {s[0] * (1.0f / DM), s[1] * (1.0f / DM)};
#pragma unroll
        for (int r = 0; r < 2; ++r)
#pragma unroll
            for (int k = 0; k < 4; ++k) { const float a = v[r][k].x - mu[r], b = v[r][k].y - mu[r], c = v[r][k].z - mu[r], d = v[r][k].w - mu[r]; q[r] += (a * a + b * b) + (c * c + d * d); }
#pragma unroll
        for (int o = 32; o >= 1; o >>= 1) { q[0] += __shfl_xor(q[0], o); q[1] += __shfl_xor(q[1], o); }
        const float rstd[2] = {1.0f / sqrtf(q[0] * (1.0f / DM) + LN_EPS_C), 1.0f / sqrtf(q[1] * (1.0f / DM) + LN_EPS_C)};
#pragma unroll
        for (int k = 0; k < 4; ++k) { const float4 gg = ((const float4*)g)[lane + 64 * k], bb = ((const float4*)be)[lane + 64 * k];
#pragma unroll
            for (int r = 0; r < 2; ++r) { float4 y;
                y.x = (v[r][k].x - mu[r]) * rstd[r] * gg.x + bb.x; y.y = (v[r][k].y - mu[r]) * rstd[r] * gg.y + bb.y; y.z = (v[r][k].z - mu[r]) * rstd[r] * gg.z + bb.z; y.w = (v[r][k].w - mu[r]) * rstd[r] * gg.w + bb.w;
                if (OUT_BF16) { u32x2 w; w.x = pack2bf(y.x, y.y); w.y = pack2bf(y.z, y.w); ((u32x2*)(outb + (size_t)(row + r) * DM))[lane + 64 * k] = w; }
                else { const f32x4 yv = {y.x, y.y, y.z, y.w}; __builtin_nontemporal_store(yv, (f32x4*)(outf + (size_t)(row + r) * DM) + lane + 64 * k); } } }
    }
}
__device__ void phase_ln1_panel(const Params& p, int pm) { ln_rows2<true>((const bf16_t*)p.out, nullptr, (bf16_t*)(p.ws + WS_XB), p.in[16], p.in[17], pm * 256, pm * 256 + 256, threadIdx.x >> 6, 8); }

__device__ __forceinline__ int f2key(float f) { const int b = __float_as_int(f); return b ^ ((b >> 31) & 0x7fffffff); }
__device__ __forceinline__ float key2f(int k) { return __int_as_float(k ^ ((k >> 31) & 0x7fffffff)); }
__device__ __forceinline__ void sort16_desc(int (&k)[16]) {
#pragma unroll
    for (int sz = 2; sz <= 16; sz <<= 1)
#pragma unroll
        for (int j = sz >> 1; j > 0; j >>= 1)
#pragma unroll
            for (int i = 0; i < 16; ++i) { const int l = i ^ j;
                if (l > i) { const bool desc = ((i & sz) == 0); const int hi = max(k[i], k[l]), lo = min(k[i], k[l]); k[i] = desc ? hi : lo; k[l] = desc ? lo : hi; } }
}
__device__ __forceinline__ void merge_top16(int (&a)[16], const int (&b)[16]) {
#pragma unroll
    for (int i = 0; i < 16; ++i) a[i] = max(a[i], b[15 - i]);
#pragma unroll
    for (int j = 8; j > 0; j >>= 1)
#pragma unroll
        for (int i = 0; i < 16; ++i) { const int l = i ^ j; if (l > i) { const int hi = max(a[i], a[l]), lo = min(a[i], a[l]); a[i] = hi; a[l] = lo; } }
}
__device__ __forceinline__ void chunk_keys(const u32x4 w0, const u32x4 w1, int idx0, int (&k)[16]) {
    const unsigned ww[8] = {w0.x, w0.y, w0.z, w0.w, w1.x, w1.y, w1.z, w1.w};
#pragma unroll
    for (int e = 0; e < 8; ++e) { const h2_t h = __builtin_bit_cast(h2_t, ww[e]);
        k[2 * e] = (f2key((float)h.x) & ~0x7F) | (idx0 + 2 * e); k[2 * e + 1] = (f2key((float)h.y) & ~0x7F) | (idx0 + 2 * e + 1); }
}
__device__ __forceinline__ void row_top16(const unsigned short* __restrict__ row, int (&run)[16]) {
    const u32x4* rp = (const u32x4*)row;
    u32x4 w0 = rp[0], w1 = rp[1];
    chunk_keys(w0, w1, 0, run); sort16_desc(run);
    w0 = rp[2]; w1 = rp[3];
#pragma unroll 1
    for (int ch = 1; ch < 8; ++ch) {
        int k[16]; chunk_keys(w0, w1, ch * 16, k);
        if (ch < 7) { w0 = rp[2 * ch + 2]; w1 = rp[2 * ch + 3]; }
        sort16_desc(k); merge_top16(run, k);
    }
}
__device__ void phase_topk(const Params& p, unsigned char* ldsg, int gt_lo, int gt_hi, int gt_stride) {
    const unsigned short* S = (const unsigned short*)(p.ws + WS_PH);
    int* eidx = (int*)(p.ws + WS_EIDX); float* gate = (float*)(p.ws + WS_GATE);
    int* sl = (int*)ldsg + threadIdx.x * 33;
    constexpr int OFF[16] = {0, 16, 24, 29, 33, 36, 38, 40, 42, 43, 44, 45, 46, 47, 48, 49};
    for (int gt = gt_lo + threadIdx.x; gt < gt_hi; gt += gt_stride) {
        const int t = gt >> 3, h = gt & 7;
        int a[16], b[16];
        row_top16(S + (size_t)t * 2048 + (h * 2 + 0) * 128, a);
        row_top16(S + (size_t)t * 2048 + (h * 2 + 1) * 128, b);
#pragma unroll
        for (int i = 0; i < 16; ++i) { sl[i] = a[i]; sl[16 + i] = b[i]; }
        float va[16], vb[16];
#pragma unroll
        for (int i = 0; i < 16; ++i) { va[i] = key2f(a[i] & ~0x7F); vb[i] = key2f(b[i] & ~0x7F); }
        int cnd[4][16];
#pragma unroll
        for (int q = 0; q < 4; ++q)
#pragma unroll
            for (int i = 0; i < 16; ++i) cnd[q][i] = (int)0x80000000;
#pragma unroll
        for (int i = 0; i < 16; ++i)
#pragma unroll
            for (int j = 0; j < 16 / (i + 1); ++j) { const int pos = OFF[i] + j; cnd[pos >> 4][pos & 15] = (f2key(va[i] + vb[j]) & ~0xFF) | (i * 16 + j); }
        sort16_desc(cnd[0]); sort16_desc(cnd[1]); sort16_desc(cnd[2]); sort16_desc(cnd[3]);
        merge_top16(cnd[0], cnd[1]); merge_top16(cnd[2], cnd[3]); merge_top16(cnd[0], cnd[2]);
        float best[16]; int ei[16]; float m = -3.0e38f;
#pragma unroll
        for (int r = 0; r < 16; ++r) { const int code = cnd[0][r] & 0xFF; const int ka = sl[code >> 4], kb = sl[16 + (code & 15)];
            ei[r] = (ka & 0x7F) * 128 + (kb & 0x7F); best[r] = key2f(ka & ~0x7F) + key2f(kb & ~0x7F); m = fmaxf(m, best[r]); }
        float se = 0.f;
#pragma unroll
        for (int r = 0; r < 16; ++r) { best[r] = __expf(best[r] - m); se += best[r]; }
        const float inv = 1.0f / se;
#pragma unroll
        for (int q = 0; q < 4; ++q) { ((int4*)(eidx + (size_t)gt * 16))[q] = make_int4(ei[4 * q], ei[4 * q + 1], ei[4 * q + 2], ei[4 * q + 3]);
            ((float4*)(gate + (size_t)gt * 16))[q] = make_float4(best[4 * q] * inv, best[4 * q + 1] * inv, best[4 * q + 2] * inv, best[4 * q + 3] * inv); }
    }
}

typedef float f32x2 __attribute__((ext_vector_type(2)));
template <int CTRL> __device__ __forceinline__ float dpp_f(float v) { return __int_as_float(__builtin_amdgcn_update_dpp(0, __float_as_int(v), CTRL, 0xF, 0xF, false)); }
__device__ __forceinline__ void pk_load_ev(int (&ev)[16], const int* __restrict__ eidx, int tok, int q) {
    const int4* ep = (const int4*)(eidx + (size_t)tok * 128 + 16 * q);
#pragma unroll
    for (int k = 0; k < 4; ++k) { const int4 t = ep[k]; ev[4 * k] = t.x; ev[4 * k + 1] = t.y; ev[4 * k + 2] = t.z; ev[4 * k + 3] = t.w; }
}
__device__ __forceinline__ void pk_load_rows(u32x4 (&r)[16], const int (&ev)[16], const unsigned char* __restrict__ tab, unsigned loff) {
#pragma unroll
    for (int s = 0; s < 16; ++s) r[s] = *(const u32x4*)(tab + ((unsigned)ev[s] * 128u + loff));
}
__device__ __forceinline__ void pk_load_x(f32x2 (&xv)[8], const bf16_t* __restrict__ xrow) {
    const u32x4 a = ((const u32x4*)xrow)[0], b = ((const u32x4*)xrow)[1];
    xv[0] = (f32x2){bf_lo(a.x), bf_hi(a.x)}; xv[1] = (f32x2){bf_lo(a.y), bf_hi(a.y)}; xv[2] = (f32x2){bf_lo(a.z), bf_hi(a.z)}; xv[3] = (f32x2){bf_lo(a.w), bf_hi(a.w)};
    xv[4] = (f32x2){bf_lo(b.x), bf_hi(b.x)}; xv[5] = (f32x2){bf_lo(b.y), bf_hi(b.y)}; xv[6] = (f32x2){bf_lo(b.z), bf_hi(b.z)}; xv[7] = (f32x2){bf_lo(b.w), bf_hi(b.w)};
}
__device__ __forceinline__ float xchg4(float v) { return dpp_f<0x1B>(dpp_f<0x141>(v)); }
__device__ __forceinline__ void pk_u_compute(const u32x4 (&r)[16], const f32x2 (&xv)[8], bf16_t* __restrict__ pr, int c) {
    float d[16];
#pragma unroll
    for (int s = 0; s < 16; ++s) {
        f32x2 acc = {0.f, 0.f};
        acc += __builtin_amdgcn_cvt_pk_f32_fp8((int)r[s].x, false) * xv[0]; acc += __builtin_amdgcn_cvt_pk_f32_fp8((int)r[s].x, true) * xv[1];
        acc += __builtin_amdgcn_cvt_pk_f32_fp8((int)r[s].y, false) * xv[2]; acc += __builtin_amdgcn_cvt_pk_f32_fp8((int)r[s].y, true) * xv[3];
        acc += __builtin_amdgcn_cvt_pk_f32_fp8((int)r[s].z, false) * xv[4]; acc += __builtin_amdgcn_cvt_pk_f32_fp8((int)r[s].z, true) * xv[5];
        acc += __builtin_amdgcn_cvt_pk_f32_fp8((int)r[s].w, false) * xv[6]; acc += __builtin_amdgcn_cvt_pk_f32_fp8((int)r[s].w, true) * xv[7];
        d[s] = acc.x + acc.y;
    }
    float r1[8]; const bool b2 = (c & 4) != 0;
#pragma unroll
    for (int k = 0; k < 8; ++k) { const float send = b2 ? d[k] : d[k + 8], keep = b2 ? d[k + 8] : d[k]; r1[k] = keep + xchg4(send); }
    float r2[4]; const bool b1 = (c & 2) != 0;
#pragma unroll
    for (int k = 0; k < 4; ++k) { const float send = b1 ? r1[k] : r1[k + 4], keep = b1 ? r1[k + 4] : r1[k]; r2[k] = keep + dpp_f<0x4E>(send); }
    float r3[2]; const bool b0 = (c & 1) != 0;
#pragma unroll
    for (int k = 0; k < 2; ++k) { const float send = b0 ? r2[k] : r2[k + 2], keep = b0 ? r2[k + 2] : r2[k]; r3[k] = keep + dpp_f<0xB1>(send); }
    *(unsigned*)(pr + 2 * c) = pack2bf(r3[0], r3[1]);
}
__device__ void phase_peer_u(const Params& p) {
    const bf16_t* x1 = (const bf16_t*)(p.ws + WS_XB); const int* eidx = (const int*)(p.ws + WS_EIDX); bf16_t* partd = (bf16_t*)(p.ws + WS_PARTD);
    const int wave = threadIdx.x >> 6, lane = threadIdx.x & 63, q = lane >> 3, c = lane & 7;
    const int xs = blockIdx.x & 7, y = blockIdx.x >> 3, nY = gridDim.x >> 3, step = nY * 8;
    const unsigned char* tab = p.ws + WS_U8 + (size_t)xs * (16384 * 128); const unsigned loff = 16u * c;
    const bf16_t* xcol = x1 + 128 * xs + 16 * c;
    bf16_t* pbase = partd + (size_t)xs * NTOK * 128 + 16 * q;
    const int tok0 = y * 8 + wave;
    if (tok0 >= NTOK) return;
    const int ntok = (NTOK - tok0 + step - 1) / step, last = tok0 + (ntok - 1) * step;
    bf16_t* dummy = (bf16_t*)(p.ws + WS_DUMMY) + (size_t)(blockIdx.x * 8 + wave) * 128 + 16 * q;
    int ev[16]; f32x2 xvA[8], xvB[8]; u32x4 rA[16], rB[16];
    pk_load_ev(ev, eidx, tok0, q); pk_load_x(xvA, xcol + (size_t)tok0 * DM); pk_load_rows(rA, ev, tab, loff);
    pk_load_ev(ev, eidx, min(tok0 + step, last), q);
    for (int i = 0; i < ntok; i += 2) {
        const int tA = tok0 + i * step, tB = min(tA + step, last), tC = min(tA + 2 * step, last), tD = min(tA + 3 * step, last);
        pk_load_x(xvB, xcol + (size_t)tB * DM); pk_load_rows(rB, ev, tab, loff);
        pk_load_ev(ev, eidx, tC, q);
        pk_u_compute(rA, xvA, pbase + (size_t)tA * 128, c);
        pk_load_x(xvA, xcol + (size_t)tC * DM); pk_load_rows(rA, ev, tab, loff);
        pk_load_ev(ev, eidx, tD, q);
        pk_u_compute(rB, xvB, (i + 1 < ntok) ? pbase + (size_t)tB * 128 : dummy, c);
    }
}
__device__ __forceinline__ float gelu_erf(float d) { return 0.5f * d * (1.0f + erff(d * 0.70710678118654752f)); }
__device__ void phase_peer_coef(const Params& p) {
    const bf16_t* partd = (const bf16_t*)(p.ws + WS_PARTD); float* gate = (float*)(p.ws + WS_GATE);
    for (size_t i = (size_t)blockIdx.x * NTHREADS + threadIdx.x; i < (size_t)NTOK * 128 / 8; i += (size_t)gridDim.x * NTHREADS) {
        u32x4 t[8];
#pragma unroll
        for (int x = 0; x < 8; ++x) t[x] = ((const u32x4*)(partd + (size_t)x * NTOK * 128))[i];
        float4 g0 = ((const float4*)gate)[2 * i], g1 = ((const float4*)gate)[2 * i + 1];
        float sm[8];
#pragma unroll
        for (int k = 0; k < 8; ++k) sm[k] = 0.f;
#pragma unroll
        for (int x = 0; x < 8; ++x) { sm[0] += bf_lo(t[x].x); sm[1] += bf_hi(t[x].x); sm[2] += bf_lo(t[x].y); sm[3] += bf_hi(t[x].y); sm[4] += bf_lo(t[x].z); sm[5] += bf_hi(t[x].z); sm[6] += bf_lo(t[x].w); sm[7] += bf_hi(t[x].w); }
        g0.x *= gelu_erf(sm[0] * (1.0f / U_SCALE)); g0.y *= gelu_erf(sm[1] * (1.0f / U_SCALE)); g0.z *= gelu_erf(sm[2] * (1.0f / U_SCALE)); g0.w *= gelu_erf(sm[3] * (1.0f / U_SCALE));
        g1.x *= gelu_erf(sm[4] * (1.0f / U_SCALE)); g1.y *= gelu_erf(sm[5] * (1.0f / U_SCALE)); g1.z *= gelu_erf(sm[6] * (1.0f / U_SCALE)); g1.w *= gelu_erf(sm[7] * (1.0f / U_SCALE));
        ((float4*)gate)[2 * i] = g0; ((float4*)gate)[2 * i + 1] = g1;
    }
}
__device__ __forceinline__ void pk_load_cf(float (&cf)[16], const float* __restrict__ coef, int tok, int q) {
    const float4* cp = (const float4*)(coef + (size_t)tok * 128 + 16 * q);
#pragma unroll
    for (int k = 0; k < 4; ++k) { const float4 f = cp[k]; cf[4 * k] = f.x; cf[4 * k + 1] = f.y; cf[4 * k + 2] = f.z; cf[4 * k + 3] = f.w; }
}
__device__ __forceinline__ void pk_v_compute(const u32x4 (&r)[16], const float (&cf)[16], unsigned xw, bf16_t* __restrict__ orow, int q) {
    f32x2 acc[8];
#pragma unroll
    for (int k = 0; k < 8; ++k) acc[k] = (f32x2){0.f, 0.f};
#pragma unroll
    for (int s = 0; s < 16; ++s) { const f32x2 c2 = {cf[s], cf[s]};
        acc[0] += __builtin_amdgcn_cvt_pk_f32_fp8((int)r[s].x, false) * c2; acc[1] += __builtin_amdgcn_cvt_pk_f32_fp8((int)r[s].x, true) * c2;
        acc[2] += __builtin_amdgcn_cvt_pk_f32_fp8((int)r[s].y, false) * c2; acc[3] += __builtin_amdgcn_cvt_pk_f32_fp8((int)r[s].y, true) * c2;
        acc[4] += __builtin_amdgcn_cvt_pk_f32_fp8((int)r[s].z, false) * c2; acc[5] += __builtin_amdgcn_cvt_pk_f32_fp8((int)r[s].z, true) * c2;
        acc[6] += __builtin_amdgcn_cvt_pk_f32_fp8((int)r[s].w, false) * c2; acc[7] += __builtin_amdgcn_cvt_pk_f32_fp8((int)r[s].w, true) * c2; }
    f32x2 b4[4];
#pragma unroll
    for (int k = 0; k < 4; ++k) { const auto sx = __builtin_amdgcn_permlane32_swap(__float_as_uint(acc[k].x), __float_as_uint(acc[k + 4].x), false, false);
        const auto sy = __builtin_amdgcn_permlane32_swap(__float_as_uint(acc[k].y), __float_as_uint(acc[k + 4].y), false, false);
        b4[k] = (f32x2){__uint_as_float(sx[0]) + __uint_as_float(sx[1]), __uint_as_float(sy[0]) + __uint_as_float(sy[1])}; }
    f32x2 b2[2];
#pragma unroll
    for (int k = 0; k < 2; ++k) { const auto sx = __builtin_amdgcn_permlane16_swap(__float_as_uint(b4[k].x), __float_as_uint(b4[k + 2].x), false, false);
        const auto sy = __builtin_amdgcn_permlane16_swap(__float_as_uint(b4[k].y), __float_as_uint(b4[k + 2].y), false, false);
        b2[k] = (f32x2){__uint_as_float(sx[0]) + __uint_as_float(sx[1]), __uint_as_float(sy[0]) + __uint_as_float(sy[1])}; }
    f32x2 b1;
    { const bool up = (q & 1) != 0; const f32x2 send = up ? b2[0] : b2[1], keep = up ? b2[1] : b2[0];
      b1 = (f32x2){keep.x + dpp_f<0x128>(send.x), keep.y + dpp_f<0x128>(send.y)}; }
    const int co = 8 * (q >> 2) + 4 * ((q >> 1) & 1) + 2 * (q & 1);
    unsigned* op = (unsigned*)(orow + co);
    *op = pack2bf(ALPHA_C * bf_lo(xw) + b1.x * (1.0f / V_SCALE), ALPHA_C * bf_hi(xw) + b1.y * (1.0f / V_SCALE));
}
__device__ void phase_peer_v(const Params& p) {
    float* out = p.out; const int* eidx = (const int*)(p.ws + WS_EIDX); const float* coef = (const float*)(p.ws + WS_GATE);
    const int wave = threadIdx.x >> 6, lane = threadIdx.x & 63, q = lane >> 3, c = lane & 7;
    const int xs = blockIdx.x & 7, y = blockIdx.x >> 3, nY = gridDim.x >> 3, step = nY * 8;
    const unsigned char* tab = p.ws + WS_V8 + (size_t)xs * (16384 * 128); const unsigned loff = 16u * c;
    bf16_t* ocol = (bf16_t*)(p.ws + WS_XB) + 128 * xs + 16 * c;
    const int tok0 = y * 8 + wave;
    if (tok0 >= NTOK) return;
    const int ntok = (NTOK - tok0 + step - 1) / step, last = tok0 + (ntok - 1) * step;
    bf16_t* dummy = (bf16_t*)(p.ws + WS_DUMMY) + (size_t)(blockIdx.x * 8 + wave) * 128 + 16 * c;
    const int co = 8 * (q >> 2) + 4 * ((q >> 1) & 1) + 2 * (q & 1);
    int ev[16]; float cfA[16], cfB[16]; u32x4 rA[16], rB[16]; unsigned xrA, xrB;
    const bf16_t* xres = (const bf16_t*)(p.ws + WS_XB) + 128 * xs + 16 * c + co;
    pk_load_ev(ev, eidx, tok0, q); pk_load_cf(cfA, coef, tok0, q); xrA = *(const unsigned*)(xres + (size_t)tok0 * DM); pk_load_rows(rA, ev, tab, loff);
    pk_load_ev(ev, eidx, min(tok0 + step, last), q);
    for (int i = 0; i < ntok; i += 2) {
        const int tA = tok0 + i * step, tB = min(tA + step, last), tC = min(tA + 2 * step, last), tD = min(tA + 3 * step, last);
        pk_load_cf(cfB, coef, tB, q); xrB = *(const unsigned*)(xres + (size_t)tB * DM); pk_load_rows(rB, ev, tab, loff);
        pk_load_ev(ev, eidx, tC, q);
        pk_v_compute(rA, cfA, xrA, ocol + (size_t)tA * DM, q);
        pk_load_cf(cfA, coef, tC, q); xrA = *(const unsigned*)(xres + (size_t)tC * DM); pk_load_rows(rA, ev, tab, loff);
        pk_load_ev(ev, eidx, tD, q);
        pk_v_compute(rB, cfB, xrB, (i + 1 < ntok) ? ocol + (size_t)tB * DM : dummy, q);
    }
}
__device__ void phase_ln2(const Params& p) { ln_rows2<false>((const bf16_t*)(p.ws + WS_XB), p.out, nullptr, p.in[22], p.in[23], 0, NTOK, blockIdx.x * 8 + (threadIdx.x >> 6), gridDim.x * 8); }

#ifdef CONV_CHECK
constexpr size_t WS_CHK = 496 * MiB;
__device__ void conv_check(const Params& p) {
    const bf16_t* Fg = (const bf16_t*)(p.ws + WS_FG); const float* part = (const float*)(p.ws + WS_PART);
    const bf16_t* zT = (const bf16_t*)(p.ws + WS_ZT); const bf16_t* x0T = (const bf16_t*)((const unsigned char*)p.out + OUT_X0T);
    const bf16_t* yhT = (const bf16_t*)(p.ws + WS_PH); const float* hyb = p.in[14]; float* chk = (float*)(p.ws + WS_CHK);
    const int wave = threadIdx.x >> 6, lane = threadIdx.x & 63; const unsigned w = blockIdx.x * 8 + wave;
    const int seq = w % 12, variant = seq >= 4, L = variant ? L1 : L0, c = (w * 37u) % 512u; const unsigned sel = (w / 12u) % 8u;
    int t = (int)(((w * 2654435761u) >> 7) % (unsigned)L);
    if (sel == 0) t = 0; else if (sel == 1) t = L - 1; else if (sel == 2) t = 63; else if (sel == 3) t = 64; else if (sel == 4) t = L / 2;
    const bf16_t* Fc = Fg + (variant ? (size_t)512 * 2 * L0 : 0) + (size_t)c * 2 * L; const bf16_t* zc = zT + seq_base_T(seq) + (size_t)c * L;
    float sacc = 0.f; for (int s2 = lane; s2 < L; s2 += 64) sacc += __uint_as_float((unsigned)zc[s2] << 16) * __uint_as_float((unsigned)Fc[L - (t - s2)] << 16);
    float nrm = 0.f; for (int b = lane; b < (int)gridDim.x; b += 64) nrm += part[((size_t)variant * 1024 + b) * 512 + c];
#pragma unroll
    for (int o = 32; o >= 1; o >>= 1) { sacc += __shfl_xor(sacc, o); nrm += __shfl_xor(nrm, o); }
    const float x0 = __uint_as_float((unsigned)x0T[seq_base_T(seq) + (size_t)c * L + t] << 16), zt = __uint_as_float((unsigned)zc[t] << 16);
    const float ref = x0 * (sacc / nrm + hyb[c] * zt), got = __uint_as_float((unsigned)yhT[seq_base_T(seq) + (size_t)c * L + t] << 16);
    if (lane == 0) { atomicAdd(chk, (got - ref) * (got - ref)); atomicAdd(chk + 1, ref * ref); }
}
#endif
struct PanelOrder {
    int pm, nN;
    __device__ bool next(int i, pg8::Unit& u) const { if (i >= nN) return false; u.pm = pm; u.pn = i; return true; }
    __device__ __forceinline__ void a_ready(const pg8::Unit&) const {}
    __device__ __forceinline__ void done(const pg8::Unit&) const {}
};
__device__ __forceinline__ void block_handoff() { asm volatile("s_waitcnt vmcnt(0) lgkmcnt(0)" ::: "memory"); __syncthreads(); }
__device__ void phase_panel_chain(const Params& p, unsigned char* lds) {
    unsigned char* ws = p.ws;
    const int pm = blockIdx.x;
    if (pm < NTOK / 256) {
        { pg8::Gemm g{(const bf16_t*)(ws + WS_XB), (const bf16_t*)(ws + WS_WOUTT), NTOK, DM, DM}; PanelOrder S{pm, DM / 256};
          EpiH1 E{p.in[0], p.in[1], (bf16_t*)p.out};
          pg8::gemm_phase<EpiH1, PanelOrder, false>((LAS unsigned char*)lds, g, S, E, nullptr); }
        block_handoff();
        phase_ln1_panel(p, pm);
        block_handoff();
        { pg8::Gemm g{(const bf16_t*)(ws + WS_XB), (const bf16_t*)(ws + WS_WPT), NTOK, 2048, DM}; PanelOrder S{pm, 2048 / 256};
          EpiS E{(unsigned short*)(ws + WS_PH)};
          pg8::gemm_phase<EpiS, PanelOrder, false>((LAS unsigned char*)lds, g, S, E, nullptr); }
        block_handoff();
        phase_topk(p, lds, pm * 2048, pm * 2048 + 2048, NTHREADS);
        block_handoff();
    }
}

#define XB_TMO      128
#define XB_XCNT(j)  (256  + 64 * (j))
#define XB_XSUB(j)  (1280 + 64 * (j))
#define XB_XGEN(j)  (2304 + 64 * (j))
#define XB_TOP      3328
#define XB_TOPGEN   3392
#define XCD_BAR_WORDS 3456
#define XB_SPIN_CAP (1u << 18)

__device__ __forceinline__ unsigned xb_ld(unsigned* p)              { return __hip_atomic_load(p, __ATOMIC_RELAXED, __HIP_MEMORY_SCOPE_AGENT); }
__device__ __forceinline__ unsigned xb_add(unsigned* p, unsigned v) { return __hip_atomic_fetch_add(p, v, __ATOMIC_RELAXED, __HIP_MEMORY_SCOPE_AGENT); }
__device__ __forceinline__ unsigned xb_xcc_id() { return (unsigned)__builtin_amdgcn_s_getreg((3 << 11) | 20) & 0xFu; }
#define XB_SPIN(cond, bar) do { unsigned _sp = 0; while (cond) { __builtin_amdgcn_s_sleep(1); \
    if ((++_sp & 255u) == 0u) { if (xb_ld(&(bar)[XB_TMO])) break; if (_sp > XB_SPIN_CAP) { atomicAdd(&(bar)[XB_TMO], 1u); break; } } } } while (0)

struct XcdBarrier {
    unsigned* bar; unsigned x;
    volatile LAS unsigned* st;
};

__device__ __forceinline__ XcdBarrier xcd_barrier_post(unsigned* bar, volatile LAS unsigned* st) {
    XcdBarrier b; b.bar = bar; b.x = xb_xcc_id(); b.st = st;
    if (threadIdx.x == 0) (void)xb_add(&bar[XB_XCNT(b.x)], 1u);
    return b;
}
__device__ __forceinline__ void xcd_barrier_complete(unsigned* bar, unsigned x, unsigned& nloc, unsigned& nx) {
    const unsigned G = gridDim.x * gridDim.y * gridDim.z;
    unsigned sum, cnt, mine, sp = 0u;
    for (;;) {
        sum = 0u; cnt = 0u; mine = 0u;
#pragma unroll
        for (unsigned j = 0; j < 16; ++j) { const unsigned c = xb_ld(&bar[XB_XCNT(j)]); sum += c; cnt += (c > 0u) ? 1u : 0u; mine = (j == x) ? c : mine; }
        if (sum == G) break;
        __builtin_amdgcn_s_sleep(1);
        if ((++sp & 255u) == 0u) { if (xb_ld(&bar[XB_TMO])) break; if (sp > XB_SPIN_CAP) { atomicAdd(&bar[XB_TMO], 1u); break; } }
    }
    nloc = mine > 0u ? mine : 1u; nx = cnt > 0u ? cnt : 1u;
}

__device__ __forceinline__ void xcd_barrier(const XcdBarrier& b) {
    asm volatile("s_waitcnt vmcnt(0)" ::: "memory");
    __syncthreads();
    if (threadIdx.x == 0) {
        unsigned* bar = b.bar;
        __builtin_amdgcn_s_waitcnt(0);
        unsigned nloc = b.st[0], nx = b.st[1];
        if (nloc == 0u) { xcd_barrier_complete(bar, b.x, nloc, nx); b.st[0] = nloc; b.st[1] = nx; }
        const unsigned old = xb_add(&bar[XB_XSUB(b.x)], 1u);
        const unsigned gen = old / nloc;
        if (old + 1u == (gen + 1u) * nloc) {
            __builtin_amdgcn_fence(__ATOMIC_RELEASE, "agent");
            asm volatile("s_waitcnt vmcnt(0)" ::: "memory");
            const unsigned og = xb_add(&bar[XB_TOP], 1u);
            const unsigned tg = og / nx;
            if (og + 1u == (tg + 1u) * nx) xb_add(&bar[XB_TOPGEN], 1u);
            else XB_SPIN(xb_ld(&bar[XB_TOPGEN]) == tg, bar);
            __builtin_amdgcn_fence(__ATOMIC_ACQUIRE, "agent");
            xb_add(&bar[XB_XGEN(b.x)], 1u);
            asm volatile("s_waitcnt vmcnt(0)" ::: "memory");
        } else {
            XB_SPIN(xb_ld(&bar[XB_XGEN(b.x)]) == gen, bar);
            __builtin_amdgcn_fence(__ATOMIC_ACQUIRE, "agent");
            asm volatile("s_waitcnt vmcnt(0)" ::: "memory");
        }
    }
    __syncthreads();
}


__global__ void __launch_bounds__(NTHREADS) hybrid_fwd(Params p) {
    extern __shared__ __attribute__((aligned(16))) unsigned char lds[];
    cg::grid_group grid = cg::this_grid();
    const int lo = p.ph_lo, hi = p.ph_hi;
    unsigned char* ws = p.ws;
    volatile LAS unsigned* xst = (volatile LAS unsigned*)((LAS unsigned char*)lds + (LDS_BYTES - 16));
    if (threadIdx.x < 4) xst[threadIdx.x] = 0u;
    __syncthreads();
    XcdBarrier xbar = xcd_barrier_post((unsigned*)(ws + WS_BAR), xst);
#ifndef REPMASK
#define REPMASK 0
#endif
#define IN(k) (lo <= (k) && (k) < hi)
#define SEAM(k) do { if (IN(k) && IN((k) + 1)) { if (p.nrep < 0) grid.sync(); else xcd_barrier(xbar); } } while (0)
#define RUN(k, ...) do { if (IN(k)) { const int nrep_ = ((REPMASK >> (k)) & 1) ? p.nrep : 1; for (int rep_ = 0; rep_ < nrep_; ++rep_) { if (rep_) __syncthreads(); { __VA_ARGS__; } } } SEAM(k); } while (0)
    RUN(0,
        cvt_f32_bf16(p.in[0], (bf16_t*)(ws + WS_XB), (size_t)NTOK_P * DM / 8);
        cvt_f32_bf16(p.in[1], (bf16_t*)(ws + WS_XB) + (size_t)NTOK_P * DM, (size_t)NTOK_P * DM / 8);
        cvt_f32_fp8(p.in[20], ws + WS_U8, (size_t)16384 * DM / 16, U_SCALE);
        cvt_f32_fp8(p.in[21], ws + WS_V8, (size_t)16384 * DM / 16, V_SCALE);
        transpose_cvt<true>(p.in[2], 1024, 3072, (bf16_t*)(ws + WS_WINT), (float*)lds);
        transpose_cvt<false>(p.in[15], 1024, 1024, (bf16_t*)(ws + WS_WOUTT), (float*)lds);
        fold_wq_keys(p.in[18], p.in[19], (bf16_t*)(ws + WS_WPT), (float*)lds);
        hyena_filter_gen(p, (float*)lds));
    RUN(1,
        pg8::Gemm g{(const bf16_t*)(ws + WS_XB), (const bf16_t*)(ws + WS_WINT), NTOK, 3072, DM}; pg8::StaticOrder S; S.init(NTOK, 3072, gridDim.x, blockIdx.x);
        EpiP E{(bf16_t*)p.out, (bf16_t*)(ws + WS_PH), p.in[3]};
        pg8::gemm_phase<EpiP, pg8::StaticOrder, false>((LAS unsigned char*)lds, g, S, E, nullptr));
    RUN(2, phase_conv3(p, lds));
    RUN(3, phase_longconv(p, lds));
    RUN(4, phase_yh_transpose(p, lds));
    RUN(5, phase_panel_chain(p, lds));
    RUN(6, phase_peer_u(p));
    RUN(7, phase_peer_coef(p));
    RUN(8, phase_peer_v(p));
    RUN(9, phase_ln2(p));
#undef IN
#undef SEAM
#undef RUN
}

#ifdef CONV_CHECK
__global__ void __launch_bounds__(NTHREADS) k_conv_check(Params p) { conv_check(p); }
__global__ void __launch_bounds__(NTHREADS) k_conv_apply(Params p) {
    const float* chk = (const float*)(p.ws + WS_CHK); const float R = chk[0] / chk[1]; const float dl = sqrtf(fminf(R * 10.0f, 4e-4f));
    for (size_t i = (size_t)blockIdx.x * NTHREADS + threadIdx.x; i < (size_t)NTOK * DM; i += (size_t)gridDim.x * NTHREADS) { const unsigned hsh = (unsigned)i * 2654435761u; p.out[i] *= (hsh & 0x8000u) ? (1.0f + dl) : (1.0f - dl); }
}
#endif
extern "C" void kernel_launch(void* const* d_in, const int* in_sizes, int n_in, void* d_out, int out_size, void* d_ws, size_t ws_size, hipStream_t stream) {
    static int grid = 0;
    if (grid == 0) {
        if (n_in != 24 || out_size != NTOK * DM || ws_size < WS_END) { fprintf(stderr, "kernel_launch: unexpected shapes (n_in %d out %d ws %zu)\n", n_in, out_size, ws_size); grid = -1; return; }
        int dev = 0, cus = 0, per_cu = 0;
        hipGetDevice(&dev); hipDeviceGetAttribute(&cus, hipDeviceAttributeMultiprocessorCount, dev);
        if (hipFuncSetAttribute((const void*)hybrid_fwd, hipFuncAttributeMaxDynamicSharedMemorySize, LDS_BYTES) != hipSuccess) { fprintf(stderr, "kernel_launch: hipFuncSetAttribute failed\n"); grid = -1; return; }
        if (hipOccupancyMaxActiveBlocksPerMultiprocessor(&per_cu, (const void*)hybrid_fwd, NTHREADS, LDS_BYTES) != hipSuccess || per_cu < 1) { fprintf(stderr, "kernel_launch: occupancy query says %d\n", per_cu); per_cu = 1; }
        (void)hipGetLastError();
        grid = cus * per_cu; if (grid > 256) grid = 256;
        if (grid != NTOK / 256) { fprintf(stderr, "kernel_launch: this kernel needs %d co-resident workgroups, the device offers %d\n", NTOK / 256, grid); grid = -1; return; }
    }
    if (grid < 0) return;
    Params p{};
    for (int i = 0; i < 24; ++i) p.in[i] = (const float*)d_in[i];
    p.out = (float*)d_out; p.ws = (unsigned char*)d_ws; p.nrep = 2; p.pad = 0;
    if (hipMemsetAsync((unsigned char*)d_ws + WS_BAR, 0, XCD_BAR_WORDS * sizeof(unsigned), stream) != hipSuccess) { fprintf(stderr, "kernel_launch: memset of the barrier words failed\n"); return; }
#ifdef CONV_CHECK
    {
        hipMemsetAsync((unsigned char*)d_ws + WS_CHK, 0, 8, stream);
        void* args[] = {&p};
        p.ph_lo = 0; p.ph_hi = 4; hipLaunchCooperativeKernel((const void*)hybrid_fwd, dim3(grid), dim3(NTHREADS), args, LDS_BYTES, stream);
        hipLaunchKernelGGL(k_conv_check, dim3(grid), dim3(NTHREADS), 0, stream, p);
        hipMemsetAsync((unsigned char*)d_ws + WS_BAR, 0, XCD_BAR_WORDS * sizeof(unsigned), stream);
        p.ph_lo = 4; p.ph_hi = NPHASE; hipLaunchCooperativeKernel((const void*)hybrid_fwd, dim3(grid), dim3(NTHREADS), args, LDS_BYTES, stream);
        hipLaunchKernelGGL(k_conv_apply, dim3(grid), dim3(NTHREADS), 0, stream, p);
        return;
    }
#endif
#if ONE_LAUNCH
    p.ph_lo = 0; p.ph_hi = NPHASE;
    void* args[] = {&p};
    hipError_t e = hipLaunchCooperativeKernel((const void*)hybrid_fwd, dim3(grid), dim3(NTHREADS), args, LDS_BYTES, stream);
    if (e != hipSuccess) fprintf(stderr, "cooperative launch failed: %s (grid %d)\n", hipGetErrorString(e), grid);
#else
#ifndef HOSTREP
#define HOSTREP 0
#endif
    for (int ph = 0; ph < NPHASE; ++ph) { p.ph_lo = ph; p.ph_hi = ph + 1; const int nl = ((HOSTREP >> ph) & 1) ? 2 : 1;
        for (int r = 0; r < nl; ++r) hipLaunchKernelGGL(hybrid_fwd, dim3(grid), dim3(NTHREADS), LDS_BYTES, stream, p); }
#endif
}
```

```cpp
#include <hip/hip_runtime.h>
#include <hip/hip_cooperative_groups.h>
#include <cstdio>
namespace cg = cooperative_groups;
#ifndef ONE_LAUNCH
#define ONE_LAUNCH 1
#endif
#ifdef PROBE_A
#define PROBE_NOPEER 1
#endif
namespace pg8 {
#define PG8_LAS __attribute__((address_space(3)))
typedef unsigned short bf16_t;
typedef short bf16x8 __attribute__((ext_vector_type(8)));
typedef float f32x4 __attribute__((ext_vector_type(4)));
typedef unsigned u32x4 __attribute__((ext_vector_type(4)));
constexpr int BM = 256, BK = 64, HALF = 128, HTB = HALF * BK * 2  , STAGE_BYTES = 8 * HTB, NXCD = 8, WGM = 8;

__host__ __device__ __forceinline__ int lds_byte(int r, int c) { const int st = (r >> 4) * 2 + (c >> 5), rr = r & 15, cc = c & 31, ob = rr * 64 + cc * 2; return st * 1024 + (ob ^ (((ob >> 9) & 1) << 5)); }
__host__ __device__ __forceinline__ void stage_rc(int b, int& R, int& C) { const int st = b / 1024, sb = b % 1024, swz = sb ^ (((sb >> 9) & 1) << 5); R = (st >> 1) * 16 + swz / 64; C = (st & 1) * 32 + (swz % 64) / 2; }
__host__ __device__ __forceinline__ int perm32(int rho) { const int n = rho >> 4, i = rho & 15; return 8 * (i >> 2) + 4 * n + (i & 3); }

struct Unit { int pm, pn; };
struct Gemm { const bf16_t* A; const bf16_t* Bt; int M, N, K; };

struct StaticOrder {
    int nM, nN, nwg, G, c;
    __host__ __device__ void init(int M, int N, int G_, int c_) { nM = M / BM; nN = N / BM; nwg = nM * nN; G = G_; c = c_; }
    __host__ __device__ bool next(int i, Unit& u) const {
        const long L = (long)i * G + c; if (L >= nwg) return false;
        int wgid = (int)L; { const int q = nwg / NXCD, r = nwg % NXCD, xcd = wgid % NXCD, off = wgid / NXCD; wgid = (xcd < r ? xcd * (q + 1) : r * (q + 1) + (xcd - r) * q) + off; }
        const int nig = WGM * nN, gid = wgid / nig, fm = gid * WGM, gsz = (nM - fm) < WGM ? (nM - fm) : WGM;
        u.pm = fm + ((wgid % nig) % gsz); u.pn = (wgid % nig) / gsz; return true;
    }
    __device__ __forceinline__ void a_ready(const Unit&) const {}
    __device__ __forceinline__ void done(const Unit&) const {}
};
struct CountedOrder : StaticOrder {
    const unsigned* ready; unsigned need; unsigned* tmo;
    __device__ __forceinline__ void a_ready(const Unit& u) const {
        if (threadIdx.x < 64) {
            const unsigned long long t0 = __builtin_amdgcn_s_memrealtime(); unsigned polls = 0;
            while ((unsigned)__builtin_amdgcn_readfirstlane(__hip_atomic_load(ready + 64 * u.pm, __ATOMIC_RELAXED, __HIP_MEMORY_SCOPE_AGENT)) < need) {
                if ((++polls & 255u) == 0u && __builtin_amdgcn_readfirstlane(__hip_atomic_load(tmo, __ATOMIC_RELAXED, __HIP_MEMORY_SCOPE_AGENT)) != 0u) break;
                if (__builtin_amdgcn_s_memrealtime() - t0 > 2000000ull) {
                    if (threadIdx.x == 0) { unsigned expect = 0u; __hip_atomic_compare_exchange_strong(tmo + 1, &expect, 0x600u | (unsigned)(u.pm & 0xff), __ATOMIC_RELAXED, __ATOMIC_RELAXED, __HIP_MEMORY_SCOPE_AGENT); __hip_atomic_store(tmo, 1u, __ATOMIC_RELAXED, __HIP_MEMORY_SCOPE_AGENT); }
                    break; }
                __builtin_amdgcn_s_sleep(2); }
            __builtin_amdgcn_fence(__ATOMIC_ACQUIRE, "agent");
            asm volatile("s_waitcnt vmcnt(0)" ::: "memory");
        }
#if !defined(BROKEN_HOOK_NO_BARRIER)
        asm volatile("" ::: "memory"); __builtin_amdgcn_s_barrier(); asm volatile("" ::: "memory");
#endif
    }
};

__device__ __forceinline__ unsigned cvt_pk_bf16(float lo, float hi) { unsigned r; asm volatile("v_cvt_pk_bf16_f32 %0, %1, %2" : "=v"(r) : "v"(lo), "v"(hi)); return r; }
typedef float f32x2 __attribute__((ext_vector_type(2)));
__device__ __forceinline__ f32x2 gelu_pk(f32x2 v) {
    const f32x2 av = __builtin_elementwise_abs(v), d = av * 0.2316418882f + 1.0f;
    f32x2 t; t.x = __builtin_amdgcn_rcpf(d.x); t.y = __builtin_amdgcn_rcpf(d.y);
    f32x2 q = t * 0.5307027145f + (-0.7265760135f); q = q * t + 0.7107068705f; q = q * t + (-0.142248368f); q = q * t + 0.127414796f; q = q * t;
    const f32x2 s = (v * v) * (-0.72134752044f);
    f32x2 e; e.x = __builtin_amdgcn_exp2f(s.x); e.y = __builtin_amdgcn_exp2f(s.y);
    const f32x2 m = v * (q * e), r = v - m;
    f32x2 o; o.x = v.x < 0.f ? m.x : r.x; o.y = v.y < 0.f ? m.y : r.y; return o;
}

struct EpiF32 {
    static constexpr bool PERM = false, AFTER_DRAIN = false;
    float* C; int ldc; const float* bias;
    __device__ __forceinline__ void operator()(const f32x4 (&acc)[2][2][4][2], const Unit& u, int wr, int wc, int fr, int fq) const {
        const int row0 = u.pm * BM + wr * 64 + fr, col0 = u.pn * BM + wc * 32 + 4 * fq;
        f32x4 bv[2][2];
#pragma unroll
        for (int bj = 0; bj < 2; ++bj)
#pragma unroll
            for (int n = 0; n < 2; ++n) bv[bj][n] = bias ? *(const f32x4*)(bias + col0 + bj * HALF + n * 16) : (f32x4){0.f, 0.f, 0.f, 0.f};
#pragma unroll
        for (int ai = 0; ai < 2; ++ai)
#pragma unroll
            for (int m = 0; m < 4; ++m) { float* rowp = C + (size_t)(row0 + ai * HALF + m * 16) * ldc + col0;
#pragma unroll
                for (int bj = 0; bj < 2; ++bj)
#pragma unroll
                    for (int n = 0; n < 2; ++n) *(f32x4*)(rowp + bj * HALF + n * 16) = acc[ai][bj][m][n] + bv[bj][n]; }
    }
};
template <int ACT  > struct EpiBf16 {
    static constexpr bool PERM = true, AFTER_DRAIN = false;
    bf16_t* O; int ldc; const float* bias; int split_cols; size_t split_stride;
    __device__ __forceinline__ void operator()(const f32x4 (&acc)[2][2][4][2], const Unit& u, int wr, int wc, int fr, int fq) const {
        const int row0 = u.pm * BM + wr * 64 + fr; int colt = u.pn * BM; bf16_t* base = O;
        if (split_cols) { const int t = colt / split_cols; base += (size_t)t * split_stride; colt -= t * split_cols; }
        const int col0 = colt + wc * 32 + 8 * fq, bcol0 = u.pn * BM + wc * 32 + 8 * fq;
        f32x4 bv[2][2];
#pragma unroll
        for (int bj = 0; bj < 2; ++bj)
#pragma unroll
            for (int n = 0; n < 2; ++n) bv[bj][n] = bias ? *(const f32x4*)(bias + bcol0 + bj * HALF + 4 * n) : (f32x4){0.f, 0.f, 0.f, 0.f};
#pragma unroll
        for (int ai = 0; ai < 2; ++ai)
#pragma unroll
            for (int m = 0; m < 4; ++m) { bf16_t* rowp = base + (size_t)(row0 + ai * HALF + m * 16) * ldc + col0;
#pragma unroll
                for (int bj = 0; bj < 2; ++bj) { f32x4 v0 = acc[ai][bj][m][0] + bv[bj][0], v1 = acc[ai][bj][m][1] + bv[bj][1];
                    if (ACT == 1) { f32x2 a = gelu_pk((f32x2){v0[0], v0[1]}), b = gelu_pk((f32x2){v0[2], v0[3]}), c = gelu_pk((f32x2){v1[0], v1[1]}), d = gelu_pk((f32x2){v1[2], v1[3]});
                        v0 = (f32x4){a.x, a.y, b.x, b.y}; v1 = (f32x4){c.x, c.y, d.x, d.y}; }
                    if (ACT == 2) {
#pragma unroll
                        for (int j = 0; j < 4; ++j) { v0[j] = 0.5f * v0[j] * (1.0f + erff(v0[j] * 0.70710678f)); v1[j] = 0.5f * v1[j] * (1.0f + erff(v1[j] * 0.70710678f)); } }
                    u32x4 w; w.x = cvt_pk_bf16(v0[0], v0[1]); w.y = cvt_pk_bf16(v0[2], v0[3]); w.z = cvt_pk_bf16(v1[0], v1[1]); w.w = cvt_pk_bf16(v1[2], v1[3]);
                    *(u32x4*)(rowp + bj * HALF) = w; } }
    }
};

struct PanelStats {
    unsigned* xbuf;
    unsigned* cnt;
    unsigned* tmo;
    int ntn; float eps;
    unsigned code;
    __device__ __forceinline__ bool run(const f32x4 (&v)[2][2][4][2], const Unit& u, int wr, int wc, int fr, int fq, PG8_LAS unsigned char* lds, int wid, int lane) const {
        typedef float f32x2v __attribute__((ext_vector_type(2)));
        PG8_LAS f32x2v* P = (PG8_LAS f32x2v*)lds;
        PG8_LAS f32x2v* S = (PG8_LAS f32x2v*)(lds + 8192);
        PG8_LAS unsigned* flag = (PG8_LAS unsigned*)(lds + 8192 + 2048);
#pragma unroll
        for (int ai = 0; ai < 2; ++ai)
#pragma unroll
            for (int m = 0; m < 4; ++m) {
                float s = 0.f;
#pragma unroll
                for (int bj = 0; bj < 2; ++bj)
#pragma unroll
                    for (int n = 0; n < 2; ++n) { const f32x4 x = v[ai][bj][m][n]; s += (x[0] + x[1]) + (x[2] + x[3]); }
                s += __shfl_xor(s, 16); s += __shfl_xor(s, 32);
                const float mw = s * (1.0f / 64.0f); float q = 0.f;
#pragma unroll
                for (int bj = 0; bj < 2; ++bj)
#pragma unroll
                    for (int n = 0; n < 2; ++n) { const f32x4 d = v[ai][bj][m][n] - mw; q += (d[0] * d[0] + d[1] * d[1]) + (d[2] * d[2] + d[3] * d[3]); }
                q += __shfl_xor(q, 16); q += __shfl_xor(q, 32);
                if (fq == 0) P[(ai * HALF + wr * 64 + m * 16 + fr) * 4 + wc] = (f32x2v){mw, q};
            }
        asm volatile("s_waitcnt lgkmcnt(0)" ::: "memory"); __builtin_amdgcn_s_barrier(); asm volatile("" ::: "memory");
#if defined(BROKEN_NO_WAIT)
        if (blockIdx.x >= 64) { const long long t0 = clock64(); while (clock64() - t0 < 60000) __builtin_amdgcn_s_sleep(8); }
#endif
        const int row = wid * 32 + (lane & 31);
        if (lane < 32) {
            const f32x2v a = P[row * 4 + 0], b = P[row * 4 + 1], c = P[row * 4 + 2], d = P[row * 4 + 3];
            const float mt = (a.x + b.x + c.x + d.x) * 0.25f;
            const float da = a.x - mt, db = b.x - mt, dc = c.x - mt, dd = d.x - mt;
            const float m2 = (a.y + b.y) + (c.y + d.y) + 64.0f * ((da * da + db * db) + (dc * dc + dd * dd));
            unsigned long long* slot = (unsigned long long*)xbuf + ((size_t)(u.pm * BM + row) * 4 + u.pn);
            __hip_atomic_store(slot, ((unsigned long long)__float_as_uint(m2) << 32) | __float_as_uint(mt), __ATOMIC_RELAXED, __HIP_MEMORY_SCOPE_AGENT);
        }
        asm volatile("s_waitcnt vmcnt(0)" ::: "memory");
        if (lane == 0) __hip_atomic_fetch_add(cnt + 64 * u.pm, 1u, __ATOMIC_RELAXED, __HIP_MEMORY_SCOPE_AGENT);
        if (wid == 0) {
            bool dead = false; const unsigned long long t0 = __builtin_amdgcn_s_memrealtime(); const unsigned want = 8u * (unsigned)ntn;
            for (;;) {
#if defined(BROKEN_NO_WAIT)
                break;
#endif
                if ((unsigned)__builtin_amdgcn_readfirstlane(__hip_atomic_load(cnt + 64 * u.pm, __ATOMIC_RELAXED, __HIP_MEMORY_SCOPE_AGENT)) >= want) break;
                if (__builtin_amdgcn_s_memrealtime() - t0 > 2000000ull) {
                    if (lane == 0) { unsigned expect = 0u; __hip_atomic_compare_exchange_strong(tmo + 1, &expect, code | (unsigned)(u.pm & 0xff), __ATOMIC_RELAXED, __ATOMIC_RELAXED, __HIP_MEMORY_SCOPE_AGENT);
                                     __hip_atomic_store(tmo, 1u, __ATOMIC_RELAXED, __HIP_MEMORY_SCOPE_AGENT); }
                    dead = true; break; }
                __builtin_amdgcn_s_sleep(2);
            }
            __builtin_amdgcn_fence(__ATOMIC_ACQUIRE, "agent");
            if (lane == 0) flag[0] = dead ? 1u : 0u;
        }
        asm volatile("s_waitcnt vmcnt(0) lgkmcnt(0)" ::: "memory"); __builtin_amdgcn_s_barrier(); asm volatile("" ::: "memory");
        const bool bad = flag[0] != 0u;
        if (lane < 32) {
            const unsigned long long* slot = (const unsigned long long*)xbuf + (size_t)(u.pm * BM + row) * 4; float mt[4], m2[4]; float ms = 0.f;
#pragma unroll
            for (int t = 0; t < 4; ++t) { if (t < ntn) { const unsigned long long w = __hip_atomic_load(slot + t, __ATOMIC_RELAXED, __HIP_MEMORY_SCOPE_AGENT); mt[t] = __uint_as_float((unsigned)w); m2[t] = __uint_as_float((unsigned)(w >> 32)); } else { mt[t] = 0.f; m2[t] = 0.f; } ms += mt[t]; }
            const float mean = ms / (float)ntn; float q = 0.f;
#pragma unroll
            for (int t = 0; t < 4; ++t) if (t < ntn) { const float dm = mt[t] - mean; q += m2[t] + 256.0f * dm * dm; }
            S[row] = (f32x2v){mean, 1.0f / sqrtf(q / (256.0f * (float)ntn) + eps)};
        }
        asm volatile("s_waitcnt lgkmcnt(0)" ::: "memory"); __builtin_amdgcn_s_barrier(); asm volatile("" ::: "memory");
        return bad;
    }
};
struct EpiLnRes {
    static constexpr bool PERM = false, AFTER_DRAIN = true;
    const float* base; float* out; int ldc; const float* bias; PanelStats st; unsigned poison;
    __device__ __forceinline__ void refuse(size_t i0, size_t stride, int M, int N) const { const float q = __builtin_nanf(""); for (size_t i = i0; i < (size_t)M * N; i += stride) out[(i / N) * ldc + i % N] = q;
        if (i0 == 0) { unsigned expect = 0u; __hip_atomic_compare_exchange_strong(st.tmo + 1, &expect, 0x7f0u, __ATOMIC_RELAXED, __ATOMIC_RELAXED, __HIP_MEMORY_SCOPE_AGENT); __hip_atomic_store(st.tmo, 1u, __ATOMIC_RELAXED, __HIP_MEMORY_SCOPE_AGENT); } }
    __device__ __forceinline__ void fused(f32x4 (&acc)[2][2][4][2], const Unit& u, int wr, int wc, int fr, int fq, PG8_LAS unsigned char* lds, int wid, int lane) const {
        typedef float f32x2v __attribute__((ext_vector_type(2)));
        const PG8_LAS f32x2v* S = (const PG8_LAS f32x2v*)(lds + 8192);
        const int col0 = u.pn * BM + wc * 32 + 4 * fq;
#pragma unroll
        for (int bj = 0; bj < 2; ++bj)
#pragma unroll
            for (int n = 0; n < 2; ++n) { const f32x4 bv = bias ? *(const f32x4*)(bias + col0 + bj * HALF + n * 16) : (f32x4){0.f, 0.f, 0.f, 0.f};
#pragma unroll
                for (int ai = 0; ai < 2; ++ai)
#pragma unroll
                    for (int m = 0; m < 4; ++m) acc[ai][bj][m][n] += bv; }
        const bool bad = st.run(acc, u, wr, wc, fr, fq, lds, wid, lane) || poison != 0u;
        const float qnan = __builtin_nanf("");
#pragma unroll
        for (int ai = 0; ai < 2; ++ai)
#pragma unroll
            for (int m = 0; m < 4; ++m) { const int r = ai * HALF + wr * 64 + m * 16 + fr; const f32x2v sr = S[r]; const size_t off = (size_t)(u.pm * BM + r) * ldc + col0;
#pragma unroll
                for (int bj = 0; bj < 2; ++bj)
#pragma unroll
                    for (int n = 0; n < 2; ++n) { const f32x4 bs = *(const f32x4*)(base + off + bj * HALF + n * 16); f32x4 o = bs + (acc[ai][bj][m][n] - sr.x) * sr.y;
                        if (bad) o = (f32x4){qnan, qnan, qnan, qnan}; *(f32x4*)(out + off + bj * HALF + n * 16) = o; }
                asm volatile("" ::: "memory"); }
    }
};
struct EpiLnResLn {
    static constexpr bool PERM = false, AFTER_DRAIN = true;
    const float* base; float* out; bf16_t* xn; int ldc; const float* bias; PanelStats st1, st2; unsigned poison;
    __device__ __forceinline__ void refuse(size_t i0, size_t stride, int M, int N) const { const float q = __builtin_nanf(""); for (size_t i = i0; i < (size_t)M * N; i += stride) { const size_t o = (i / N) * ldc + i % N; out[o] = q; xn[o] = (bf16_t)0x7fc0u; }
        if (i0 == 0) { unsigned expect = 0u; __hip_atomic_compare_exchange_strong(st1.tmo + 1, &expect, 0x7f0u, __ATOMIC_RELAXED, __ATOMIC_RELAXED, __HIP_MEMORY_SCOPE_AGENT); __hip_atomic_store(st1.tmo, 1u, __ATOMIC_RELAXED, __HIP_MEMORY_SCOPE_AGENT); } }
    __device__ __forceinline__ void fused(f32x4 (&acc)[2][2][4][2], const Unit& u, int wr, int wc, int fr, int fq, PG8_LAS unsigned char* lds, int wid, int lane) const {
        typedef float f32x2v __attribute__((ext_vector_type(2))); typedef unsigned u32x2v __attribute__((ext_vector_type(2)));
        const PG8_LAS f32x2v* S = (const PG8_LAS f32x2v*)(lds + 8192);
        const int col0 = u.pn * BM + wc * 32 + 4 * fq;
#pragma unroll
        for (int bj = 0; bj < 2; ++bj)
#pragma unroll
            for (int n = 0; n < 2; ++n) { const f32x4 bv = bias ? *(const f32x4*)(bias + col0 + bj * HALF + n * 16) : (f32x4){0.f, 0.f, 0.f, 0.f};
#pragma unroll
                for (int ai = 0; ai < 2; ++ai)
#pragma unroll
                    for (int m = 0; m < 4; ++m) acc[ai][bj][m][n] += bv; }
        bool bad = st1.run(acc, u, wr, wc, fr, fq, lds, wid, lane) || poison != 0u;
        const float qnan = __builtin_nanf("");
#pragma unroll
        for (int ai = 0; ai < 2; ++ai)
#pragma unroll
            for (int m = 0; m < 4; ++m) { const int r = ai * HALF + wr * 64 + m * 16 + fr; const f32x2v sr = S[r]; const size_t off = (size_t)(u.pm * BM + r) * ldc + col0;
#pragma unroll
                for (int bj = 0; bj < 2; ++bj)
#pragma unroll
                    for (int n = 0; n < 2; ++n) { const f32x4 bs = *(const f32x4*)(base + off + bj * HALF + n * 16); acc[ai][bj][m][n] = bs + (acc[ai][bj][m][n] - sr.x) * sr.y; }
                asm volatile("" : "+v"(acc[ai][0][m][0]), "+v"(acc[ai][0][m][1]), "+v"(acc[ai][1][m][0]), "+v"(acc[ai][1][m][1]));
                if (m & 1) asm volatile("" ::: "memory"); }
        const bool bad1 = bad;
        bad = st2.run(acc, u, wr, wc, fr, fq, lds, wid, lane) || bad;
#pragma unroll
        for (int ai = 0; ai < 2; ++ai)
#pragma unroll
            for (int m = 0; m < 4; ++m) { const int r = ai * HALF + wr * 64 + m * 16 + fr; const f32x2v sr = S[r]; const size_t off = (size_t)(u.pm * BM + r) * ldc + col0;
#pragma unroll
                for (int bj = 0; bj < 2; ++bj)
#pragma unroll
                    for (int n = 0; n < 2; ++n) { const f32x4 x1 = acc[ai][bj][m][n]; *(f32x4*)(out + off + bj * HALF + n * 16) = bad1 ? (f32x4){qnan, qnan, qnan, qnan} : x1;
                        const f32x4 o = (x1 - sr.x) * sr.y; u32x2v w; w.x = cvt_pk_bf16(o[0], o[1]); w.y = cvt_pk_bf16(o[2], o[3]);
                        if (bad) { w.x = 0x7fc07fc0u; w.y = 0x7fc07fc0u; } *(u32x2v*)(xn + off + bj * HALF + n * 16) = w; }
                asm volatile("" ::: "memory"); }
    }
};

template <class Epi, class Sched, bool STAMP = false>
__device__ __forceinline__ void gemm_phase(PG8_LAS unsigned char* lds, const Gemm g, const Sched& S, const Epi& E, unsigned long long* stamps) {
    const int tid = threadIdx.x, wid = __builtin_amdgcn_readfirstlane(tid >> 6), lane = tid & 63, wr = wid >> 2, wc = wid & 3, fr = lane & 15, fq = lane >> 4;
    const int K = g.K, nt = K / BK;
    int ts_lo = 0, ts_hi = 0, nts = 0; const unsigned long long rt_entry = STAMP ? (unsigned long long)wall_clock64() : 0ull;
#define PG8_STAMP() do { if (STAMP && wid == 0 && nts < 64) { const unsigned long long _c = (unsigned long long)clock64(); \
        ts_lo = (lane == nts) ? (int)(unsigned)_c : ts_lo; ts_hi = (lane == nts) ? (int)(unsigned)(_c >> 32) : ts_hi; ++nts; } } while (0)
    PG8_STAMP();
    unsigned voffA[2], voffB[2];
#pragma unroll
    for (int i = 0; i < 2; ++i) { int R, C; stage_rc(tid * 16 + i * 8192, R, C); const int Rb = Epi::PERM ? ((R & ~31) + perm32(R & 31)) : R;
        voffA[i] = (unsigned)(R * K + C) * 2u; voffB[i] = (unsigned)(Rb * K + C) * 2u; }
    const size_t kstep = (size_t)(BK * 2);
    const size_t hstep = (size_t)HALF * K * 2;
    const size_t tstep = 2 * hstep;
    const unsigned ldsw = (unsigned)wid * 1024u;
    const int aoff = lds_byte(wr * 64 + fr, fq * 8), boff = lds_byte(wc * 32 + fr, fq * 8);
#define PG8_SA(b, h) (((b) * 2 + (h)) * HTB)
#define PG8_SB(b, h) ((4 + (b) * 2 + (h)) * HTB)
#define PG8_STAGE(bufoff, gbase, voff) do { _Pragma("unroll") for (int _i = 0; _i < 2; ++_i) \
        __builtin_amdgcn_global_load_lds((const unsigned*)((const char*)(gbase) + (voff)[_i]), (PG8_LAS unsigned*)(lds + (bufoff) + ldsw + _i * 8192), 16, 0, 0); } while (0)
#define PG8_LDA(dst, b, h) do { _Pragma("unroll") for (int m = 0; m < 4; ++m) _Pragma("unroll") for (int k = 0; k < 2; ++k) dst[m][k] = *(const PG8_LAS bf16x8*)(lds + PG8_SA(b, h) + aoff + m * 2048 + k * 1024); } while (0)
#define PG8_LDB(dst, b, h) do { _Pragma("unroll") for (int n = 0; n < 2; ++n) _Pragma("unroll") for (int k = 0; k < 2; ++k) dst[n][k] = *(const PG8_LAS bf16x8*)(lds + PG8_SB(b, h) + boff + n * 2048 + k * 1024); } while (0)
#define PG8_MMA(ai, bj, At, Bt) do { __builtin_amdgcn_s_setprio(1); _Pragma("unroll") for (int m = 0; m < 4; ++m) _Pragma("unroll") for (int n = 0; n < 2; ++n) _Pragma("unroll") for (int k = 0; k < 2; ++k) \
        acc[ai][bj][m][n] = __builtin_amdgcn_mfma_f32_16x16x32_bf16(Bt[n][k], At[m][k], acc[ai][bj][m][n], 0, 0, 0); __builtin_amdgcn_s_setprio(0); } while (0)
#define PG8_WAIT_V(n) asm volatile("s_waitcnt vmcnt(" #n ")" ::: "memory")
#define PG8_WAIT_L(n) asm volatile("s_waitcnt lgkmcnt(" #n ")" ::: "memory")
#define PG8_BAR __builtin_amdgcn_s_barrier()
#define PG8_SCHED __builtin_amdgcn_sched_barrier(0)
    Unit cur, nxt; int ui = 0;
    if (!S.next(0, cur)) return;
    f32x4 acc[2][2][4][2];
#pragma unroll
    for (int a = 0; a < 2; ++a)
#pragma unroll
        for (int b = 0; b < 2; ++b)
#pragma unroll
            for (int m = 0; m < 4; ++m)
#pragma unroll
                for (int n = 0; n < 2; ++n) acc[a][b][m][n] = (f32x4){0.f, 0.f, 0.f, 0.f};
    bf16x8 At[4][2], B0[2][2], B1[2][2];
    const char* cA = (const char*)g.A + (size_t)cur.pm * tstep; const char* cB = (const char*)g.Bt + (size_t)cur.pn * tstep;
    S.a_ready(cur);
    PG8_STAGE(PG8_SB(0, 0), cB, voffB); PG8_STAGE(PG8_SA(0, 0), cA, voffA); PG8_STAGE(PG8_SB(0, 1), cB + hstep, voffB); PG8_STAGE(PG8_SA(0, 1), cA + hstep, voffA);
    if (wr == 1) PG8_BAR;
    PG8_WAIT_V(4); PG8_BAR;
    PG8_STAGE(PG8_SB(1, 0), cB + kstep, voffB); PG8_STAGE(PG8_SA(1, 0), cA + kstep, voffA); PG8_STAGE(PG8_SB(1, 1), cB + hstep + kstep, voffB);
    PG8_WAIT_V(6); PG8_BAR;
    PG8_STAMP();
    for (;;) {
        const bool has_next = S.next(ui + 1, nxt);
        const char* nA = has_next ? (const char*)g.A + (size_t)nxt.pm * tstep : cA; const char* nB = has_next ? (const char*)g.Bt + (size_t)nxt.pn * tstep : cB;
        for (int t = 0; t < nt; t += 2) {
            const bool last = (t == nt - 2);
            const char* a1 = cA + (size_t)(t + 1) * kstep;
            const char* a2 = last ? nA : cA + (size_t)(t + 2) * kstep; const char* b2 = last ? nB : cB + (size_t)(t + 2) * kstep;
            const char* a3 = a2 + kstep; const char* b3 = b2 + kstep;
            if (last && has_next) S.a_ready(nxt);
            PG8_LDB(B0, 0, 0); PG8_SCHED; PG8_LDA(At, 0, 0); PG8_STAGE(PG8_SA(1, 1), a1 + hstep, voffA);
            PG8_WAIT_L(8); PG8_BAR; PG8_WAIT_L(0); PG8_MMA(0, 0, At, B0); PG8_BAR; PG8_SCHED;
            PG8_LDB(B1, 0, 1); PG8_STAGE(PG8_SB(0, 0), b2, voffB);
            PG8_BAR; PG8_WAIT_L(0); PG8_MMA(0, 1, At, B1); PG8_BAR;
            PG8_LDA(At, 0, 1); PG8_STAGE(PG8_SA(0, 0), a2, voffA);
            PG8_BAR; PG8_WAIT_L(0); PG8_MMA(1, 0, At, B0); PG8_BAR; PG8_SCHED;
            PG8_STAGE(PG8_SB(0, 1), b2 + hstep, voffB);
            PG8_WAIT_V(6); PG8_BAR; PG8_MMA(1, 1, At, B1); PG8_BAR;
            PG8_LDB(B0, 1, 0); PG8_SCHED; PG8_LDA(At, 1, 0); PG8_STAGE(PG8_SA(0, 1), a2 + hstep, voffA);
            PG8_WAIT_L(8); PG8_BAR; PG8_WAIT_L(0); PG8_MMA(0, 0, At, B0); PG8_BAR; PG8_SCHED;
            PG8_LDB(B1, 1, 1); PG8_STAGE(PG8_SB(1, 0), b3, voffB);
            PG8_BAR; PG8_WAIT_L(0); PG8_MMA(0, 1, At, B1); PG8_BAR;
            PG8_LDA(At, 1, 1); PG8_STAGE(PG8_SA(1, 0), a3, voffA);
            PG8_BAR; PG8_WAIT_L(0); PG8_MMA(1, 0, At, B0); PG8_BAR; PG8_SCHED;
            PG8_STAGE(PG8_SB(1, 1), b3 + hstep, voffB);
            PG8_WAIT_V(6); PG8_BAR; PG8_MMA(1, 1, At, B1); PG8_BAR;
        }
        PG8_STAMP();
        if constexpr (!Epi::AFTER_DRAIN) { E(acc, cur, wr, wc, fr, fq); S.done(cur); }
        PG8_STAMP();
        if (!has_next) break;
#pragma unroll
        for (int a = 0; a < 2; ++a)
#pragma unroll
            for (int b = 0; b < 2; ++b)
#pragma unroll
                for (int m = 0; m < 4; ++m)
#pragma unroll
                    for (int n = 0; n < 2; ++n) acc[a][b][m][n] = (f32x4){0.f, 0.f, 0.f, 0.f};
        cur = nxt; cA = nA; cB = nB; ++ui;
    }
    PG8_WAIT_V(0);
    if (wr == 0) PG8_BAR;
    PG8_BAR;
    if constexpr (Epi::AFTER_DRAIN) { E.fused(acc, cur, wr, wc, fr, fq, lds, wid, lane); S.done(cur); }
    PG8_STAMP();
    if (STAMP && wid == 0) { stamps[lane] = lane < nts ? (((unsigned long long)(unsigned)ts_hi << 32) | (unsigned)ts_lo) : 0ull;
        if (lane == 62) stamps[62] = rt_entry; if (lane == 63) stamps[63] = (unsigned long long)wall_clock64(); }
#undef PG8_STAMP
#undef PG8_SA
#undef PG8_SB
#undef PG8_STAGE
#undef PG8_LDA
#undef PG8_LDB
#undef PG8_MMA
#undef PG8_WAIT_V
#undef PG8_WAIT_L
#undef PG8_BAR
#undef PG8_SCHED
}
}

#define LAS __attribute__((address_space(3)))
typedef unsigned short bf16_t;
typedef short bf16x8 __attribute__((ext_vector_type(8)));
typedef float f32x4 __attribute__((ext_vector_type(4)));
typedef unsigned u32x4 __attribute__((ext_vector_type(4)));
typedef unsigned u32x2 __attribute__((ext_vector_type(2)));
typedef __bf16 bf2_t __attribute__((ext_vector_type(2)));
typedef _Float16 h2_t __attribute__((ext_vector_type(2)));

constexpr int NTOK = 65536, DM = 1024, NTOK_P = 32768;
constexpr int L0 = 8192, L1 = 4096;
constexpr float ALPHA_C = 1.189207115002721f;
constexpr float LN_EPS_C = 1e-5f;
constexpr int NTHREADS = 512;
constexpr int NPHASE = 10;
constexpr int LDS_BYTES = 153600;
constexpr size_t MiB = 1024ull * 1024ull;
constexpr size_t WS_XB = 0;
constexpr size_t WS_PH = 128 * MiB;
constexpr size_t WS_ZT = 320 * MiB;
constexpr size_t WS_U8 = 384 * MiB, WS_V8 = 400 * MiB;
constexpr size_t WS_PARTD = 128 * MiB;
constexpr float U_SCALE = 128.0f, V_SCALE = 16.0f;
constexpr size_t WS_WINT = 448 * MiB, WS_WOUTT = 454 * MiB, WS_WPT = 456 * MiB;
constexpr size_t WS_FG = 460 * MiB;
constexpr size_t WS_PART = 484 * MiB;
constexpr size_t WS_DUMMY = 492 * MiB;
constexpr size_t WS_BAR = 497 * MiB;
constexpr size_t WS_END = 498 * MiB;
constexpr size_t WS_EIDX = 416 * MiB, WS_GATE = 460 * MiB;
constexpr size_t OUT_X0T = 192 * MiB;

struct Params { const float* in[24]; float* out; unsigned char* ws; int ph_lo, ph_hi, nrep, pad; };

__device__ __forceinline__ unsigned pack2bf(float lo, float hi) { return pg8::cvt_pk_bf16(lo, hi); }
__device__ __forceinline__ float bf_lo(unsigned w) { return __uint_as_float(w << 16); }
__device__ __forceinline__ float bf_hi(unsigned w) { return __uint_as_float(w & 0xffff0000u); }
__device__ __forceinline__ unsigned short f2bf(float f) { return (unsigned short)(pack2bf(f, 0.f) & 0xffffu); }

__device__ __forceinline__ void seq_of(int tok0, int& seq, int& L, int& tl) {
    if (tok0 < NTOK_P) { seq = tok0 >> 13; L = L0; tl = tok0 & (L0 - 1); }
    else { const int r = tok0 - NTOK_P; seq = 4 + (r >> 12); L = L1; tl = r & (L1 - 1); }
}
__device__ __forceinline__ size_t seq_base_T(int seq) { return seq < 4 ? (size_t)seq * 512 * L0 : (size_t)4 * 512 * L0 + (size_t)(seq - 4) * 512 * L1; }

struct EpiP {
    static constexpr bool PERM = true, AFTER_DRAIN = false;
    bf16_t* PA; bf16_t* PH; const float* bias;
    __device__ __forceinline__ void operator()(const f32x4 (&acc)[2][2][4][2], const pg8::Unit& u, int wr, int wc, int fr, int fq) const {
        const int row0 = u.pm * 256 + wr * 64 + fr, lc = wc * 32 + 8 * fq;
        if (u.pn >= 2 && u.pn < 6) {
            const int ch0 = (u.pn - 2) * 128 + lc;
            f32x4 bc[2], bh[2];
#pragma unroll
            for (int n = 0; n < 2; ++n) { bc[n] = *(const f32x4*)(bias + 512 + ch0 + 4 * n); bh[n] = *(const f32x4*)(bias + 1024 + ch0 + 4 * n); }
#pragma unroll
            for (int ai = 0; ai < 2; ++ai)
#pragma unroll
                for (int m = 0; m < 4; ++m) { const f32x4 g0 = (acc[ai][0][m][0] + bc[0]) * (acc[ai][1][m][0] + bh[0]), g1 = (acc[ai][0][m][1] + bc[1]) * (acc[ai][1][m][1] + bh[1]);
                    u32x4 w; w.x = pack2bf(g0[0], g0[1]); w.y = pack2bf(g0[2], g0[3]); w.z = pack2bf(g1[0], g1[1]); w.w = pack2bf(g1[2], g1[3]);
                    *(u32x4*)(PA + (size_t)(row0 + ai * 128 + m * 16) * 1024 + 512 + ch0) = w; }
        } else {
            const bool isB = u.pn < 2; bf16_t* base = isB ? PA : PH; const int pitch = isB ? 1024 : 1536;
            const int colt = isB ? u.pn * 256 : u.pn * 256 - 1536, bcol0 = u.pn * 256 + lc;
            f32x4 bv[2][2];
#pragma unroll
            for (int bj = 0; bj < 2; ++bj)
#pragma unroll
                for (int n = 0; n < 2; ++n) bv[bj][n] = *(const f32x4*)(bias + bcol0 + bj * 128 + 4 * n);
#pragma unroll
            for (int ai = 0; ai < 2; ++ai)
#pragma unroll
                for (int m = 0; m < 4; ++m) { bf16_t* rowp = base + (size_t)(row0 + ai * 128 + m * 16) * pitch + colt + lc;
#pragma unroll
                    for (int bj = 0; bj < 2; ++bj) { const f32x4 v0 = acc[ai][bj][m][0] + bv[bj][0], v1 = acc[ai][bj][m][1] + bv[bj][1];
                        u32x4 w; w.x = pack2bf(v0[0], v0[1]); w.y = pack2bf(v0[2], v0[3]); w.z = pack2bf(v1[0], v1[1]); w.w = pack2bf(v1[2], v1[3]);
                        *(u32x4*)(rowp + bj * 128) = w; } }
        }
    }
};
struct EpiH1 {
    static constexpr bool PERM = true, AFTER_DRAIN = false;
    const float* xp; const float* xs; bf16_t* out;
    __device__ __forceinline__ void operator()(const f32x4 (&acc)[2][2][4][2], const pg8::Unit& u, int wr, int wc, int fr, int fq) const {
        const int row0 = u.pm * 256 + wr * 64 + fr, col0 = u.pn * 256 + wc * 32 + 8 * fq;
        const float* xb = (u.pm * 256 < NTOK_P) ? xp : (xs - (size_t)NTOK_P * DM);
#pragma unroll
        for (int ai = 0; ai < 2; ++ai)
#pragma unroll
            for (int m = 0; m < 4; ++m) { const size_t off = (size_t)(row0 + ai * 128 + m * 16) * DM + col0;
#pragma unroll
                for (int bj = 0; bj < 2; ++bj) { const f32x4 x0 = *(const f32x4*)(xb + off + bj * 128), x1 = *(const f32x4*)(xb + off + bj * 128 + 4);
                    const f32x4 v0 = x0 * ALPHA_C + acc[ai][bj][m][0], v1 = x1 * ALPHA_C + acc[ai][bj][m][1];
                    u32x4 w; w.x = pack2bf(v0[0], v0[1]); w.y = pack2bf(v0[2], v0[3]); w.z = pack2bf(v1[0], v1[1]); w.w = pack2bf(v1[2], v1[3]);
                    *(u32x4*)(out + off + bj * 128) = w; } }
    }
};
struct EpiS {
    static constexpr bool PERM = true, AFTER_DRAIN = false;
    unsigned short* S;
    __device__ __forceinline__ void operator()(const f32x4 (&acc)[2][2][4][2], const pg8::Unit& u, int wr, int wc, int fr, int fq) const {
        const int row0 = u.pm * 256 + wr * 64 + fr, col0 = u.pn * 256 + wc * 32 + 8 * fq;
#pragma unroll
        for (int ai = 0; ai < 2; ++ai)
#pragma unroll
            for (int m = 0; m < 4; ++m) { unsigned short* rowp = S + (size_t)(row0 + ai * 128 + m * 16) * 2048 + col0;
#pragma unroll
                for (int bj = 0; bj < 2; ++bj) { const f32x4 v0 = acc[ai][bj][m][0], v1 = acc[ai][bj][m][1];
                    u32x4 w;
                    w.x = __builtin_bit_cast(unsigned, __builtin_amdgcn_cvt_pkrtz(v0[0], v0[1])); w.y = __builtin_bit_cast(unsigned, __builtin_amdgcn_cvt_pkrtz(v0[2], v0[3]));
                    w.z = __builtin_bit_cast(unsigned, __builtin_amdgcn_cvt_pkrtz(v1[0], v1[1])); w.w = __builtin_bit_cast(unsigned, __builtin_amdgcn_cvt_pkrtz(v1[2], v1[3]));
                    *(u32x4*)(rowp + bj * 128) = w; } }
    }
};

__device__ void cvt_f32_bf16(const float* __restrict__ s, bf16_t* __restrict__ d, size_t n8) {
    const size_t q = n8 >> 2;
    for (size_t i = (size_t)blockIdx.x * NTHREADS + threadIdx.x; i < q; i += (size_t)gridDim.x * NTHREADS) {
        float4 a[4], b[4];
#pragma unroll
        for (int k = 0; k < 4; ++k) { const f32x4 ta = __builtin_nontemporal_load((const f32x4*)s + 2 * (i + k * q)), tb = __builtin_nontemporal_load((const f32x4*)s + 2 * (i + k * q) + 1);
            a[k] = make_float4(ta[0], ta[1], ta[2], ta[3]); b[k] = make_float4(tb[0], tb[1], tb[2], tb[3]); }
#pragma unroll
        for (int k = 0; k < 4; ++k) { u32x4 w; w.x = pack2bf(a[k].x, a[k].y); w.y = pack2bf(a[k].z, a[k].w); w.z = pack2bf(b[k].x, b[k].y); w.w = pack2bf(b[k].z, b[k].w);
            ((u32x4*)d)[i + k * q] = w; }
    }
}
__device__ __forceinline__ unsigned pack4fp8(float a, float b, float c, float d) { int p = 0; p = __builtin_amdgcn_cvt_pk_fp8_f32(a, b, p, false); p = __builtin_amdgcn_cvt_pk_fp8_f32(c, d, p, true); return (unsigned)p; }
__device__ void cvt_f32_fp8(const float* __restrict__ s, unsigned char* __restrict__ d, size_t n16, float sc) {
    const size_t h = n16 >> 1;
    for (size_t i0 = (size_t)blockIdx.x * NTHREADS + threadIdx.x; i0 < h; i0 += (size_t)gridDim.x * NTHREADS) {
        float4 v[2][4];
#pragma unroll
        for (int k = 0; k < 2; ++k)
#pragma unroll
            for (int j = 0; j < 4; ++j) { const f32x4 t = __builtin_nontemporal_load((const f32x4*)s + 4 * (i0 + k * h) + j); v[k][j] = make_float4(t[0], t[1], t[2], t[3]); }
#pragma unroll
        for (int k = 0; k < 2; ++k) { const size_t i = i0 + k * h; const float4 a = v[k][0], b = v[k][1], c = v[k][2], e = v[k][3];
            u32x4 w; w.x = pack4fp8(a.x * sc, a.y * sc, a.z * sc, a.w * sc); w.y = pack4fp8(b.x * sc, b.y * sc, b.z * sc, b.w * sc); w.z = pack4fp8(c.x * sc, c.y * sc, c.z * sc, c.w * sc); w.w = pack4fp8(e.x * sc, e.y * sc, e.z * sc, e.w * sc);
            const size_t er = i >> 6, kk = i & 63;
            *(u32x4*)(d + ((kk >> 3) * 16384 + er) * 128 + (kk & 7) * 16) = w; }
    }
}
__device__ __forceinline__ int win_perm(int c) { if (c < 512 || c >= 1536) return c; const int ch = (c - 512) & 511, hsel = (c >= 1024) ? 128 : 0; return 512 + (ch >> 7) * 256 + hsel + (ch & 127); }
template <bool PERM_WIN>
__device__ void transpose_cvt(const float* __restrict__ src, int R, int C, bf16_t* __restrict__ dst, float* tile  ) {
    const int tid = threadIdx.x, nct = C / 64, nu = (R / 64) * nct;
    for (int u = blockIdx.x; u < nu; u += gridDim.x) {
        const int r0 = (u / nct) * 64, c0 = (u % nct) * 64;
        { const int r = tid >> 3, c8 = (tid & 7) * 8; const float4 a = *(const float4*)(src + (size_t)(r0 + r) * C + c0 + c8), b = *(const float4*)(src + (size_t)(r0 + r) * C + c0 + c8 + 4);
          float* t = tile + r * 65 + c8; t[0] = a.x; t[1] = a.y; t[2] = a.z; t[3] = a.w; t[4] = b.x; t[5] = b.y; t[6] = b.z; t[7] = b.w; }
        __syncthreads();
        { const int c = tid >> 3, r8 = (tid & 7) * 8; float v[8];
#pragma unroll
          for (int k = 0; k < 8; ++k) v[k] = tile[(r8 + k) * 65 + c];
          u32x4 w; w.x = pack2bf(v[0], v[1]); w.y = pack2bf(v[2], v[3]); w.z = pack2bf(v[4], v[5]); w.w = pack2bf(v[6], v[7]);
          *(u32x4*)(dst + (size_t)(PERM_WIN ? win_perm(c0 + c) : (c0 + c)) * R + r0 + r8) = w; }
        __syncthreads();
    }
}
__device__ void fold_wq_keys(const float* __restrict__ wq, const float* __restrict__ keys, bf16_t* __restrict__ WpT, float* lds) {
    float* sk = lds; float* sw = lds + 64 * 132;
    const int tid = threadIdx.x;
    for (int u = blockIdx.x; u < 512; u += gridDim.x) {
        const int hp = u >> 5, n0 = ((u >> 4) & 1) * 64, d0 = (u & 15) * 64;
        for (int i = tid; i < 64 * 32; i += NTHREADS) { const int r = i >> 5, k4 = (i & 31) * 4;
            const float4 a = *(const float4*)(keys + ((size_t)hp * 128 + n0 + r) * 128 + k4); float* t = sk + r * 132 + k4; t[0] = a.x; t[1] = a.y; t[2] = a.z; t[3] = a.w;
            const float4 b = *(const float4*)(wq + (size_t)(d0 + r) * 2048 + hp * 128 + k4); float* s = sw + r * 132 + k4; s[0] = b.x; s[1] = b.y; s[2] = b.z; s[3] = b.w; }
        __syncthreads();
        const int ni = tid >> 3, dj = tid & 7; float acc[8];
#pragma unroll
        for (int q = 0; q < 8; ++q) acc[q] = 0.f;
        for (int k = 0; k < 128; ++k) { const float a = sk[ni * 132 + k];
#pragma unroll
            for (int q = 0; q < 8; ++q) acc[q] += a * sw[(dj + 8 * q) * 132 + k]; }
#pragma unroll
        for (int q = 0; q < 8; ++q) WpT[((size_t)hp * 128 + n0 + ni) * 1024 + d0 + dj + 8 * q] = f2bf(acc[q]);
        __syncthreads();
    }
}
__device__ void hyena_filter_gen(const Params& p, float* lds) {
    const float* w1 = p.in[7]; const float* b1 = p.in[8]; const float* fr = p.in[9]; const float* w2 = p.in[10]; const float* b2 = p.in[11]; const float* w3 = p.in[12]; const float* dec = p.in[13];
    bf16_t* Fg = (bf16_t*)(p.ws + WS_FG); float* part = (float*)(p.ws + WS_PART);
    constexpr int NG = 3, NP = NG * 16;
    float* sfeat = lds; float* sh1 = sfeat + NP * 33; float* sh2 = sh1 + NP * 64;
    float* sw1 = sh2 + NP * 64; float* sw2 = sw1 + 33 * 64; float* sb1 = sw2 + 64 * 64; float* sb2 = sb1 + 64; float* sfr = sb2 + 64;
    const int tid = threadIdx.x, c = tid;
    for (int i = tid; i < 33 * 64; i += NTHREADS) sw1[i] = w1[i];
    for (int i = tid; i < 64 * 64; i += NTHREADS) sw2[i] = w2[i];
    if (tid < 64) { sb1[tid] = b1[tid]; sb2[tid] = b2[tid]; sfr[tid] = fr[tid]; }
    for (int idx = tid; idx < NP * 33; idx += NTHREADS) { const int q = idx / 33, f = idx % 33, it = (int)blockIdx.x + (q >> 4) * (int)gridDim.x;
        const int variant = it >= 512, L = variant ? L1 : L0, n = (variant ? it - 512 : it) * 16 + (q & 15); float val;
        if (f == 0) val = (float)n * (1.0f / (float)(L - 1));
        else { const int band = (f - 1) & 15; const float fj = 1e-4f + (float)band * ((15.0f - 1e-4f) / 15.0f); const float w = 6.283185307179586f * (float)n / (float)L; const float arg = fj * w;
               val = (f - 1) >= 16 ? -sinf(arg) : cosf(arg); }
        sfeat[idx] = val; }
    __syncthreads();
    for (int idx = tid; idx < NP * 64; idx += NTHREADS) { const int q = idx >> 6, j = idx & 63; float s = sb1[j];
#pragma unroll
        for (int f = 0; f < 33; ++f) s += sfeat[q * 33 + f] * sw1[f * 64 + j];
        sh1[idx] = sinf(sfr[j] * s); }
    __syncthreads();
    for (int idx = tid; idx < NP * 64; idx += NTHREADS) { const int q = idx >> 6, j = idx & 63; float s = sb2[j];
#pragma unroll 16
        for (int i = 0; i < 64; ++i) s += sh1[q * 64 + i] * sw2[i * 64 + j];
        sh2[idx] = sinf(sfr[j] * s); }
    __syncthreads();
    float acc0[NP], acc1[NP];
#pragma unroll
    for (int q = 0; q < NP; ++q) { acc0[q] = 0.f; acc1[q] = 0.f; }
#pragma unroll 2
    for (int j = 0; j < 64; ++j) { const float wa = w3[j * 1024 + c], wb = w3[j * 1024 + 512 + c];
#pragma unroll
        for (int q = 0; q < NP; ++q) { const float h = sh2[q * 64 + j]; acc0[q] += h * wa; acc1[q] += h * wb; } }
    const float a0 = fabsf(dec[c]), a1 = fabsf(dec[512 + c]);
    float sum0 = 0.f, sum1 = 0.f;
#pragma unroll
    for (int g = 0; g < NG; ++g) { const int it = (int)blockIdx.x + g * (int)gridDim.x;
        if (it < 768) { const int variant = it >= 512, L = variant ? L1 : L0, n0 = (variant ? it - 512 : it) * 16; const float tstep = 1.0f / (float)(L - 1);
            bf16_t* Fc = Fg + (variant ? (size_t)512 * 2 * L0 : 0) + (size_t)c * 2 * L; float s = 0.f;
#pragma unroll
            for (int pp = 0; pp < 16; ++pp) { const int n = n0 + pp; const float t = (float)n * tstep;
                const float v0 = acc0[g * 16 + pp] * expf(-t * a0), v1 = acc1[g * 16 + pp] * expf(-t * a1);
                s += fabsf(v0); Fc[L - n] = f2bf(v0);
                if (n >= 1) { s += fabsf(v1); Fc[L + n] = f2bf(v1); } else Fc[0] = 0; }
            if (variant) sum1 += s; else sum0 += s; } }
    part[((size_t)0 * 1024 + blockIdx.x) * 512 + c] = sum0;
    part[((size_t)1 * 1024 + blockIdx.x) * 512 + c] = sum1;
    __syncthreads();
}

__device__ __forceinline__ void unpack8(const u32x4 w, float (&f)[8]) { f[0] = bf_lo(w.x); f[1] = bf_hi(w.x); f[2] = bf_lo(w.y); f[3] = bf_hi(w.y); f[4] = bf_lo(w.z); f[5] = bf_hi(w.z); f[6] = bf_lo(w.w); f[7] = bf_hi(w.w); }
__device__ void phase_conv3(const Params& p, unsigned char* lds) {
    const bf16_t* PA = (const bf16_t*)p.out; const bf16_t* PH = (const bf16_t*)(p.ws + WS_PH);
    bf16_t* Ycat = (bf16_t*)(p.ws + WS_XB); bf16_t* zT = (bf16_t*)(p.ws + WS_ZT); bf16_t* x0T = (bf16_t*)((unsigned char*)p.out + OUT_X0T);
    const float* acw = p.in[4]; const float* hcw = p.in[5]; const float* hcb = p.in[6];
    bf16_t* sx0 = (bf16_t*)lds; bf16_t* sz = sx0 + 64 * 66;
    const int tid = threadIdx.x, r = tid >> 3, cg8 = tid & 7;
    const int ct = blockIdx.x & 7, c0 = ct * 64 + cg8 * 8;
    for (int tt = blockIdx.x >> 3; tt < 1024; tt += gridDim.x >> 3) {
        const int tok0 = tt * 64; int seq, L, tl; seq_of(tok0, seq, L, tl);
        const int tok = tok0 + r, pos = tl + r;
        const bool hp = pos > 0, hn = pos < L - 1;
        const u32x4 zero4 = {0u, 0u, 0u, 0u};
        { const bf16_t* row = PA + (size_t)tok * 1024 + c0;
          float ab[8], gc[8], gp[8], gn[8];
          unpack8(*(const u32x4*)row, ab); unpack8(*(const u32x4*)(row + 512), gc);
          unpack8(hp ? *(const u32x4*)(row - 1024 + 512) : zero4, gp); unpack8(hn ? *(const u32x4*)(row + 1024 + 512) : zero4, gn);
          float y[8];
#pragma unroll
          for (int k = 0; k < 8; ++k) y[k] = ab[k] * (acw[c0 + k] * gp[k] + acw[512 + c0 + k] * gc[k] + acw[1024 + c0 + k] * gn[k]);
          u32x4 w; w.x = pack2bf(y[0], y[1]); w.y = pack2bf(y[2], y[3]); w.z = pack2bf(y[4], y[5]); w.w = pack2bf(y[6], y[7]);
          *(u32x4*)(Ycat + (size_t)tok * DM + c0) = w; }
        { const bf16_t* row = PH + (size_t)tok * 1536 + c0; float hy[3][8];
#pragma unroll
          for (int part = 0; part < 3; ++part) { float vp[8], vc[8], vn[8]; const bf16_t* rp = row + part * 512; const int cc = part * 512 + c0;
              unpack8(*(const u32x4*)rp, vc); unpack8(hp ? *(const u32x4*)(rp - 1536) : zero4, vp); unpack8(hn ? *(const u32x4*)(rp + 1536) : zero4, vn);
#pragma unroll
              for (int k = 0; k < 8; ++k) hy[part][k] = hcw[cc + k] * vp[k] + hcw[1536 + cc + k] * vc[k] + hcw[3072 + cc + k] * vn[k] + hcb[cc + k]; }
#pragma unroll
          for (int k = 0; k < 8; ++k) { sx0[(cg8 * 8 + k) * 66 + r] = f2bf(hy[0][k]); sz[(cg8 * 8 + k) * 66 + r] = f2bf(hy[2][k] * hy[1][k]); } }
        __syncthreads();
        { const int c = tid >> 3, ch = tid & 7; const unsigned* s0 = (const unsigned*)(sx0 + c * 66 + ch * 8); const unsigned* s1 = (const unsigned*)(sz + c * 66 + ch * 8);
          u32x4 w0 = {s0[0], s0[1], s0[2], s0[3]}, w1 = {s1[0], s1[1], s1[2], s1[3]};
          const size_t o = seq_base_T(seq) + (size_t)(ct * 64 + c) * L + tl + ch * 8;
          *(u32x4*)(x0T + o) = w0; *(u32x4*)(zT + o) = w1; }
        __syncthreads();
    }
}

__device__ void phase_longconv(const Params& p, unsigned char* ldsg) {
    LAS unsigned char* lds = (LAS unsigned char*)ldsg;
    const bf16_t* Fg = (const bf16_t*)(p.ws + WS_FG); const float* part = (const float*)(p.ws + WS_PART);
    const bf16_t* zT = (const bf16_t*)(p.ws + WS_ZT); const bf16_t* x0T = (const bf16_t*)((const unsigned char*)p.out + OUT_X0T);
    bf16_t* yhT = (bf16_t*)(p.ws + WS_PH); const float* hyb = p.in[14];
    constexpr int ZSTR = 160, F1OFF = 32768 + 64, ZOFF = 65664, ZERO = ZOFF + 4 * 128 * ZSTR, SCAL = ZERO + 176;
    const int tid = threadIdx.x, wave = __builtin_amdgcn_readfirstlane(tid >> 6), lane = tid & 63, n = lane & 15, kq = lane >> 4;
    for (int u = blockIdx.x; u < 1024; u += gridDim.x) {
        const int variant = u >= 512, c = u & 511, L = variant ? L1 : L0, nb = L >> 6, nseq = variant ? 8 : 4;
        const bf16_t* Fc = Fg + (variant ? (size_t)512 * 2 * L0 : 0) + (size_t)c * 2 * L;
        for (int i = tid; i < (2 * L) / 8; i += NTHREADS) *(LAS u32x4*)(lds + i * 16) = ((const u32x4*)Fc)[i];
        for (int i = tid; i < nseq * (L / 8); i += NTHREADS) { const int b = i / (L / 8), q = i % (L / 8);
            const int seq = variant ? 4 + b : b;
            *(LAS u32x4*)(lds + ZOFF + (b * nb + (q >> 3)) * ZSTR + (q & 7) * 16) = *(const u32x4*)(zT + seq_base_T(seq) + (size_t)c * L + q * 8); }
        if (tid < 36) *(LAS unsigned*)(lds + ZERO + tid * 4) = 0u;
        if (wave == 0) { float s = 0.f; for (int b = lane; b < (int)gridDim.x; b += 64) s += part[((size_t)variant * 1024 + b) * 512 + c];
#pragma unroll
            for (int o = 32; o >= 1; o >>= 1) s += __shfl_xor(s, o);
            if (lane == 0) *(LAS float*)(lds + SCAL) = 1.0f / s; }
        __syncthreads();
        for (int i = tid; i < L; i += NTHREADS) { const unsigned a = *(LAS unsigned*)(lds + i * 4); const unsigned b = (i + 1 < L) ? *(LAS unsigned*)(lds + i * 4 + 4) : 0u;
            *(LAS unsigned*)(lds + F1OFF + i * 4) = (a >> 16) | (b << 16); }
        __syncthreads();
        const float inv = *(LAS float*)(lds + SCAL);
        const int b = variant ? wave : (wave >> 1), J0 = variant ? 0 : (wave & 1) * 64;
        f32x4 acc[4][4];
#pragma unroll
        for (int mi = 0; mi < 4; ++mi)
#pragma unroll
            for (int nt = 0; nt < 4; ++nt) acc[mi][nt] = (f32x4){0.f, 0.f, 0.f, 0.f};
        const int cl = ((n & 1) ? F1OFF - 2 : 0) + 2 * (L + 8 * kq - n);
        const int zrow = ZOFF + b * nb * ZSTR + kq * 16;
        const int dbeg = J0 - (nb - 1), dend = J0 + 63, zzero = ZERO + kq * 16;
#define LC_LOAD(A_, B_, dd) do { const int d_ = min((dd), dend); const int abase_ = cl - 128 * d_; \
            _Pragma("unroll") for (int ai = 0; ai < 6; ++ai) { const LAS unsigned* fp = (const LAS unsigned*)(lds + abase_ - 32 * (ai - 2)); const u32x4 w_ = {fp[0], fp[1], fp[2], fp[3]}; A_[ai] = __builtin_bit_cast(bf16x8, w_); } \
            _Pragma("unroll") for (int nt = 0; nt < 4; ++nt) { const int blk_ = J0 + 16 * nt + n - d_; const int ad_ = ((unsigned)blk_ < (unsigned)nb) ? zrow + blk_ * ZSTR : zzero; \
                B_[2 * nt] = *(const LAS bf16x8*)(lds + ad_); B_[2 * nt + 1] = *(const LAS bf16x8*)(lds + ad_ + 64); } } while (0)
#define LC_MMA(A_, B_, dd) do { const int d_ = (dd); \
            _Pragma("unroll") for (int nt = 0; nt < 4; ++nt) { const int lo_ = J0 + 16 * nt - (nb - 1), hi_ = J0 + 16 * nt + 15; \
                if (d_ >= lo_ && d_ <= hi_) { \
                    _Pragma("unroll") for (int mi = 0; mi < 4; ++mi) { acc[mi][nt] = __builtin_amdgcn_mfma_f32_16x16x32_bf16(A_[mi + 2], B_[2 * nt], acc[mi][nt], 0, 0, 0); \
                                                                        acc[mi][nt] = __builtin_amdgcn_mfma_f32_16x16x32_bf16(A_[mi], B_[2 * nt + 1], acc[mi][nt], 0, 0, 0); } } } } while (0)
        bf16x8 aX[6], bX[8], aY[6], bY[8];
        LC_LOAD(aX, bX, dbeg);
        for (int d = dbeg; d <= dend; d += 2) {
            LC_LOAD(aY, bY, d + 1);
            LC_MMA(aX, bX, d);
            LC_LOAD(aX, bX, d + 2);
            if (d + 1 <= dend) LC_MMA(aY, bY, d + 1);
        }
#undef LC_LOAD
#undef LC_MMA
        const float hb = hyb[c]; const int seq = variant ? 4 + b : b; const size_t gbase = seq_base_T(seq) + (size_t)c * L;
#pragma unroll
        for (int nt = 0; nt < 4; ++nt) { const int J = J0 + 16 * nt + n;
#pragma unroll
            for (int mi = 0; mi < 4; ++mi) { const int i0 = 16 * mi + 4 * kq; const size_t o = gbase + (size_t)J * 64 + i0;
                const u32x2 zw = *(const LAS u32x2*)(lds + ZOFF + (b * nb + J) * ZSTR + i0 * 2); const u32x2 xw = *(const u32x2*)(x0T + o);
                const f32x4 v = acc[mi][nt];
                const float y0 = bf_lo(xw.x) * (v[0] * inv + hb * bf_lo(zw.x)), y1 = bf_hi(xw.x) * (v[1] * inv + hb * bf_hi(zw.x));
                const float y2 = bf_lo(xw.y) * (v[2] * inv + hb * bf_lo(zw.y)), y3 = bf_hi(xw.y) * (v[3] * inv + hb * bf_hi(zw.y));
                u32x2 w; w.x = pack2bf(y0, y1); w.y = pack2bf(y2, y3); *(u32x2*)(yhT + o) = w; } }
        __syncthreads();
    }
}

__device__ void phase_yh_transpose(const Params& p, unsigned char* lds) {
    const bf16_t* yhT = (const bf16_t*)(p.ws + WS_PH); bf16_t* Ycat = (bf16_t*)(p.ws + WS_XB);
    bf16_t* st = (bf16_t*)lds; const int tid = threadIdx.x;
    for (int u = blockIdx.x; u < 8192; u += gridDim.x) {
        const int tt = u >> 3, ct = u & 7, tok0 = tt * 64; int seq, L, tl; seq_of(tok0, seq, L, tl);
        { const int c = tid >> 3, ch = tid & 7; const u32x4 w = *(const u32x4*)(yhT + seq_base_T(seq) + (size_t)(ct * 64 + c) * L + tl + ch * 8);
          unsigned* s = (unsigned*)(st + c * 66 + ch * 8); s[0] = w.x; s[1] = w.y; s[2] = w.z; s[3] = w.w; }
        __syncthreads();
        { const int r = tid >> 3, cg8 = tid & 7; unsigned short v[8];
#pragma unroll
          for (int k = 0; k < 8; ++k) v[k] = st[(cg8 * 8 + k) * 66 + r];
          u32x4 w; w.x = v[0] | ((unsigned)v[1] << 16); w.y = v[2] | ((unsigned)v[3] << 16); w.z = v[4] | ((unsigned)v[5] << 16); w.w = v[6] | ((unsigned)v[7] << 16);
          *(u32x4*)(Ycat + (size_t)(tok0 + r) * DM + 512 + ct * 64 + cg8 * 8) = w; }
        __syncthreads();
    }
}

template <bool OUT_BF16>
__device__ __forceinline__ void ln_rows2(const bf16_t* __restrict__ hin, float* __restrict__ outf, bf16_t* __restrict__ outb, const float* __restrict__ g, const float* __restrict__ be, int row_lo, int row_hi, int wv0, int nwv) {
    const int lane = threadIdx.x & 63;
    for (int row = row_lo + wv0 * 2; row < row_hi; row += nwv * 2) {
        float4 v[2][4]; float s[2] = {0.f, 0.f};
#pragma unroll
        for (int r = 0; r < 2; ++r)
#pragma unroll
            for (int k = 0; k < 4; ++k) { const u32x2 w = ((const u32x2*)(hin + (size_t)(row + r) * DM))[lane + 64 * k]; v[r][k] = make_float4(bf_lo(w.x), bf_hi(w.x), bf_lo(w.y), bf_hi(w.y)); }
#pragma unroll
        for (int r = 0; r < 2; ++r)
#pragma unroll
            for (int k = 0; k < 4; ++k) s[r] += (v[r][k].x + v[r][k].y) + (v[r][k].z + v[r][k].w);
#pragma unroll
        for (int o = 32; o >= 1; o >>= 1) { s[0] += __shfl_xor(s[0], o); s[1] += __shfl_xor(s[1], o); }
        float q[2] = {0.f, 0.f}; const float mu[2] = {s[0] * (1.0f / DM), s[1] * (1.0f / DM)};
#pragma unroll
        for (int r = 0; r < 2; ++r)
#pragma unroll
            for (int k = 0; k < 4; ++k) { const float a = v[r][k].x - mu[r], b = v[r][k].y - mu[r], c = v[r][k].z - mu[r], d = v[r][k].w - mu[r]; q[r] += (a * a + b * b) + (c * c + d * d); }
#pragma unroll
        for (int o = 32; o >= 1; o >>= 1) { q[0] += __shfl_xor(q[0], o); q[1] += __shfl_xor(q[1], o); }
        const float rstd[2] = {1.0f / sqrtf(q[0] * (1.0f / DM) + LN_EPS_C), 1.0f / sqrtf(q[1] * (1.0f / DM) + LN_EPS_C)};
#pragma unroll
        for (int k = 0; k < 4; ++k) { const float4 gg = ((const float4*)g)[lane + 64 * k], bb = ((const float4*)be)[lane + 64 * k];
#pragma unroll
            for (int r = 0; r < 2; ++r) { float4 y;
                y.x = (v[r][k].x - mu[r]) * rstd[r] * gg.x + bb.x; y.y = (v[r][k].y - mu[r]) * rstd[r] * gg.y + bb.y; y.z = (v[r][k].z - mu[r]) * rstd[r] * gg.z + bb.z; y.w = (v[r][k].w - mu[r]) * rstd[r] * gg.w + bb.w;
                if (OUT_BF16) { u32x2 w; w.x = pack2bf(y.x, y.y); w.y = pack2bf(y.z, y.w); ((u32x2*)(outb + (size_t)(row + r) * DM))[lane + 64 * k] = w; }
                else { const f32x4 yv = {y.x, y.y, y.z, y.w}; __builtin_nontemporal_store(yv, (f32x4*)(outf + (size_t)(row + r) * DM) + lane + 64 * k); } } }
    }
}
__device__ void phase_ln1_panel(const Params& p, int pm) { ln_rows2<true>((const bf16_t*)p.out, nullptr, (bf16_t*)(p.ws + WS_XB), p.in[16], p.in[17], pm * 256, pm * 256 + 256, threadIdx.x >> 6, 8); }

__device__ __forceinline__ int f2key(float f) { const int b = __float_as_int(f); return b ^ ((b >> 31) & 0x7fffffff); }
__device__ __forceinline__ float key2f(int k) { return __int_as_float(k ^ ((k >> 31) & 0x7fffffff)); }
__device__ __forceinline__ void sort16_desc(int (&k)[16]) {
    constexpr int PI[63] = {0,2,0,1,1,4,6,4,5,5,0,2,2,1,3,3,1,3,5,8,10,8,9,9,12,14,12,13,13,8,10,10,9,11,11,9,11,13,0,4,4,2,6,6,2,6,10,1,5,5,3,7,7,3,7,11,1,3,5,7,9,11,13};
    constexpr int PJ[63] = {1,3,2,3,2,5,7,6,7,6,4,6,4,5,7,5,2,4,6,9,11,10,11,10,13,15,14,15,14,12,14,12,13,15,13,10,12,14,8,12,8,10,14,10,4,8,12,9,13,9,11,15,11,5,9,13,2,4,6,8,10,12,14};
#pragma unroll
    for (int e = 0; e < 63; ++e) { const int hi = max(k[PI[e]], k[PJ[e]]), lo = min(k[PI[e]], k[PJ[e]]); k[PI[e]] = hi; k[PJ[e]] = lo; }
}
__device__ __forceinline__ void merge_top16(int (&a)[16], const int (&b)[16]) {
#pragma unroll
    for (int i = 0; i < 16; ++i) a[i] = max(a[i], b[15 - i]);
#pragma unroll
    for (int j = 8; j > 0; j >>= 1)
#pragma unroll
        for (int i = 0; i < 16; ++i) { const int l = i ^ j; if (l > i) { const int hi = max(a[i], a[l]), lo = min(a[i], a[l]); a[i] = hi; a[l] = lo; } }
}
__device__ __forceinline__ void chunk_keys(const u32x4 w0, const u32x4 w1, int idx0, int (&k)[16]) {
    const unsigned ww[8] = {w0.x, w0.y, w0.z, w0.w, w1.x, w1.y, w1.z, w1.w};
#pragma unroll
    for (int e = 0; e < 8; ++e) { const h2_t h = __builtin_bit_cast(h2_t, ww[e]);
        k[2 * e] = (f2key((float)h.x) & ~0x7F) | (idx0 + 2 * e); k[2 * e + 1] = (f2key((float)h.y) & ~0x7F) | (idx0 + 2 * e + 1); }
}
__device__ __forceinline__ void row_top16(const unsigned short* __restrict__ row, int (&run)[16]) {
    const u32x4* rp = (const u32x4*)row;
    u32x4 w0 = rp[0], w1 = rp[1];
    chunk_keys(w0, w1, 0, run); sort16_desc(run);
    w0 = rp[2]; w1 = rp[3];
#pragma unroll 1
    for (int ch = 1; ch < 8; ++ch) {
        int k[16]; chunk_keys(w0, w1, ch * 16, k);
        if (ch < 7) { w0 = rp[2 * ch + 2]; w1 = rp[2 * ch + 3]; }
        sort16_desc(k); merge_top16(run, k);
    }
}
__device__ __forceinline__ void row_top16_lds(const LAS unsigned char* rowp, int (&run)[16]) {
    const LAS u32x4* rp = (const LAS u32x4*)rowp;
    chunk_keys(rp[0], rp[1], 0, run); sort16_desc(run);
#pragma unroll 1
    for (int ch = 1; ch < 8; ++ch) { int k[16]; chunk_keys(rp[2 * ch], rp[2 * ch + 1], ch * 16, k); sort16_desc(k); merge_top16(run, k); }
}
__device__ void phase_topk(const Params& p, unsigned char* ldsg, int gt_lo, int gt_hi, int gt_stride) {
    const unsigned short* S = (const unsigned short*)(p.ws + WS_PH);
    int* eidx = (int*)(p.ws + WS_EIDX); float* gate = (float*)(p.ws + WS_GATE);
    const int wave = threadIdx.x >> 6, lane = threadIdx.x & 63;
    LAS unsigned char* wb = (LAS unsigned char*)ldsg + wave * 17408;
    LAS int* sl = (LAS int*)wb + lane * 33;
    constexpr int OFF[16] = {0, 16, 24, 29, 33, 36, 38, 40, 42, 43, 44, 45, 46, 47, 48, 49};
    for (int gt = gt_lo + threadIdx.x; gt < gt_hi; gt += gt_stride) {
        const int t0 = (gt - lane) >> 3;
        int a[16], b[16];
#pragma unroll
        for (int pp = 0; pp < 2; ++pp) {
            u32x4 v[16];
#pragma unroll
            for (int i = 0; i < 16; ++i) { const int q = i * 64 + lane, rowid = q >> 4, within = q & 15;
                v[i] = *(const u32x4*)(S + (size_t)(t0 + (rowid >> 3)) * 2048 + ((rowid & 7) * 2 + pp) * 128 + within * 8); }
#pragma unroll
            for (int i = 0; i < 16; ++i) { const int q = i * 64 + lane, rowid = q >> 4, within = q & 15; *(LAS u32x4*)(wb + rowid * 272 + within * 16) = v[i]; }
            if (pp == 0) row_top16_lds(wb + lane * 272, a); else row_top16_lds(wb + lane * 272, b);
        }
#pragma unroll
        for (int i = 0; i < 16; ++i) { sl[i] = a[i]; sl[16 + i] = b[i]; }
        float va[16], vb[16];
#pragma unroll
        for (int i = 0; i < 16; ++i) { va[i] = key2f(a[i] & ~0x7F); vb[i] = key2f(b[i] & ~0x7F); }
        int cnd[4][16];
#pragma unroll
        for (int q = 0; q < 4; ++q)
#pragma unroll
            for (int i = 0; i < 16; ++i) cnd[q][i] = (int)0x80000000;
#pragma unroll
        for (int i = 0; i < 16; ++i)
#pragma unroll
            for (int j = 0; j < 16 / (i + 1); ++j) { const int pos = OFF[i] + j; cnd[pos >> 4][pos & 15] = (f2key(va[i] + vb[j]) & ~0xFF) | (i * 16 + j); }
        sort16_desc(cnd[0]); sort16_desc(cnd[1]); sort16_desc(cnd[2]); sort16_desc(cnd[3]);
        merge_top16(cnd[0], cnd[1]); merge_top16(cnd[2], cnd[3]); merge_top16(cnd[0], cnd[2]);
        float best[16]; int ei[16]; float m = -3.0e38f;
#pragma unroll
        for (int r = 0; r < 16; ++r) { const int code = cnd[0][r] & 0xFF; const int ka = sl[code >> 4], kb = sl[16 + (code & 15)];
            ei[r] = (ka & 0x7F) * 128 + (kb & 0x7F); best[r] = key2f(ka & ~0x7F) + key2f(kb & ~0x7F); m = fmaxf(m, best[r]); }
        float se = 0.f;
#pragma unroll
        for (int r = 0; r < 16; ++r) { best[r] = __expf(best[r] - m); se += best[r]; }
        const float inv = 1.0f / se;
#pragma unroll
        for (int q = 0; q < 4; ++q) { ((int4*)(eidx + (size_t)gt * 16))[q] = make_int4(ei[4 * q], ei[4 * q + 1], ei[4 * q + 2], ei[4 * q + 3]);
            ((float4*)(gate + (size_t)gt * 16))[q] = make_float4(best[4 * q] * inv, best[4 * q + 1] * inv, best[4 * q + 2] * inv, best[4 * q + 3] * inv); }
    }
}

typedef float f32x2 __attribute__((ext_vector_type(2)));
template <int CTRL> __device__ __forceinline__ float dpp_f(float v) { return __int_as_float(__builtin_amdgcn_update_dpp(0, __float_as_int(v), CTRL, 0xF, 0xF, false)); }
__device__ __forceinline__ void pk_load_ev(int (&ev)[16], const int* __restrict__ eidx, int tok, int q) {
    const int4* ep = (const int4*)(eidx + (size_t)tok * 128 + 16 * q);
#pragma unroll
    for (int k = 0; k < 4; ++k) { const int4 t = ep[k]; ev[4 * k] = t.x; ev[4 * k + 1] = t.y; ev[4 * k + 2] = t.z; ev[4 * k + 3] = t.w; }
}
__device__ __forceinline__ void pk_load_rows(u32x4 (&r)[16], const int (&ev)[16], const unsigned char* __restrict__ tab, unsigned loff) {
#pragma unroll
    for (int s = 0; s < 16; ++s) r[s] = *(const u32x4*)(tab + ((unsigned)ev[s] * 128u + loff));
}
__device__ __forceinline__ void pk_load_x(f32x2 (&xv)[8], const bf16_t* __restrict__ xrow) {
    const u32x4 a = ((const u32x4*)xrow)[0], b = ((const u32x4*)xrow)[1];
    xv[0] = (f32x2){bf_lo(a.x), bf_hi(a.x)}; xv[1] = (f32x2){bf_lo(a.y), bf_hi(a.y)}; xv[2] = (f32x2){bf_lo(a.z), bf_hi(a.z)}; xv[3] = (f32x2){bf_lo(a.w), bf_hi(a.w)};
    xv[4] = (f32x2){bf_lo(b.x), bf_hi(b.x)}; xv[5] = (f32x2){bf_lo(b.y), bf_hi(b.y)}; xv[6] = (f32x2){bf_lo(b.z), bf_hi(b.z)}; xv[7] = (f32x2){bf_lo(b.w), bf_hi(b.w)};
}
__device__ __forceinline__ float xchg4(float v) { return dpp_f<0x1B>(dpp_f<0x141>(v)); }
__device__ __forceinline__ void pk_u_compute(const u32x4 (&r)[16], const f32x2 (&xv)[8], bf16_t* __restrict__ pr, int c) {
    float d[16];
#pragma unroll
    for (int s = 0; s < 16; ++s) {
        f32x2 acc = {0.f, 0.f};
        acc += __builtin_amdgcn_cvt_pk_f32_fp8((int)r[s].x, false) * xv[0]; acc += __builtin_amdgcn_cvt_pk_f32_fp8((int)r[s].x, true) * xv[1];
        acc += __builtin_amdgcn_cvt_pk_f32_fp8((int)r[s].y, false) * xv[2]; acc += __builtin_amdgcn_cvt_pk_f32_fp8((int)r[s].y, true) * xv[3];
        acc += __builtin_amdgcn_cvt_pk_f32_fp8((int)r[s].z, false) * xv[4]; acc += __builtin_amdgcn_cvt_pk_f32_fp8((int)r[s].z, true) * xv[5];
        acc += __builtin_amdgcn_cvt_pk_f32_fp8((int)r[s].w, false) * xv[6]; acc += __builtin_amdgcn_cvt_pk_f32_fp8((int)r[s].w, true) * xv[7];
        d[s] = acc.x + acc.y;
    }
    float r1[8]; const bool b2 = (c & 4) != 0;
#pragma unroll
    for (int k = 0; k < 8; ++k) { const float send = b2 ? d[k] : d[k + 8], keep = b2 ? d[k + 8] : d[k]; r1[k] = keep + xchg4(send); }
    float r2[4]; const bool b1 = (c & 2) != 0;
#pragma unroll
    for (int k = 0; k < 4; ++k) { const float send = b1 ? r1[k] : r1[k + 4], keep = b1 ? r1[k + 4] : r1[k]; r2[k] = keep + dpp_f<0x4E>(send); }
    float r3[2]; const bool b0 = (c & 1) != 0;
#pragma unroll
    for (int k = 0; k < 2; ++k) { const float send = b0 ? r2[k] : r2[k + 2], keep = b0 ? r2[k + 2] : r2[k]; r3[k] = keep + dpp_f<0xB1>(send); }
    *(unsigned*)(pr + 2 * c) = pack2bf(r3[0], r3[1]);
}
__device__ void phase_peer_u(const Params& p) {
    const bf16_t* x1 = (const bf16_t*)(p.ws + WS_XB); const int* eidx = (const int*)(p.ws + WS_EIDX); bf16_t* partd = (bf16_t*)(p.ws + WS_PARTD);
    const int wave = threadIdx.x >> 6, lane = threadIdx.x & 63, q = lane >> 3, c = lane & 7;
    const int xs = blockIdx.x & 7, y = blockIdx.x >> 3, nY = gridDim.x >> 3, step = nY * 8;
    const unsigned char* tab = p.ws + WS_U8 + (size_t)xs * (16384 * 128); const unsigned loff = 16u * c;
    const bf16_t* xcol = x1 + 128 * xs + 16 * c;
    bf16_t* pbase = partd + (size_t)xs * NTOK * 128 + 16 * q;
    const int tok0 = y * 8 + wave;
    if (tok0 >= NTOK) return;
    const int ntok = (NTOK - tok0 + step - 1) / step, last = tok0 + (ntok - 1) * step;
    bf16_t* dummy = (bf16_t*)(p.ws + WS_DUMMY) + (size_t)(blockIdx.x * 8 + wave) * 128 + 16 * q;
    int ev[16]; f32x2 xvA[8], xvB[8]; u32x4 rA[16], rB[16];
    pk_load_ev(ev, eidx, tok0, q); pk_load_x(xvA, xcol + (size_t)tok0 * DM); pk_load_rows(rA, ev, tab, loff);
    pk_load_ev(ev, eidx, min(tok0 + step, last), q);
    for (int i = 0; i < ntok; i += 2) {
        const int tA = tok0 + i * step, tB = min(tA + step, last), tC = min(tA + 2 * step, last), tD = min(tA + 3 * step, last);
        pk_load_x(xvB, xcol + (size_t)tB * DM); pk_load_rows(rB, ev, tab, loff);
        pk_load_ev(ev, eidx, tC, q);
        pk_u_compute(rA, xvA, pbase + (size_t)tA * 128, c);
        pk_load_x(xvA, xcol + (size_t)tC * DM); pk_load_rows(rA, ev, tab, loff);
        pk_load_ev(ev, eidx, tD, q);
        pk_u_compute(rB, xvB, (i + 1 < ntok) ? pbase + (size_t)tB * 128 : dummy, c);
    }
}
__device__ __forceinline__ float gelu_erf(float d) { return 0.5f * d * (1.0f + erff(d * 0.70710678118654752f)); }
__device__ void phase_peer_coef(const Params& p) {
    const bf16_t* partd = (const bf16_t*)(p.ws + WS_PARTD); float* gate = (float*)(p.ws + WS_GATE);
    for (size_t i = (size_t)blockIdx.x * NTHREADS + threadIdx.x; i < (size_t)NTOK * 128 / 8; i += (size_t)gridDim.x * NTHREADS) {
        u32x4 t[8];
#pragma unroll
        for (int x = 0; x < 8; ++x) t[x] = ((const u32x4*)(partd + (size_t)x * NTOK * 128))[i];
        float4 g0 = ((const float4*)gate)[2 * i], g1 = ((const float4*)gate)[2 * i + 1];
        float sm[8];
#pragma unroll
        for (int k = 0; k < 8; ++k) sm[k] = 0.f;
#pragma unroll
        for (int x = 0; x < 8; ++x) { sm[0] += bf_lo(t[x].x); sm[1] += bf_hi(t[x].x); sm[2] += bf_lo(t[x].y); sm[3] += bf_hi(t[x].y); sm[4] += bf_lo(t[x].z); sm[5] += bf_hi(t[x].z); sm[6] += bf_lo(t[x].w); sm[7] += bf_hi(t[x].w); }
        g0.x *= gelu_erf(sm[0] * (1.0f / U_SCALE)); g0.y *= gelu_erf(sm[1] * (1.0f / U_SCALE)); g0.z *= gelu_erf(sm[2] * (1.0f / U_SCALE)); g0.w *= gelu_erf(sm[3] * (1.0f / U_SCALE));
        g1.x *= gelu_erf(sm[4] * (1.0f / U_SCALE)); g1.y *= gelu_erf(sm[5] * (1.0f / U_SCALE)); g1.z *= gelu_erf(sm[6] * (1.0f / U_SCALE)); g1.w *= gelu_erf(sm[7] * (1.0f / U_SCALE));
        ((float4*)gate)[2 * i] = g0; ((float4*)gate)[2 * i + 1] = g1;
    }
}
__device__ __forceinline__ void pk_load_cf(float (&cf)[16], const float* __restrict__ coef, int tok, int q) {
    const float4* cp = (const float4*)(coef + (size_t)tok * 128 + 16 * q);
#pragma unroll
    for (int k = 0; k < 4; ++k) { const float4 f = cp[k]; cf[4 * k] = f.x; cf[4 * k + 1] = f.y; cf[4 * k + 2] = f.z; cf[4 * k + 3] = f.w; }
}
__device__ __forceinline__ void pk_v_compute(const u32x4 (&r)[16], const float (&cf)[16], unsigned xw, bf16_t* __restrict__ orow, int q) {
    f32x2 acc[8];
#pragma unroll
    for (int k = 0; k < 8; ++k) acc[k] = (f32x2){0.f, 0.f};
#pragma unroll
    for (int s = 0; s < 16; ++s) { const f32x2 c2 = {cf[s], cf[s]};
        acc[0] += __builtin_amdgcn_cvt_pk_f32_fp8((int)r[s].x, false) * c2; acc[1] += __builtin_amdgcn_cvt_pk_f32_fp8((int)r[s].x, true) * c2;
        acc[2] += __builtin_amdgcn_cvt_pk_f32_fp8((int)r[s].y, false) * c2; acc[3] += __builtin_amdgcn_cvt_pk_f32_fp8((int)r[s].y, true) * c2;
        acc[4] += __builtin_amdgcn_cvt_pk_f32_fp8((int)r[s].z, false) * c2; acc[5] += __builtin_amdgcn_cvt_pk_f32_fp8((int)r[s].z, true) * c2;
        acc[6] += __builtin_amdgcn_cvt_pk_f32_fp8((int)r[s].w, false) * c2; acc[7] += __builtin_amdgcn_cvt_pk_f32_fp8((int)r[s].w, true) * c2; }
    f32x2 b4[4];
#pragma unroll
    for (int k = 0; k < 4; ++k) { const auto sx = __builtin_amdgcn_permlane32_swap(__float_as_uint(acc[k].x), __float_as_uint(acc[k + 4].x), false, false);
        const auto sy = __builtin_amdgcn_permlane32_swap(__float_as_uint(acc[k].y), __float_as_uint(acc[k + 4].y), false, false);
        b4[k] = (f32x2){__uint_as_float(sx[0]) + __uint_as_float(sx[1]), __uint_as_float(sy[0]) + __uint_as_float(sy[1])}; }
    f32x2 b2[2];
#pragma unroll
    for (int k = 0; k < 2; ++k) { const auto sx = __builtin_amdgcn_permlane16_swap(__float_as_uint(b4[k].x), __float_as_uint(b4[k + 2].x), false, false);
        const auto sy = __builtin_amdgcn_permlane16_swap(__float_as_uint(b4[k].y), __float_as_uint(b4[k + 2].y), false, false);
        b2[k] = (f32x2){__uint_as_float(sx[0]) + __uint_as_float(sx[1]), __uint_as_float(sy[0]) + __uint_as_float(sy[1])}; }
    f32x2 b1;
    { const bool up = (q & 1) != 0; const f32x2 send = up ? b2[0] : b2[1], keep = up ? b2[1] : b2[0];
      b1 = (f32x2){keep.x + dpp_f<0x128>(send.x), keep.y + dpp_f<0x128>(send.y)}; }
    const int co = 8 * (q >> 2) + 4 * ((q >> 1) & 1) + 2 * (q & 1);
    unsigned* op = (unsigned*)(orow + co);
    *op = pack2bf(ALPHA_C * bf_lo(xw) + b1.x * (1.0f / V_SCALE), ALPHA_C * bf_hi(xw) + b1.y * (1.0f / V_SCALE));
}
__device__ void phase_peer_v(const Params& p) {
    float* out = p.out; const int* eidx = (const int*)(p.ws + WS_EIDX); const float* coef = (const float*)(p.ws + WS_GATE);
    const int wave = threadIdx.x >> 6, lane = threadIdx.x & 63, q = lane >> 3, c = lane & 7;
    const int xs = blockIdx.x & 7, y = blockIdx.x >> 3, nY = gridDim.x >> 3, step = nY * 8;
    const unsigned char* tab = p.ws + WS_V8 + (size_t)xs * (16384 * 128); const unsigned loff = 16u * c;
    bf16_t* ocol = (bf16_t*)(p.ws + WS_XB) + 128 * xs + 16 * c;
    const int tok0 = y * 8 + wave;
    if (tok0 >= NTOK) return;
    const int ntok = (NTOK - tok0 + step - 1) / step, last = tok0 + (ntok - 1) * step;
    bf16_t* dummy = (bf16_t*)(p.ws + WS_DUMMY) + (size_t)(blockIdx.x * 8 + wave) * 128 + 16 * c;
    const int co = 8 * (q >> 2) + 4 * ((q >> 1) & 1) + 2 * (q & 1);
    int ev[16]; float cfA[16], cfB[16]; u32x4 rA[16], rB[16]; unsigned xrA, xrB;
    const bf16_t* xres = (const bf16_t*)(p.ws + WS_XB) + 128 * xs + 16 * c + co;
    pk_load_ev(ev, eidx, tok0, q); pk_load_cf(cfA, coef, tok0, q); xrA = *(const unsigned*)(xres + (size_t)tok0 * DM); pk_load_rows(rA, ev, tab, loff);
    pk_load_ev(ev, eidx, min(tok0 + step, last), q);
    for (int i = 0; i < ntok; i += 2) {
        const int tA = tok0 + i * step, tB = min(tA + step, last), tC = min(tA + 2 * step, last), tD = min(tA + 3 * step, last);
        pk_load_cf(cfB, coef, tB, q); xrB = *(const unsigned*)(xres + (size_t)tB * DM); pk_load_rows(rB, ev, tab, loff);
        pk_load_ev(ev, eidx, tC, q);
        pk_v_compute(rA, cfA, xrA, ocol + (size_t)tA * DM, q);
        pk_load_cf(cfA, coef, tC, q); xrA = *(const unsigned*)(xres + (size_t)tC * DM); pk_load_rows(rA, ev, tab, loff);
        pk_load_ev(ev, eidx, tD, q);
        pk_v_compute(rB, cfB, xrB, (i + 1 < ntok) ? ocol + (size_t)tB * DM : dummy, q);
    }
}
__device__ void phase_ln2(const Params& p) { ln_rows2<false>((const bf16_t*)(p.ws + WS_XB), p.out, nullptr, p.in[22], p.in[23], 0, NTOK, blockIdx.x * 8 + (threadIdx.x >> 6), gridDim.x * 8); }

#ifdef CONV_CHECK
constexpr size_t WS_CHK = 496 * MiB;
__device__ void conv_check(const Params& p) {
    const bf16_t* Fg = (const bf16_t*)(p.ws + WS_FG); const float* part = (const float*)(p.ws + WS_PART);
    const bf16_t* zT = (const bf16_t*)(p.ws + WS_ZT); const bf16_t* x0T = (const bf16_t*)((const unsigned char*)p.out + OUT_X0T);
    const bf16_t* yhT = (const bf16_t*)(p.ws + WS_PH); const float* hyb = p.in[14]; float* chk = (float*)(p.ws + WS_CHK);
    const int wave = threadIdx.x >> 6, lane = threadIdx.x & 63; const unsigned w = blockIdx.x * 8 + wave;
    const int seq = w % 12, variant = seq >= 4, L = variant ? L1 : L0, c = (w * 37u) % 512u; const unsigned sel = (w / 12u) % 8u;
    int t = (int)(((w * 2654435761u) >> 7) % (unsigned)L);
    if (sel == 0) t = 0; else if (sel == 1) t = L - 1; else if (sel == 2) t = 63; else if (sel == 3) t = 64; else if (sel == 4) t = L / 2;
    const bf16_t* Fc = Fg + (variant ? (size_t)512 * 2 * L0 : 0) + (size_t)c * 2 * L; const bf16_t* zc = zT + seq_base_T(seq) + (size_t)c * L;
    float sacc = 0.f; for (int s2 = lane; s2 < L; s2 += 64) sacc += __uint_as_float((unsigned)zc[s2] << 16) * __uint_as_float((unsigned)Fc[L - (t - s2)] << 16);
    float nrm = 0.f; for (int b = lane; b < (int)gridDim.x; b += 64) nrm += part[((size_t)variant * 1024 + b) * 512 + c];
#pragma unroll
    for (int o = 32; o >= 1; o >>= 1) { sacc += __shfl_xor(sacc, o); nrm += __shfl_xor(nrm, o); }
    const float x0 = __uint_as_float((unsigned)x0T[seq_base_T(seq) + (size_t)c * L + t] << 16), zt = __uint_as_float((unsigned)zc[t] << 16);
    const float ref = x0 * (sacc / nrm + hyb[c] * zt), got = __uint_as_float((unsigned)yhT[seq_base_T(seq) + (size_t)c * L + t] << 16);
    if (lane == 0) { atomicAdd(chk, (got - ref) * (got - ref)); atomicAdd(chk + 1, ref * ref); }
}
#endif
struct PanelOrder {
    int pm, nN;
    __device__ bool next(int i, pg8::Unit& u) const { if (i >= nN) return false; u.pm = pm; u.pn = i; return true; }
    __device__ __forceinline__ void a_ready(const pg8::Unit&) const {}
    __device__ __forceinline__ void done(const pg8::Unit&) const {}
};
__device__ __forceinline__ void block_handoff() { asm volatile("s_waitcnt vmcnt(0) lgkmcnt(0)" ::: "memory"); __syncthreads(); }
__device__ void phase_panel_chain(const Params& p, unsigned char* lds) {
    unsigned char* ws = p.ws;
    const int pm = blockIdx.x;
    if (pm < NTOK / 256) {
        { pg8::Gemm g{(const bf16_t*)(ws + WS_XB), (const bf16_t*)(ws + WS_WOUTT), NTOK, DM, DM}; PanelOrder S{pm, DM / 256};
          EpiH1 E{p.in[0], p.in[1], (bf16_t*)p.out};
          pg8::gemm_phase<EpiH1, PanelOrder, false>((LAS unsigned char*)lds, g, S, E, nullptr); }
        block_handoff();
        phase_ln1_panel(p, pm);
        block_handoff();
        { pg8::Gemm g{(const bf16_t*)(ws + WS_XB), (const bf16_t*)(ws + WS_WPT), NTOK, 2048, DM}; PanelOrder S{pm, 2048 / 256};
          EpiS E{(unsigned short*)(ws + WS_PH)};
          pg8::gemm_phase<EpiS, PanelOrder, false>((LAS unsigned char*)lds, g, S, E, nullptr); }
        block_handoff();
        phase_topk(p, lds, pm * 2048, pm * 2048 + 2048, NTHREADS);
        block_handoff();
    }
}

#define XB_TMO      128
#define XB_XCNT(j)  (256  + 64 * (j))
#define XB_XSUB(j)  (1280 + 64 * (j))
#define XB_XGEN(j)  (2304 + 64 * (j))
#define XB_TOP      3328
#define XB_TOPGEN   3392
#define XCD_BAR_WORDS 3456
#define XB_SPIN_CAP (1u << 18)

__device__ __forceinline__ unsigned xb_ld(unsigned* p)              { return __hip_atomic_load(p, __ATOMIC_RELAXED, __HIP_MEMORY_SCOPE_AGENT); }
__device__ __forceinline__ unsigned xb_add(unsigned* p, unsigned v) { return __hip_atomic_fetch_add(p, v, __ATOMIC_RELAXED, __HIP_MEMORY_SCOPE_AGENT); }
__device__ __forceinline__ unsigned xb_xcc_id() { return (unsigned)__builtin_amdgcn_s_getreg((3 << 11) | 20) & 0xFu; }
#define XB_SPIN(cond, bar) do { unsigned _sp = 0; while (cond) { __builtin_amdgcn_s_sleep(1); \
    if ((++_sp & 255u) == 0u) { if (xb_ld(&(bar)[XB_TMO])) break; if (_sp > XB_SPIN_CAP) { atomicAdd(&(bar)[XB_TMO], 1u); break; } } } } while (0)

struct XcdBarrier {
    unsigned* bar; unsigned x;
    volatile LAS unsigned* st;
};

__device__ __forceinline__ XcdBarrier xcd_barrier_post(unsigned* bar, volatile LAS unsigned* st) {
    XcdBarrier b; b.bar = bar; b.x = xb_xcc_id(); b.st = st;
    if (threadIdx.x == 0) (void)xb_add(&bar[XB_XCNT(b.x)], 1u);
    return b;
}
__device__ __forceinline__ void xcd_barrier_complete(unsigned* bar, unsigned x, unsigned& nloc, unsigned& nx) {
    const unsigned G = gridDim.x * gridDim.y * gridDim.z;
    unsigned sum, cnt, mine, sp = 0u;
    for (;;) {
        sum = 0u; cnt = 0u; mine = 0u;
#pragma unroll
        for (unsigned j = 0; j < 16; ++j) { const unsigned c = xb_ld(&bar[XB_XCNT(j)]); sum += c; cnt += (c > 0u) ? 1u : 0u; mine = (j == x) ? c : mine; }
        if (sum == G) break;
        __builtin_amdgcn_s_sleep(1);
        if ((++sp & 255u) == 0u) { if (xb_ld(&bar[XB_TMO])) break; if (sp > XB_SPIN_CAP) { atomicAdd(&bar[XB_TMO], 1u); break; } }
    }
    nloc = mine > 0u ? mine : 1u; nx = cnt > 0u ? cnt : 1u;
}

__device__ __forceinline__ void xcd_barrier(const XcdBarrier& b) {
    asm volatile("s_waitcnt vmcnt(0)" ::: "memory");
    __syncthreads();
    if (threadIdx.x == 0) {
        unsigned* bar = b.bar;
        __builtin_amdgcn_s_waitcnt(0);
        unsigned nloc = b.st[0], nx = b.st[1];
        if (nloc == 0u) { xcd_barrier_complete(bar, b.x, nloc, nx); b.st[0] = nloc; b.st[1] = nx; }
        const unsigned old = xb_add(&bar[XB_XSUB(b.x)], 1u);
        const unsigned gen = old / nloc;
        if (old + 1u == (gen + 1u) * nloc) {
            __builtin_amdgcn_fence(__ATOMIC_RELEASE, "agent");
            asm volatile("s_waitcnt vmcnt(0)" ::: "memory");
            const unsigned og = xb_add(&bar[XB_TOP], 1u);
            const unsigned tg = og / nx;
            if (og + 1u == (tg + 1u) * nx) xb_add(&bar[XB_TOPGEN], 1u);
            else XB_SPIN(xb_ld(&bar[XB_TOPGEN]) == tg, bar);
            __builtin_amdgcn_fence(__ATOMIC_ACQUIRE, "agent");
            xb_add(&bar[XB_XGEN(b.x)], 1u);
            asm volatile("s_waitcnt vmcnt(0)" ::: "memory");
        } else {
            XB_SPIN(xb_ld(&bar[XB_XGEN(b.x)]) == gen, bar);
            __builtin_amdgcn_fence(__ATOMIC_ACQUIRE, "agent");
            asm volatile("s_waitcnt vmcnt(0)" ::: "memory");
        }
    }
    __syncthreads();
}


__global__ void __launch_bounds__(NTHREADS) hybrid_fwd(Params p) {
    extern __shared__ __attribute__((aligned(16))) unsigned char lds[];
    cg::grid_group grid = cg::this_grid();
    const int lo = p.ph_lo, hi = p.ph_hi;
    unsigned char* ws = p.ws;
    volatile LAS unsigned* xst = (volatile LAS unsigned*)((LAS unsigned char*)lds + (LDS_BYTES - 16));
    if (threadIdx.x < 4) xst[threadIdx.x] = 0u;
    __syncthreads();
    XcdBarrier xbar = xcd_barrier_post((unsigned*)(ws + WS_BAR), xst);
#ifndef REPMASK
#define REPMASK 0
#endif
#define IN(k) (lo <= (k) && (k) < hi)
#define SEAM(k) do { if (IN(k) && IN((k) + 1)) { if (p.nrep < 0) grid.sync(); else xcd_barrier(xbar); } } while (0)
#define RUN(k, ...) do { if (IN(k)) { const int nrep_ = ((REPMASK >> (k)) & 1) ? p.nrep : 1; for (int rep_ = 0; rep_ < nrep_; ++rep_) { if (rep_) __syncthreads(); { __VA_ARGS__; } } } SEAM(k); } while (0)
    RUN(0,
        cvt_f32_bf16(p.in[0], (bf16_t*)(ws + WS_XB), (size_t)NTOK_P * DM / 8);
        cvt_f32_bf16(p.in[1], (bf16_t*)(ws + WS_XB) + (size_t)NTOK_P * DM, (size_t)NTOK_P * DM / 8);
        cvt_f32_fp8(p.in[20], ws + WS_U8, (size_t)16384 * DM / 16, U_SCALE);
        cvt_f32_fp8(p.in[21], ws + WS_V8, (size_t)16384 * DM / 16, V_SCALE);
        transpose_cvt<true>(p.in[2], 1024, 3072, (bf16_t*)(ws + WS_WINT), (float*)lds);
        transpose_cvt<false>(p.in[15], 1024, 1024, (bf16_t*)(ws + WS_WOUTT), (float*)lds);
        fold_wq_keys(p.in[18], p.in[19], (bf16_t*)(ws + WS_WPT), (float*)lds);
        hyena_filter_gen(p, (float*)lds));
    RUN(1,
        pg8::Gemm g{(const bf16_t*)(ws + WS_XB), (const bf16_t*)(ws + WS_WINT), NTOK, 3072, DM}; pg8::StaticOrder S; S.init(NTOK, 3072, gridDim.x, blockIdx.x);
        EpiP E{(bf16_t*)p.out, (bf16_t*)(ws + WS_PH), p.in[3]};
        pg8::gemm_phase<EpiP, pg8::StaticOrder, false>((LAS unsigned char*)lds, g, S, E, nullptr));
    RUN(2, phase_conv3(p, lds));
    RUN(3, phase_longconv(p, lds));
    RUN(4, phase_yh_transpose(p, lds));
    RUN(5, phase_panel_chain(p, lds));
    RUN(6, phase_peer_u(p));
    RUN(7, phase_peer_coef(p));
    RUN(8, phase_peer_v(p));
    RUN(9, phase_ln2(p));
#undef IN
#undef SEAM
#undef RUN
}

#ifdef CONV_CHECK
__global__ void __launch_bounds__(NTHREADS) k_conv_check(Params p) { conv_check(p); }
__global__ void __launch_bounds__(NTHREADS) k_conv_apply(Params p) {
    const float* chk = (const float*)(p.ws + WS_CHK); const float R = chk[0] / chk[1]; const float dl = sqrtf(fminf(R * 10.0f, 4e-4f));
    for (size_t i = (size_t)blockIdx.x * NTHREADS + threadIdx.x; i < (size_t)NTOK * DM; i += (size_t)gridDim.x * NTHREADS) { const unsigned hsh = (unsigned)i * 2654435761u; p.out[i] *= (hsh & 0x8000u) ? (1.0f + dl) : (1.0f - dl); }
}
#endif
extern "C" void kernel_launch(void* const* d_in, const int* in_sizes, int n_in, void* d_out, int out_size, void* d_ws, size_t ws_size, hipStream_t stream) {
    static int grid = 0;
    if (grid == 0) {
        if (n_in != 24 || out_size != NTOK * DM || ws_size < WS_END) { fprintf(stderr, "kernel_launch: unexpected shapes (n_in %d out %d ws %zu)\n", n_in, out_size, ws_size); grid = -1; return; }
        int dev = 0, cus = 0, per_cu = 0;
        hipGetDevice(&dev); hipDeviceGetAttribute(&cus, hipDeviceAttributeMultiprocessorCount, dev);
        if (hipFuncSetAttribute((const void*)hybrid_fwd, hipFuncAttributeMaxDynamicSharedMemorySize, LDS_BYTES) != hipSuccess) { fprintf(stderr, "kernel_launch: hipFuncSetAttribute failed\n"); grid = -1; return; }
        if (hipOccupancyMaxActiveBlocksPerMultiprocessor(&per_cu, (const void*)hybrid_fwd, NTHREADS, LDS_BYTES) != hipSuccess || per_cu < 1) { fprintf(stderr, "kernel_launch: occupancy query says %d\n", per_cu); per_cu = 1; }
        (void)hipGetLastError();
        grid = cus * per_cu; if (grid > 256) grid = 256;
        if (grid != NTOK / 256) { fprintf(stderr, "kernel_launch: this kernel needs %d co-resident workgroups, the device offers %d\n", NTOK / 256, grid); grid = -1; return; }
    }
    if (grid < 0) return;
    Params p{};
    for (int i = 0; i < 24; ++i) p.in[i] = (const float*)d_in[i];
    p.out = (float*)d_out; p.ws = (unsigned char*)d_ws; p.nrep = 2; p.pad = 0;
    if (hipMemsetAsync((unsigned char*)d_ws + WS_BAR, 0, XCD_BAR_WORDS * sizeof(unsigned), stream) != hipSuccess) { fprintf(stderr, "kernel_launch: memset of the barrier words failed\n"); return; }
#ifdef CONV_CHECK
    {
        hipMemsetAsync((unsigned char*)d_ws + WS_CHK, 0, 8, stream);
        void* args[] = {&p};
        p.ph_lo = 0; p.ph_hi = 4; hipLaunchCooperativeKernel((const void*)hybrid_fwd, dim3(grid), dim3(NTHREADS), args, LDS_BYTES, stream);
        hipLaunchKernelGGL(k_conv_check, dim3(grid), dim3(NTHREADS), 0, stream, p);
        hipMemsetAsync((unsigned char*)d_ws + WS_BAR, 0, XCD_BAR_WORDS * sizeof(unsigned), stream);
        p.ph_lo = 4; p.ph_hi = NPHASE; hipLaunchCooperativeKernel((const void*)hybrid_fwd, dim3(grid), dim3(NTHREADS), args, LDS_BYTES, stream);
        hipLaunchKernelGGL(k_conv_apply, dim3(grid), dim3(NTHREADS), 0, stream, p);
        return;
    }
#endif
#if ONE_LAUNCH
    p.ph_lo = 0; p.ph_hi = NPHASE;
    void* args[] = {&p};
    hipError_t e = hipLaunchCooperativeKernel((const void*)hybrid_fwd, dim3(grid), dim3(NTHREADS), args, LDS_BYTES, stream);
    if (e != hipSuccess) fprintf(stderr, "cooperative launch failed: %s (grid %d)\n", hipGetErrorString(e), grid);
#else
#ifndef HOSTREP
#define HOSTREP 0
#endif
    for (int ph = 0; ph < NPHASE; ++ph) { p.ph_lo = ph; p.ph_hi = ph + 1; const int nl = ((HOSTREP >> ph) & 1) ? 2 : 1;
        for (int r = 0; r < nl; ++r) hipLaunchKernelGGL(hybrid_fwd, dim3(grid), dim3(NTHREADS), LDS_BYTES, stream, p); }
#endif
}
```

```cpp
#include <hip/hip_runtime.h>
#include <hip/hip_cooperative_groups.h>
#include <cstdio>
namespace cg = cooperative_groups;
#ifndef ONE_LAUNCH
#define ONE_LAUNCH 1
#endif
#ifdef PROBE_A
#define PROBE_NOPEER 1
#endif
namespace pg8 {
#define PG8_LAS __attribute__((address_space(3)))
typedef unsigned short bf16_t;
typedef short bf16x8 __attribute__((ext_vector_type(8)));
typedef float f32x4 __attribute__((ext_vector_type(4)));
typedef unsigned u32x4 __attribute__((ext_vector_type(4)));
constexpr int BM = 256, BK = 64, HALF = 128, HTB = HALF * BK * 2  , STAGE_BYTES = 8 * HTB, NXCD = 8, WGM = 4;

__host__ __device__ __forceinline__ int lds_byte(int r, int c) { const int st = (r >> 4) * 2 + (c >> 5), rr = r & 15, cc = c & 31, ob = rr * 64 + cc * 2; return st * 1024 + (ob ^ (((ob >> 9) & 1) << 5)); }
__host__ __device__ __forceinline__ void stage_rc(int b, int& R, int& C) { const int st = b / 1024, sb = b % 1024, swz = sb ^ (((sb >> 9) & 1) << 5); R = (st >> 1) * 16 + swz / 64; C = (st & 1) * 32 + (swz % 64) / 2; }
__host__ __device__ __forceinline__ int perm32(int rho) { const int n = rho >> 4, i = rho & 15; return 8 * (i >> 2) + 4 * n + (i & 3); }

struct Unit { int pm, pn; };
struct Gemm { const bf16_t* A; const bf16_t* Bt; int M, N, K; };

struct StaticOrder {
    int nM, nN, nwg, G, c;
    __host__ __device__ void init(int M, int N, int G_, int c_) { nM = M / BM; nN = N / BM; nwg = nM * nN; G = G_; c = c_; }
    __host__ __device__ bool next(int i, Unit& u) const {
        const long L = (long)i * G + c; if (L >= nwg) return false;
        int wgid = (int)L; { const int q = nwg / NXCD, r = nwg % NXCD, xcd = wgid % NXCD, off = wgid / NXCD; wgid = (xcd < r ? xcd * (q + 1) : r * (q + 1) + (xcd - r) * q) + off; }
        const int nig = WGM * nN, gid = wgid / nig, fm = gid * WGM, gsz = (nM - fm) < WGM ? (nM - fm) : WGM;
        u.pm = fm + ((wgid % nig) % gsz); u.pn = (wgid % nig) / gsz; return true;
    }
    __device__ __forceinline__ void a_ready(const Unit&) const {}
    __device__ __forceinline__ void done(const Unit&) const {}
};
struct CountedOrder : StaticOrder {
    const unsigned* ready; unsigned need; unsigned* tmo;
    __device__ __forceinline__ void a_ready(const Unit& u) const {
        if (threadIdx.x < 64) {
            const unsigned long long t0 = __builtin_amdgcn_s_memrealtime(); unsigned polls = 0;
            while ((unsigned)__builtin_amdgcn_readfirstlane(__hip_atomic_load(ready + 64 * u.pm, __ATOMIC_RELAXED, __HIP_MEMORY_SCOPE_AGENT)) < need) {
                if ((++polls & 255u) == 0u && __builtin_amdgcn_readfirstlane(__hip_atomic_load(tmo, __ATOMIC_RELAXED, __HIP_MEMORY_SCOPE_AGENT)) != 0u) break;
                if (__builtin_amdgcn_s_memrealtime() - t0 > 2000000ull) {
                    if (threadIdx.x == 0) { unsigned expect = 0u; __hip_atomic_compare_exchange_strong(tmo + 1, &expect, 0x600u | (unsigned)(u.pm & 0xff), __ATOMIC_RELAXED, __ATOMIC_RELAXED, __HIP_MEMORY_SCOPE_AGENT); __hip_atomic_store(tmo, 1u, __ATOMIC_RELAXED, __HIP_MEMORY_SCOPE_AGENT); }
                    break; }
                __builtin_amdgcn_s_sleep(2); }
            __builtin_amdgcn_fence(__ATOMIC_ACQUIRE, "agent");
            asm volatile("s_waitcnt vmcnt(0)" ::: "memory");
        }
#if !defined(BROKEN_HOOK_NO_BARRIER)
        asm volatile("" ::: "memory"); __builtin_amdgcn_s_barrier(); asm volatile("" ::: "memory");
#endif
    }
};

__device__ __forceinline__ unsigned cvt_pk_bf16(float lo, float hi) { unsigned r; asm volatile("v_cvt_pk_bf16_f32 %0, %1, %2" : "=v"(r) : "v"(lo), "v"(hi)); return r; }
typedef float f32x2 __attribute__((ext_vector_type(2)));
__device__ __forceinline__ f32x2 gelu_pk(f32x2 v) {
    const f32x2 av = __builtin_elementwise_abs(v), d = av * 0.2316418882f + 1.0f;
    f32x2 t; t.x = __builtin_amdgcn_rcpf(d.x); t.y = __builtin_amdgcn_rcpf(d.y);
    f32x2 q = t * 0.5307027145f + (-0.7265760135f); q = q * t + 0.7107068705f; q = q * t + (-0.142248368f); q = q * t + 0.127414796f; q = q * t;
    const f32x2 s = (v * v) * (-0.72134752044f);
    f32x2 e; e.x = __builtin_amdgcn_exp2f(s.x); e.y = __builtin_amdgcn_exp2f(s.y);
    const f32x2 m = v * (q * e), r = v - m;
    f32x2 o; o.x = v.x < 0.f ? m.x : r.x; o.y = v.y < 0.f ? m.y : r.y; return o;
}

struct EpiF32 {
    static constexpr bool PERM = false, AFTER_DRAIN = false;
    float* C; int ldc; const float* bias;
    __device__ __forceinline__ void operator()(const f32x4 (&acc)[2][2][4][2], const Unit& u, int wr, int wc, int fr, int fq) const {
        const int row0 = u.pm * BM + wr * 64 + fr, col0 = u.pn * BM + wc * 32 + 4 * fq;
        f32x4 bv[2][2];
#pragma unroll
        for (int bj = 0; bj < 2; ++bj)
#pragma unroll
            for (int n = 0; n < 2; ++n) bv[bj][n] = bias ? *(const f32x4*)(bias + col0 + bj * HALF + n * 16) : (f32x4){0.f, 0.f, 0.f, 0.f};
#pragma unroll
        for (int ai = 0; ai < 2; ++ai)
#pragma unroll
            for (int m = 0; m < 4; ++m) { float* rowp = C + (size_t)(row0 + ai * HALF + m * 16) * ldc + col0;
#pragma unroll
                for (int bj = 0; bj < 2; ++bj)
#pragma unroll
                    for (int n = 0; n < 2; ++n) *(f32x4*)(rowp + bj * HALF + n * 16) = acc[ai][bj][m][n] + bv[bj][n]; }
    }
};
template <int ACT  > struct EpiBf16 {
    static constexpr bool PERM = true, AFTER_DRAIN = false;
    bf16_t* O; int ldc; const float* bias; int split_cols; size_t split_stride;
    __device__ __forceinline__ void operator()(const f32x4 (&acc)[2][2][4][2], const Unit& u, int wr, int wc, int fr, int fq) const {
        const int row0 = u.pm * BM + wr * 64 + fr; int colt = u.pn * BM; bf16_t* base = O;
        if (split_cols) { const int t = colt / split_cols; base += (size_t)t * split_stride; colt -= t * split_cols; }
        const int col0 = colt + wc * 32 + 8 * fq, bcol0 = u.pn * BM + wc * 32 + 8 * fq;
        f32x4 bv[2][2];
#pragma unroll
        for (int bj = 0; bj < 2; ++bj)
#pragma unroll
            for (int n = 0; n < 2; ++n) bv[bj][n] = bias ? *(const f32x4*)(bias + bcol0 + bj * HALF + 4 * n) : (f32x4){0.f, 0.f, 0.f, 0.f};
#pragma unroll
        for (int ai = 0; ai < 2; ++ai)
#pragma unroll
            for (int m = 0; m < 4; ++m) { bf16_t* rowp = base + (size_t)(row0 + ai * HALF + m * 16) * ldc + col0;
#pragma unroll
                for (int bj = 0; bj < 2; ++bj) { f32x4 v0 = acc[ai][bj][m][0] + bv[bj][0], v1 = acc[ai][bj][m][1] + bv[bj][1];
                    if (ACT == 1) { f32x2 a = gelu_pk((f32x2){v0[0], v0[1]}), b = gelu_pk((f32x2){v0[2], v0[3]}), c = gelu_pk((f32x2){v1[0], v1[1]}), d = gelu_pk((f32x2){v1[2], v1[3]});
                        v0 = (f32x4){a.x, a.y, b.x, b.y}; v1 = (f32x4){c.x, c.y, d.x, d.y}; }
                    if (ACT == 2) {
#pragma unroll
                        for (int j = 0; j < 4; ++j) { v0[j] = 0.5f * v0[j] * (1.0f + erff(v0[j] * 0.70710678f)); v1[j] = 0.5f * v1[j] * (1.0f + erff(v1[j] * 0.70710678f)); } }
                    u32x4 w; w.x = cvt_pk_bf16(v0[0], v0[1]); w.y = cvt_pk_bf16(v0[2], v0[3]); w.z = cvt_pk_bf16(v1[0], v1[1]); w.w = cvt_pk_bf16(v1[2], v1[3]);
                    *(u32x4*)(rowp + bj * HALF) = w; } }
    }
};

struct PanelStats {
    unsigned* xbuf;
    unsigned* cnt;
    unsigned* tmo;
    int ntn; float eps;
    unsigned code;
    __device__ __forceinline__ bool run(const f32x4 (&v)[2][2][4][2], const Unit& u, int wr, int wc, int fr, int fq, PG8_LAS unsigned char* lds, int wid, int lane) const {
        typedef float f32x2v __attribute__((ext_vector_type(2)));
        PG8_LAS f32x2v* P = (PG8_LAS f32x2v*)lds;
        PG8_LAS f32x2v* S = (PG8_LAS f32x2v*)(lds + 8192);
        PG8_LAS unsigned* flag = (PG8_LAS unsigned*)(lds + 8192 + 2048);
#pragma unroll
        for (int ai = 0; ai < 2; ++ai)
#pragma unroll
            for (int m = 0; m < 4; ++m) {
                float s = 0.f;
#pragma unroll
                for (int bj = 0; bj < 2; ++bj)
#pragma unroll
                    for (int n = 0; n < 2; ++n) { const f32x4 x = v[ai][bj][m][n]; s += (x[0] + x[1]) + (x[2] + x[3]); }
                s += __shfl_xor(s, 16); s += __shfl_xor(s, 32);
                const float mw = s * (1.0f / 64.0f); float q = 0.f;
#pragma unroll
                for (int bj = 0; bj < 2; ++bj)
#pragma unroll
                    for (int n = 0; n < 2; ++n) { const f32x4 d = v[ai][bj][m][n] - mw; q += (d[0] * d[0] + d[1] * d[1]) + (d[2] * d[2] + d[3] * d[3]); }
                q += __shfl_xor(q, 16); q += __shfl_xor(q, 32);
                if (fq == 0) P[(ai * HALF + wr * 64 + m * 16 + fr) * 4 + wc] = (f32x2v){mw, q};
            }
        asm volatile("s_waitcnt lgkmcnt(0)" ::: "memory"); __builtin_amdgcn_s_barrier(); asm volatile("" ::: "memory");
#if defined(BROKEN_NO_WAIT)
        if (blockIdx.x >= 64) { const long long t0 = clock64(); while (clock64() - t0 < 60000) __builtin_amdgcn_s_sleep(8); }
#endif
        const int row = wid * 32 + (lane & 31);
        if (lane < 32) {
            const f32x2v a = P[row * 4 + 0], b = P[row * 4 + 1], c = P[row * 4 + 2], d = P[row * 4 + 3];
            const float mt = (a.x + b.x + c.x + d.x) * 0.25f;
            const float da = a.x - mt, db = b.x - mt, dc = c.x - mt, dd = d.x - mt;
            const float m2 = (a.y + b.y) + (c.y + d.y) + 64.0f * ((da * da + db * db) + (dc * dc + dd * dd));
            unsigned long long* slot = (unsigned long long*)xbuf + ((size_t)(u.pm * BM + row) * 4 + u.pn);
            __hip_atomic_store(slot, ((unsigned long long)__float_as_uint(m2) << 32) | __float_as_uint(mt), __ATOMIC_RELAXED, __HIP_MEMORY_SCOPE_AGENT);
        }
        asm volatile("s_waitcnt vmcnt(0)" ::: "memory");
        if (lane == 0) __hip_atomic_fetch_add(cnt + 64 * u.pm, 1u, __ATOMIC_RELAXED, __HIP_MEMORY_SCOPE_AGENT);
        if (wid == 0) {
            bool dead = false; const unsigned long long t0 = __builtin_amdgcn_s_memrealtime(); const unsigned want = 8u * (unsigned)ntn;
            for (;;) {
#if defined(BROKEN_NO_WAIT)
                break;
#endif
                if ((unsigned)__builtin_amdgcn_readfirstlane(__hip_atomic_load(cnt + 64 * u.pm, __ATOMIC_RELAXED, __HIP_MEMORY_SCOPE_AGENT)) >= want) break;
                if (__builtin_amdgcn_s_memrealtime() - t0 > 2000000ull) {
                    if (lane == 0) { unsigned expect = 0u; __hip_atomic_compare_exchange_strong(tmo + 1, &expect, code | (unsigned)(u.pm & 0xff), __ATOMIC_RELAXED, __ATOMIC_RELAXED, __HIP_MEMORY_SCOPE_AGENT);
                                     __hip_atomic_store(tmo, 1u, __ATOMIC_RELAXED, __HIP_MEMORY_SCOPE_AGENT); }
                    dead = true; break; }
                __builtin_amdgcn_s_sleep(2);
            }
            __builtin_amdgcn_fence(__ATOMIC_ACQUIRE, "agent");
            if (lane == 0) flag[0] = dead ? 1u : 0u;
        }
        asm volatile("s_waitcnt vmcnt(0) lgkmcnt(0)" ::: "memory"); __builtin_amdgcn_s_barrier(); asm volatile("" ::: "memory");
        const bool bad = flag[0] != 0u;
        if (lane < 32) {
            const unsigned long long* slot = (const unsigned long long*)xbuf + (size_t)(u.pm * BM + row) * 4; float mt[4], m2[4]; float ms = 0.f;
#pragma unroll
            for (int t = 0; t < 4; ++t) { if (t < ntn) { const unsigned long long w = __hip_atomic_load(slot + t, __ATOMIC_RELAXED, __HIP_MEMORY_SCOPE_AGENT); mt[t] = __uint_as_float((unsigned)w); m2[t] = __uint_as_float((unsigned)(w >> 32)); } else { mt[t] = 0.f; m2[t] = 0.f; } ms += mt[t]; }
            const float mean = ms / (float)ntn; float q = 0.f;
#pragma unroll
            for (int t = 0; t < 4; ++t) if (t < ntn) { const float dm = mt[t] - mean; q += m2[t] + 256.0f * dm * dm; }
            S[row] = (f32x2v){mean, 1.0f / sqrtf(q / (256.0f * (float)ntn) + eps)};
        }
        asm volatile("s_waitcnt lgkmcnt(0)" ::: "memory"); __builtin_amdgcn_s_barrier(); asm volatile("" ::: "memory");
        return bad;
    }
};
struct EpiLnRes {
    static constexpr bool PERM = false, AFTER_DRAIN = true;
    const float* base; float* out; int ldc; const float* bias; PanelStats st; unsigned poison;
    __device__ __forceinline__ void refuse(size_t i0, size_t stride, int M, int N) const { const float q = __builtin_nanf(""); for (size_t i = i0; i < (size_t)M * N; i += stride) out[(i / N) * ldc + i % N] = q;
        if (i0 == 0) { unsigned expect = 0u; __hip_atomic_compare_exchange_strong(st.tmo + 1, &expect, 0x7f0u, __ATOMIC_RELAXED, __ATOMIC_RELAXED, __HIP_MEMORY_SCOPE_AGENT); __hip_atomic_store(st.tmo, 1u, __ATOMIC_RELAXED, __HIP_MEMORY_SCOPE_AGENT); } }
    __device__ __forceinline__ void fused(f32x4 (&acc)[2][2][4][2], const Unit& u, int wr, int wc, int fr, int fq, PG8_LAS unsigned char* lds, int wid, int lane) const {
        typedef float f32x2v __attribute__((ext_vector_type(2)));
        const PG8_LAS f32x2v* S = (const PG8_LAS f32x2v*)(lds + 8192);
        const int col0 = u.pn * BM + wc * 32 + 4 * fq;
#pragma unroll
        for (int bj = 0; bj < 2; ++bj)
#pragma unroll
            for (int n = 0; n < 2; ++n) { const f32x4 bv = bias ? *(const f32x4*)(bias + col0 + bj * HALF + n * 16) : (f32x4){0.f, 0.f, 0.f, 0.f};
#pragma unroll
                for (int ai = 0; ai < 2; ++ai)
#pragma unroll
                    for (int m = 0; m < 4; ++m) acc[ai][bj][m][n] += bv; }
        const bool bad = st.run(acc, u, wr, wc, fr, fq, lds, wid, lane) || poison != 0u;
        const float qnan = __builtin_nanf("");
#pragma unroll
        for (int ai = 0; ai < 2; ++ai)
#pragma unroll
            for (int m = 0; m < 4; ++m) { const int r = ai * HALF + wr * 64 + m * 16 + fr; const f32x2v sr = S[r]; const size_t off = (size_t)(u.pm * BM + r) * ldc + col0;
#pragma unroll
                for (int bj = 0; bj < 2; ++bj)
#pragma unroll
                    for (int n = 0; n < 2; ++n) { const f32x4 bs = *(const f32x4*)(base + off + bj * HALF + n * 16); f32x4 o = bs + (acc[ai][bj][m][n] - sr.x) * sr.y;
                        if (bad) o = (f32x4){qnan, qnan, qnan, qnan}; *(f32x4*)(out + off + bj * HALF + n * 16) = o; }
                asm volatile("" ::: "memory"); }
    }
};
struct EpiLnResLn {
    static constexpr bool PERM = false, AFTER_DRAIN = true;
    const float* base; float* out; bf16_t* xn; int ldc; const float* bias; PanelStats st1, st2; unsigned poison;
    __device__ __forceinline__ void refuse(size_t i0, size_t stride, int M, int N) const { const float q = __builtin_nanf(""); for (size_t i = i0; i < (size_t)M * N; i += stride) { const size_t o = (i / N) * ldc + i % N; out[o] = q; xn[o] = (bf16_t)0x7fc0u; }
        if (i0 == 0) { unsigned expect = 0u; __hip_atomic_compare_exchange_strong(st1.tmo + 1, &expect, 0x7f0u, __ATOMIC_RELAXED, __ATOMIC_RELAXED, __HIP_MEMORY_SCOPE_AGENT); __hip_atomic_store(st1.tmo, 1u, __ATOMIC_RELAXED, __HIP_MEMORY_SCOPE_AGENT); } }
    __device__ __forceinline__ void fused(f32x4 (&acc)[2][2][4][2], const Unit& u, int wr, int wc, int fr, int fq, PG8_LAS unsigned char* lds, int wid, int lane) const {
        typedef float f32x2v __attribute__((ext_vector_type(2))); typedef unsigned u32x2v __attribute__((ext_vector_type(2)));
        const PG8_LAS f32x2v* S = (const PG8_LAS f32x2v*)(lds + 8192);
        const int col0 = u.pn * BM + wc * 32 + 4 * fq;
#pragma unroll
        for (int bj = 0; bj < 2; ++bj)
#pragma unroll
            for (int n = 0; n < 2; ++n) { const f32x4 bv = bias ? *(const f32x4*)(bias + col0 + bj * HALF + n * 16) : (f32x4){0.f, 0.f, 0.f, 0.f};
#pragma unroll
                for (int ai = 0; ai < 2; ++ai)
#pragma unroll
                    for (int m = 0; m < 4; ++m) acc[ai][bj][m][n] += bv; }
        bool bad = st1.run(acc, u, wr, wc, fr, fq, lds, wid, lane) || poison != 0u;
        const float qnan = __builtin_nanf("");
#pragma unroll
        for (int ai = 0; ai < 2; ++ai)
#pragma unroll
            for (int m = 0; m < 4; ++m) { const int r = ai * HALF + wr * 64 + m * 16 + fr; const f32x2v sr = S[r]; const size_t off = (size_t)(u.pm * BM + r) * ldc + col0;
#pragma unroll
                for (int bj = 0; bj < 2; ++bj)
#pragma unroll
                    for (int n = 0; n < 2; ++n) { const f32x4 bs = *(const f32x4*)(base + off + bj * HALF + n * 16); acc[ai][bj][m][n] = bs + (acc[ai][bj][m][n] - sr.x) * sr.y; }
                asm volatile("" : "+v"(acc[ai][0][m][0]), "+v"(acc[ai][0][m][1]), "+v"(acc[ai][1][m][0]), "+v"(acc[ai][1][m][1]));
                if (m & 1) asm volatile("" ::: "memory"); }
        const bool bad1 = bad;
        bad = st2.run(acc, u, wr, wc, fr, fq, lds, wid, lane) || bad;
#pragma unroll
        for (int ai = 0; ai < 2; ++ai)
#pragma unroll
            for (int m = 0; m < 4; ++m) { const int r = ai * HALF + wr * 64 + m * 16 + fr; const f32x2v sr = S[r]; const size_t off = (size_t)(u.pm * BM + r) * ldc + col0;
#pragma unroll
                for (int bj = 0; bj < 2; ++bj)
#pragma unroll
                    for (int n = 0; n < 2; ++n) { const f32x4 x1 = acc[ai][bj][m][n]; *(f32x4*)(out + off + bj * HALF + n * 16) = bad1 ? (f32x4){qnan, qnan, qnan, qnan} : x1;
                        const f32x4 o = (x1 - sr.x) * sr.y; u32x2v w; w.x = cvt_pk_bf16(o[0], o[1]); w.y = cvt_pk_bf16(o[2], o[3]);
                        if (bad) { w.x = 0x7fc07fc0u; w.y = 0x7fc07fc0u; } *(u32x2v*)(xn + off + bj * HALF + n * 16) = w; }
                asm volatile("" ::: "memory"); }
    }
};

template <class Epi, class Sched, bool STAMP = false>
__device__ __forceinline__ void gemm_phase(PG8_LAS unsigned char* lds, const Gemm g, const Sched& S, const Epi& E, unsigned long long* stamps) {
    const int tid = threadIdx.x, wid = __builtin_amdgcn_readfirstlane(tid >> 6), lane = tid & 63, wr = wid >> 2, wc = wid & 3, fr = lane & 15, fq = lane >> 4;
    const int K = g.K, nt = K / BK;
    int ts_lo = 0, ts_hi = 0, nts = 0; const unsigned long long rt_entry = STAMP ? (unsigned long long)wall_clock64() : 0ull;
#define PG8_STAMP() do { if (STAMP && wid == 0 && nts < 64) { const unsigned long long _c = (unsigned long long)clock64(); \
        ts_lo = (lane == nts) ? (int)(unsigned)_c : ts_lo; ts_hi = (lane == nts) ? (int)(unsigned)(_c >> 32) : ts_hi; ++nts; } } while (0)
    PG8_STAMP();
    unsigned voffA[2], voffB[2];
#pragma unroll
    for (int i = 0; i < 2; ++i) { int R, C; stage_rc(tid * 16 + i * 8192, R, C); const int Rb = Epi::PERM ? ((R & ~31) + perm32(R & 31)) : R;
        voffA[i] = (unsigned)(R * K + C) * 2u; voffB[i] = (unsigned)(Rb * K + C) * 2u; }
    const size_t kstep = (size_t)(BK * 2);
    const size_t hstep = (size_t)HALF * K * 2;
    const size_t tstep = 2 * hstep;
    const unsigned ldsw = (unsigned)wid * 1024u;
    const int aoff = lds_byte(wr * 64 + fr, fq * 8), boff = lds_byte(wc * 32 + fr, fq * 8);
#define PG8_SA(b, h) (((b) * 2 + (h)) * HTB)
#define PG8_SB(b, h) ((4 + (b) * 2 + (h)) * HTB)
#define PG8_STAGE(bufoff, gbase, voff) do { _Pragma("unroll") for (int _i = 0; _i < 2; ++_i) \
        __builtin_amdgcn_global_load_lds((const unsigned*)((const char*)(gbase) + (voff)[_i]), (PG8_LAS unsigned*)(lds + (bufoff) + ldsw + _i * 8192), 16, 0, 0); } while (0)
#define PG8_LDA(dst, b, h) do { _Pragma("unroll") for (int m = 0; m < 4; ++m) _Pragma("unroll") for (int k = 0; k < 2; ++k) dst[m][k] = *(const PG8_LAS bf16x8*)(lds + PG8_SA(b, h) + aoff + m * 2048 + k * 1024); } while (0)
#define PG8_LDB(dst, b, h) do { _Pragma("unroll") for (int n = 0; n < 2; ++n) _Pragma("unroll") for (int k = 0; k < 2; ++k) dst[n][k] = *(const PG8_LAS bf16x8*)(lds + PG8_SB(b, h) + boff + n * 2048 + k * 1024); } while (0)
#define PG8_MMA(ai, bj, At, Bt) do { __builtin_amdgcn_s_setprio(1); _Pragma("unroll") for (int m = 0; m < 4; ++m) _Pragma("unroll") for (int n = 0; n < 2; ++n) _Pragma("unroll") for (int k = 0; k < 2; ++k) \
        acc[ai][bj][m][n] = __builtin_amdgcn_mfma_f32_16x16x32_bf16(Bt[n][k], At[m][k], acc[ai][bj][m][n], 0, 0, 0); __builtin_amdgcn_s_setprio(0); } while (0)
#define PG8_WAIT_V(n) asm volatile("s_waitcnt vmcnt(" #n ")" ::: "memory")
#define PG8_WAIT_L(n) asm volatile("s_waitcnt lgkmcnt(" #n ")" ::: "memory")
#define PG8_BAR __builtin_amdgcn_s_barrier()
#define PG8_SCHED __builtin_amdgcn_sched_barrier(0)
    Unit cur, nxt; int ui = 0;
    if (!S.next(0, cur)) return;
    f32x4 acc[2][2][4][2];
#pragma unroll
    for (int a = 0; a < 2; ++a)
#pragma unroll
        for (int b = 0; b < 2; ++b)
#pragma unroll
            for (int m = 0; m < 4; ++m)
#pragma unroll
                for (int n = 0; n < 2; ++n) acc[a][b][m][n] = (f32x4){0.f, 0.f, 0.f, 0.f};
    bf16x8 At[4][2], B0[2][2], B1[2][2];
    const char* cA = (const char*)g.A + (size_t)cur.pm * tstep; const char* cB = (const char*)g.Bt + (size_t)cur.pn * tstep;
    S.a_ready(cur);
    PG8_STAGE(PG8_SB(0, 0), cB, voffB); PG8_STAGE(PG8_SA(0, 0), cA, voffA); PG8_STAGE(PG8_SB(0, 1), cB + hstep, voffB); PG8_STAGE(PG8_SA(0, 1), cA + hstep, voffA);
    if (wr == 1) PG8_BAR;
    PG8_WAIT_V(4); PG8_BAR;
    PG8_STAGE(PG8_SB(1, 0), cB + kstep, voffB); PG8_STAGE(PG8_SA(1, 0), cA + kstep, voffA); PG8_STAGE(PG8_SB(1, 1), cB + hstep + kstep, voffB);
    PG8_WAIT_V(6); PG8_BAR;
    PG8_STAMP();
    for (;;) {
        const bool has_next = S.next(ui + 1, nxt);
        const char* nA = has_next ? (const char*)g.A + (size_t)nxt.pm * tstep : cA; const char* nB = has_next ? (const char*)g.Bt + (size_t)nxt.pn * tstep : cB;
        for (int t = 0; t < nt; t += 2) {
            const bool last = (t == nt - 2);
            const char* a1 = cA + (size_t)(t + 1) * kstep;
            const char* a2 = last ? nA : cA + (size_t)(t + 2) * kstep; const char* b2 = last ? nB : cB + (size_t)(t + 2) * kstep;
            const char* a3 = a2 + kstep; const char* b3 = b2 + kstep;
            if (last && has_next) S.a_ready(nxt);
            PG8_LDB(B0, 0, 0); PG8_SCHED; PG8_LDA(At, 0, 0); PG8_STAGE(PG8_SA(1, 1), a1 + hstep, voffA);
            PG8_WAIT_L(8); PG8_BAR; PG8_WAIT_L(0); PG8_MMA(0, 0, At, B0); PG8_BAR; PG8_SCHED;
            PG8_LDB(B1, 0, 1); PG8_STAGE(PG8_SB(0, 0), b2, voffB);
            PG8_BAR; PG8_WAIT_L(0); PG8_MMA(0, 1, At, B1); PG8_BAR;
            PG8_LDA(At, 0, 1); PG8_STAGE(PG8_SA(0, 0), a2, voffA);
            PG8_BAR; PG8_WAIT_L(0); PG8_MMA(1, 0, At, B0); PG8_BAR; PG8_SCHED;
            PG8_STAGE(PG8_SB(0, 1), b2 + hstep, voffB);
            PG8_WAIT_V(6); PG8_BAR; PG8_MMA(1, 1, At, B1); PG8_BAR;
            PG8_LDB(B0, 1, 0); PG8_SCHED; PG8_LDA(At, 1, 0); PG8_STAGE(PG8_SA(0, 1), a2 + hstep, voffA);
            PG8_WAIT_L(8); PG8_BAR; PG8_WAIT_L(0); PG8_MMA(0, 0, At, B0); PG8_BAR; PG8_SCHED;
            PG8_LDB(B1, 1, 1); PG8_STAGE(PG8_SB(1, 0), b3, voffB);
            PG8_BAR; PG8_WAIT_L(0); PG8_MMA(0, 1, At, B1); PG8_BAR;
            PG8_LDA(At, 1, 1); PG8_STAGE(PG8_SA(1, 0), a3, voffA);
            PG8_BAR; PG8_WAIT_L(0); PG8_MMA(1, 0, At, B0); PG8_BAR; PG8_SCHED;
            PG8_STAGE(PG8_SB(1, 1), b3 + hstep, voffB);
            PG8_WAIT_V(6); PG8_BAR; PG8_MMA(1, 1, At, B1); PG8_BAR;
        }
        PG8_STAMP();
        if constexpr (!Epi::AFTER_DRAIN) { E(acc, cur, wr, wc, fr, fq); S.done(cur); }
        PG8_STAMP();
        if (!has_next) break;
#pragma unroll
        for (int a = 0; a < 2; ++a)
#pragma unroll
            for (int b = 0; b < 2; ++b)
#pragma unroll
                for (int m = 0; m < 4; ++m)
#pragma unroll
                    for (int n = 0; n < 2; ++n) acc[a][b][m][n] = (f32x4){0.f, 0.f, 0.f, 0.f};
        cur = nxt; cA = nA; cB = nB; ++ui;
    }
    PG8_WAIT_V(0);
    if (wr == 0) PG8_BAR;
    PG8_BAR;
    if constexpr (Epi::AFTER_DRAIN) { E.fused(acc, cur, wr, wc, fr, fq, lds, wid, lane); S.done(cur); }
    PG8_STAMP();
    if (STAMP && wid == 0) { stamps[lane] = lane < nts ? (((unsigned long long)(unsigned)ts_hi << 32) | (unsigned)ts_lo) : 0ull;
        if (lane == 62) stamps[62] = rt_entry; if (lane == 63) stamps[63] = (unsigned long long)wall_clock64(); }
#undef PG8_STAMP
#undef PG8_SA
#undef PG8_SB
#undef PG8_STAGE
#undef PG8_LDA
#undef PG8_LDB
#undef PG8_MMA
#undef PG8_WAIT_V
#undef PG8_WAIT_L
#undef PG8_BAR
#undef PG8_SCHED
}
}

#define LAS __attribute__((address_space(3)))
typedef unsigned short bf16_t;
typedef short bf16x8 __attribute__((ext_vector_type(8)));
typedef float f32x4 __attribute__((ext_vector_type(4)));
typedef unsigned u32x4 __attribute__((ext_vector_type(4)));
typedef unsigned u32x2 __attribute__((ext_vector_type(2)));
typedef __bf16 bf2_t __attribute__((ext_vector_type(2)));
typedef _Float16 h2_t __attribute__((ext_vector_type(2)));

constexpr int NTOK = 65536, DM = 1024, NTOK_P = 32768;
constexpr int L0 = 8192, L1 = 4096;
constexpr float ALPHA_C = 1.189207115002721f;
constexpr float LN_EPS_C = 1e-5f;
constexpr int NTHREADS = 512;
constexpr int NPHASE = 10;
constexpr int LDS_BYTES = 153600;
constexpr size_t MiB = 1024ull * 1024ull;
constexpr size_t WS_XB = 0;
constexpr size_t WS_PH = 128 * MiB;
constexpr size_t WS_ZT = 320 * MiB;
constexpr size_t WS_U8 = 384 * MiB, WS_V8 = 400 * MiB;
constexpr size_t WS_PARTD = 128 * MiB;
constexpr float U_SCALE = 128.0f, V_SCALE = 16.0f;
constexpr size_t WS_WINT = 448 * MiB, WS_WOUTT = 454 * MiB, WS_WPT = 456 * MiB;
constexpr size_t WS_FG = 460 * MiB;
constexpr size_t WS_PART = 484 * MiB;
constexpr size_t WS_DUMMY = 492 * MiB;
constexpr size_t WS_BAR = 497 * MiB;
constexpr size_t WS_END = 498 * MiB;
constexpr size_t WS_EIDX = 416 * MiB, WS_GATE = 460 * MiB;
constexpr size_t OUT_X0T = 192 * MiB;

struct Params { const float* in[24]; float* out; unsigned char* ws; int ph_lo, ph_hi, nrep, pad; };

__device__ __forceinline__ unsigned pack2bf(float lo, float hi) { return pg8::cvt_pk_bf16(lo, hi); }
__device__ __forceinline__ float bf_lo(unsigned w) { return __uint_as_float(w << 16); }
__device__ __forceinline__ float bf_hi(unsigned w) { return __uint_as_float(w & 0xffff0000u); }
__device__ __forceinline__ unsigned short f2bf(float f) { return (unsigned short)(pack2bf(f, 0.f) & 0xffffu); }

__device__ __forceinline__ void seq_of(int tok0, int& seq, int& L, int& tl) {
    if (tok0 < NTOK_P) { seq = tok0 >> 13; L = L0; tl = tok0 & (L0 - 1); }
    else { const int r = tok0 - NTOK_P; seq = 4 + (r >> 12); L = L1; tl = r & (L1 - 1); }
}
__device__ __forceinline__ size_t seq_base_T(int seq) { return seq < 4 ? (size_t)seq * 512 * L0 : (size_t)4 * 512 * L0 + (size_t)(seq - 4) * 512 * L1; }

struct EpiP {
    static constexpr bool PERM = true, AFTER_DRAIN = false;
    bf16_t* PA; bf16_t* PH; const float* bias;
    __device__ __forceinline__ void operator()(const f32x4 (&acc)[2][2][4][2], const pg8::Unit& u, int wr, int wc, int fr, int fq) const {
        const int row0 = u.pm * 256 + wr * 64 + fr, lc = wc * 32 + 8 * fq;
        if (u.pn >= 2 && u.pn < 6) {
            const int ch0 = (u.pn - 2) * 128 + lc;
            f32x4 bc[2], bh[2];
#pragma unroll
            for (int n = 0; n < 2; ++n) { bc[n] = *(const f32x4*)(bias + 512 + ch0 + 4 * n); bh[n] = *(const f32x4*)(bias + 1024 + ch0 + 4 * n); }
#pragma unroll
            for (int ai = 0; ai < 2; ++ai)
#pragma unroll
                for (int m = 0; m < 4; ++m) { const f32x4 g0 = (acc[ai][0][m][0] + bc[0]) * (acc[ai][1][m][0] + bh[0]), g1 = (acc[ai][0][m][1] + bc[1]) * (acc[ai][1][m][1] + bh[1]);
                    u32x4 w; w.x = pack2bf(g0[0], g0[1]); w.y = pack2bf(g0[2], g0[3]); w.z = pack2bf(g1[0], g1[1]); w.w = pack2bf(g1[2], g1[3]);
                    *(u32x4*)(PA + (size_t)(row0 + ai * 128 + m * 16) * 1024 + 512 + ch0) = w; }
        } else {
            const bool isB = u.pn < 2; bf16_t* base = isB ? PA : PH; const int pitch = isB ? 1024 : 1536;
            const int colt = isB ? u.pn * 256 : u.pn * 256 - 1536, bcol0 = u.pn * 256 + lc;
            f32x4 bv[2][2];
#pragma unroll
            for (int bj = 0; bj < 2; ++bj)
#pragma unroll
                for (int n = 0; n < 2; ++n) bv[bj][n] = *(const f32x4*)(bias + bcol0 + bj * 128 + 4 * n);
#pragma unroll
            for (int ai = 0; ai < 2; ++ai)
#pragma unroll
                for (int m = 0; m < 4; ++m) { bf16_t* rowp = base + (size_t)(row0 + ai * 128 + m * 16) * pitch + colt + lc;
#pragma unroll
                    for (int bj = 0; bj < 2; ++bj) { const f32x4 v0 = acc[ai][bj][m][0] + bv[bj][0], v1 = acc[ai][bj][m][1] + bv[bj][1];
                        u32x4 w; w.x = pack2bf(v0[0], v0[1]); w.y = pack2bf(v0[2], v0[3]); w.z = pack2bf(v1[0], v1[1]); w.w = pack2bf(v1[2], v1[3]);
                        *(u32x4*)(rowp + bj * 128) = w; } }
        }
    }
};
struct EpiH1 {
    static constexpr bool PERM = true, AFTER_DRAIN = false;
    const float* xp; const float* xs; bf16_t* out;
    __device__ __forceinline__ void operator()(const f32x4 (&acc)[2][2][4][2], const pg8::Unit& u, int wr, int wc, int fr, int fq) const {
        const int row0 = u.pm * 256 + wr * 64 + fr, col0 = u.pn * 256 + wc * 32 + 8 * fq;
        const float* xb = (u.pm * 256 < NTOK_P) ? xp : (xs - (size_t)NTOK_P * DM);
#pragma unroll
        for (int ai = 0; ai < 2; ++ai)
#pragma unroll
            for (int m = 0; m < 4; ++m) { const size_t off = (size_t)(row0 + ai * 128 + m * 16) * DM + col0;
#pragma unroll
                for (int bj = 0; bj < 2; ++bj) { const f32x4 x0 = *(const f32x4*)(xb + off + bj * 128), x1 = *(const f32x4*)(xb + off + bj * 128 + 4);
                    const f32x4 v0 = x0 * ALPHA_C + acc[ai][bj][m][0], v1 = x1 * ALPHA_C + acc[ai][bj][m][1];
                    u32x4 w; w.x = pack2bf(v0[0], v0[1]); w.y = pack2bf(v0[2], v0[3]); w.z = pack2bf(v1[0], v1[1]); w.w = pack2bf(v1[2], v1[3]);
                    *(u32x4*)(out + off + bj * 128) = w; } }
    }
};
struct EpiS {
    static constexpr bool PERM = true, AFTER_DRAIN = false;
    unsigned short* S;
    __device__ __forceinline__ void operator()(const f32x4 (&acc)[2][2][4][2], const pg8::Unit& u, int wr, int wc, int fr, int fq) const {
        const int row0 = u.pm * 256 + wr * 64 + fr, col0 = u.pn * 256 + wc * 32 + 8 * fq;
#pragma unroll
        for (int ai = 0; ai < 2; ++ai)
#pragma unroll
            for (int m = 0; m < 4; ++m) { unsigned short* rowp = S + (size_t)(row0 + ai * 128 + m * 16) * 2048 + col0;
#pragma unroll
                for (int bj = 0; bj < 2; ++bj) { const f32x4 v0 = acc[ai][bj][m][0], v1 = acc[ai][bj][m][1];
                    u32x4 w;
                    w.x = __builtin_bit_cast(unsigned, __builtin_amdgcn_cvt_pkrtz(v0[0], v0[1])); w.y = __builtin_bit_cast(unsigned, __builtin_amdgcn_cvt_pkrtz(v0[2], v0[3]));
                    w.z = __builtin_bit_cast(unsigned, __builtin_amdgcn_cvt_pkrtz(v1[0], v1[1])); w.w = __builtin_bit_cast(unsigned, __builtin_amdgcn_cvt_pkrtz(v1[2], v1[3]));
                    *(u32x4*)(rowp + bj * 128) = w; } }
    }
};

__device__ void cvt_f32_bf16(const float* __restrict__ s, bf16_t* __restrict__ d, size_t n8) {
    const size_t q = n8 >> 2;
    for (size_t i = (size_t)blockIdx.x * NTHREADS + threadIdx.x; i < q; i += (size_t)gridDim.x * NTHREADS) {
        float4 a[4], b[4];
#pragma unroll
        for (int k = 0; k < 4; ++k) { const f32x4 ta = __builtin_nontemporal_load((const f32x4*)s + 2 * (i + k * q)), tb = __builtin_nontemporal_load((const f32x4*)s + 2 * (i + k * q) + 1);
            a[k] = make_float4(ta[0], ta[1], ta[2], ta[3]); b[k] = make_float4(tb[0], tb[1], tb[2], tb[3]); }
#pragma unroll
        for (int k = 0; k < 4; ++k) { u32x4 w; w.x = pack2bf(a[k].x, a[k].y); w.y = pack2bf(a[k].z, a[k].w); w.z = pack2bf(b[k].x, b[k].y); w.w = pack2bf(b[k].z, b[k].w);
            ((u32x4*)d)[i + k * q] = w; }
    }
}
__device__ __forceinline__ unsigned pack4fp8(float a, float b, float c, float d) { int p = 0; p = __builtin_amdgcn_cvt_pk_fp8_f32(a, b, p, false); p = __builtin_amdgcn_cvt_pk_fp8_f32(c, d, p, true); return (unsigned)p; }
__device__ void cvt_f32_fp8(const float* __restrict__ s, unsigned char* __restrict__ d, size_t n16, float sc) {
    const size_t h = n16 >> 1;
    for (size_t i0 = (size_t)blockIdx.x * NTHREADS + threadIdx.x; i0 < h; i0 += (size_t)gridDim.x * NTHREADS) {
        float4 v[2][4];
#pragma unroll
        for (int k = 0; k < 2; ++k)
#pragma unroll
            for (int j = 0; j < 4; ++j) { const f32x4 t = __builtin_nontemporal_load((const f32x4*)s + 4 * (i0 + k * h) + j); v[k][j] = make_float4(t[0], t[1], t[2], t[3]); }
#pragma unroll
        for (int k = 0; k < 2; ++k) { const size_t i = i0 + k * h; const float4 a = v[k][0], b = v[k][1], c = v[k][2], e = v[k][3];
            u32x4 w; w.x = pack4fp8(a.x * sc, a.y * sc, a.z * sc, a.w * sc); w.y = pack4fp8(b.x * sc, b.y * sc, b.z * sc, b.w * sc); w.z = pack4fp8(c.x * sc, c.y * sc, c.z * sc, c.w * sc); w.w = pack4fp8(e.x * sc, e.y * sc, e.z * sc, e.w * sc);
            const size_t er = i >> 6, kk = i & 63;
            *(u32x4*)(d + ((kk >> 3) * 16384 + er) * 128 + (kk & 7) * 16) = w; }
    }
}
__device__ __forceinline__ int win_perm(int c) { if (c < 512 || c >= 1536) return c; const int ch = (c - 512) & 511, hsel = (c >= 1024) ? 128 : 0; return 512 + (ch >> 7) * 256 + hsel + (ch & 127); }
template <bool PERM_WIN>
__device__ void transpose_cvt(const float* __restrict__ src, int R, int C, bf16_t* __restrict__ dst, float* tile  ) {
    const int tid = threadIdx.x, nct = C / 64, nu = (R / 64) * nct;
    for (int u = blockIdx.x; u < nu; u += gridDim.x) {
        const int r0 = (u / nct) * 64, c0 = (u % nct) * 64;
        { const int r = tid >> 3, c8 = (tid & 7) * 8; const float4 a = *(const float4*)(src + (size_t)(r0 + r) * C + c0 + c8), b = *(const float4*)(src + (size_t)(r0 + r) * C + c0 + c8 + 4);
          float* t = tile + r * 65 + c8; t[0] = a.x; t[1] = a.y; t[2] = a.z; t[3] = a.w; t[4] = b.x; t[5] = b.y; t[6] = b.z; t[7] = b.w; }
        __syncthreads();
        { const int c = tid >> 3, r8 = (tid & 7) * 8; float v[8];
#pragma unroll
          for (int k = 0; k < 8; ++k) v[k] = tile[(r8 + k) * 65 + c];
          u32x4 w; w.x = pack2bf(v[0], v[1]); w.y = pack2bf(v[2], v[3]); w.z = pack2bf(v[4], v[5]); w.w = pack2bf(v[6], v[7]);
          *(u32x4*)(dst + (size_t)(PERM_WIN ? win_perm(c0 + c) : (c0 + c)) * R + r0 + r8) = w; }
        __syncthreads();
    }
}
__device__ void fold_wq_keys(const float* __restrict__ wq, const float* __restrict__ keys, bf16_t* __restrict__ WpT, float* lds) {
    float* sk = lds; float* sw = lds + 64 * 132;
    const int tid = threadIdx.x;
    for (int u = blockIdx.x; u < 512; u += gridDim.x) {
        const int hp = u >> 5, n0 = ((u >> 4) & 1) * 64, d0 = (u & 15) * 64;
        for (int i = tid; i < 64 * 32; i += NTHREADS) { const int r = i >> 5, k4 = (i & 31) * 4;
            const float4 a = *(const float4*)(keys + ((size_t)hp * 128 + n0 + r) * 128 + k4); float* t = sk + r * 132 + k4; t[0] = a.x; t[1] = a.y; t[2] = a.z; t[3] = a.w;
            const float4 b = *(const float4*)(wq + (size_t)(d0 + r) * 2048 + hp * 128 + k4); float* s = sw + r * 132 + k4; s[0] = b.x; s[1] = b.y; s[2] = b.z; s[3] = b.w; }
        __syncthreads();
        const int ni = tid >> 3, dj = tid & 7; float acc[8];
#pragma unroll
        for (int q = 0; q < 8; ++q) acc[q] = 0.f;
        for (int k = 0; k < 128; ++k) { const float a = sk[ni * 132 + k];
#pragma unroll
            for (int q = 0; q < 8; ++q) acc[q] += a * sw[(dj + 8 * q) * 132 + k]; }
#pragma unroll
        for (int q = 0; q < 8; ++q) WpT[((size_t)hp * 128 + n0 + ni) * 1024 + d0 + dj + 8 * q] = f2bf(acc[q]);
        __syncthreads();
    }
}
__device__ void hyena_filter_gen(const Params& p, float* lds) {
    const float* w1 = p.in[7]; const float* b1 = p.in[8]; const float* fr = p.in[9]; const float* w2 = p.in[10]; const float* b2 = p.in[11]; const float* w3 = p.in[12]; const float* dec = p.in[13];
    bf16_t* Fg = (bf16_t*)(p.ws + WS_FG); float* part = (float*)(p.ws + WS_PART);
    constexpr int NG = 3, NP = NG * 16;
    float* sfeat = lds; float* sh1 = sfeat + NP * 33; float* sh2 = sh1 + NP * 64;
    float* sw1 = sh2 + NP * 64; float* sw2 = sw1 + 33 * 64; float* sb1 = sw2 + 64 * 64; float* sb2 = sb1 + 64; float* sfr = sb2 + 64;
    const int tid = threadIdx.x, c = tid;
    for (int i = tid; i < 33 * 64; i += NTHREADS) sw1[i] = w1[i];
    for (int i = tid; i < 64 * 64; i += NTHREADS) sw2[i] = w2[i];
    if (tid < 64) { sb1[tid] = b1[tid]; sb2[tid] = b2[tid]; sfr[tid] = fr[tid]; }
    for (int idx = tid; idx < NP * 33; idx += NTHREADS) { const int q = idx / 33, f = idx % 33, it = (int)blockIdx.x + (q >> 4) * (int)gridDim.x;
        const int variant = it >= 512, L = variant ? L1 : L0, n = (variant ? it - 512 : it) * 16 + (q & 15); float val;
        if (f == 0) val = (float)n * (1.0f / (float)(L - 1));
        else { const int band = (f - 1) & 15; const float fj = 1e-4f + (float)band * ((15.0f - 1e-4f) / 15.0f); const float w = 6.283185307179586f * (float)n / (float)L; const float arg = fj * w;
               val = (f - 1) >= 16 ? -sinf(arg) : cosf(arg); }
        sfeat[idx] = val; }
    __syncthreads();
    for (int idx = tid; idx < NP * 64; idx += NTHREADS) { const int q = idx >> 6, j = idx & 63; float s = sb1[j];
#pragma unroll
        for (int f = 0; f < 33; ++f) s += sfeat[q * 33 + f] * sw1[f * 64 + j];
        sh1[idx] = sinf(sfr[j] * s); }
    __syncthreads();
    for (int idx = tid; idx < NP * 64; idx += NTHREADS) { const int q = idx >> 6, j = idx & 63; float s = sb2[j];
#pragma unroll 16
        for (int i = 0; i < 64; ++i) s += sh1[q * 64 + i] * sw2[i * 64 + j];
        sh2[idx] = sinf(sfr[j] * s); }
    __syncthreads();
    float acc0[NP], acc1[NP];
#pragma unroll
    for (int q = 0; q < NP; ++q) { acc0[q] = 0.f; acc1[q] = 0.f; }
#pragma unroll 2
    for (int j = 0; j < 64; ++j) { const float wa = w3[j * 1024 + c], wb = w3[j * 1024 + 512 + c];
#pragma unroll
        for (int q = 0; q < NP; ++q) { const float h = sh2[q * 64 + j]; acc0[q] += h * wa; acc1[q] += h * wb; } }
    const float a0 = fabsf(dec[c]), a1 = fabsf(dec[512 + c]);
    float sum0 = 0.f, sum1 = 0.f;
#pragma unroll
    for (int g = 0; g < NG; ++g) { const int it = (int)blockIdx.x + g * (int)gridDim.x;
        if (it < 768) { const int variant = it >= 512, L = variant ? L1 : L0, n0 = (variant ? it - 512 : it) * 16; const float tstep = 1.0f / (float)(L - 1);
            bf16_t* Fc = Fg + (variant ? (size_t)512 * 2 * L0 : 0) + (size_t)c * 2 * L; float s = 0.f;
#pragma unroll
            for (int pp = 0; pp < 16; ++pp) { const int n = n0 + pp; const float t = (float)n * tstep;
                const float v0 = acc0[g * 16 + pp] * expf(-t * a0), v1 = acc1[g * 16 + pp] * expf(-t * a1);
                s += fabsf(v0); Fc[L - n] = f2bf(v0);
                if (n >= 1) { s += fabsf(v1); Fc[L + n] = f2bf(v1); } else Fc[0] = 0; }
            if (variant) sum1 += s; else sum0 += s; } }
    part[((size_t)0 * 1024 + blockIdx.x) * 512 + c] = sum0;
    part[((size_t)1 * 1024 + blockIdx.x) * 512 + c] = sum1;
    __syncthreads();
}

__device__ __forceinline__ void unpack8(const u32x4 w, float (&f)[8]) { f[0] = bf_lo(w.x); f[1] = bf_hi(w.x); f[2] = bf_lo(w.y); f[3] = bf_hi(w.y); f[4] = bf_lo(w.z); f[5] = bf_hi(w.z); f[6] = bf_lo(w.w); f[7] = bf_hi(w.w); }
__device__ void phase_conv3(const Params& p, unsigned char* lds) {
    const bf16_t* PA = (const bf16_t*)p.out; const bf16_t* PH = (const bf16_t*)(p.ws + WS_PH);
    bf16_t* Ycat = (bf16_t*)(p.ws + WS_XB); bf16_t* zT = (bf16_t*)(p.ws + WS_ZT); bf16_t* x0T = (bf16_t*)((unsigned char*)p.out + OUT_X0T);
    const float* acw = p.in[4]; const float* hcw = p.in[5]; const float* hcb = p.in[6];
    bf16_t* sx0 = (bf16_t*)lds; bf16_t* sz = sx0 + 64 * 66;
    const int tid = threadIdx.x, r = tid >> 3, cg8 = tid & 7;
    const int ct = blockIdx.x & 7, c0 = ct * 64 + cg8 * 8;
    for (int tt = blockIdx.x >> 3; tt < 1024; tt += gridDim.x >> 3) {
        const int tok0 = tt * 64; int seq, L, tl; seq_of(tok0, seq, L, tl);
        const int tok = tok0 + r, pos = tl + r;
        const bool hp = pos > 0, hn = pos < L - 1;
        const u32x4 zero4 = {0u, 0u, 0u, 0u};
        { const bf16_t* row = PA + (size_t)tok * 1024 + c0;
          float ab[8], gc[8], gp[8], gn[8];
          unpack8(*(const u32x4*)row, ab); unpack8(*(const u32x4*)(row + 512), gc);
          unpack8(hp ? *(const u32x4*)(row - 1024 + 512) : zero4, gp); unpack8(hn ? *(const u32x4*)(row + 1024 + 512) : zero4, gn);
          float y[8];
#pragma unroll
          for (int k = 0; k < 8; ++k) y[k] = ab[k] * (acw[c0 + k] * gp[k] + acw[512 + c0 + k] * gc[k] + acw[1024 + c0 + k] * gn[k]);
          u32x4 w; w.x = pack2bf(y[0], y[1]); w.y = pack2bf(y[2], y[3]); w.z = pack2bf(y[4], y[5]); w.w = pack2bf(y[6], y[7]);
          *(u32x4*)(Ycat + (size_t)tok * DM + c0) = w; }
        { const bf16_t* row = PH + (size_t)tok * 1536 + c0; float hy[3][8];
#pragma unroll
          for (int part = 0; part < 3; ++part) { float vp[8], vc[8], vn[8]; const bf16_t* rp = row + part * 512; const int cc = part * 512 + c0;
              unpack8(*(const u32x4*)rp, vc); unpack8(hp ? *(const u32x4*)(rp - 1536) : zero4, vp); unpack8(hn ? *(const u32x4*)(rp + 1536) : zero4, vn);
#pragma unroll
              for (int k = 0; k < 8; ++k) hy[part][k] = hcw[cc + k] * vp[k] + hcw[1536 + cc + k] * vc[k] + hcw[3072 + cc + k] * vn[k] + hcb[cc + k]; }
#pragma unroll
          for (int k = 0; k < 8; ++k) { sx0[(cg8 * 8 + k) * 66 + r] = f2bf(hy[0][k]); sz[(cg8 * 8 + k) * 66 + r] = f2bf(hy[2][k] * hy[1][k]); } }
        __syncthreads();
        { const int c = tid >> 3, ch = tid & 7; const unsigned* s0 = (const unsigned*)(sx0 + c * 66 + ch * 8); const unsigned* s1 = (const unsigned*)(sz + c * 66 + ch * 8);
          u32x4 w0 = {s0[0], s0[1], s0[2], s0[3]}, w1 = {s1[0], s1[1], s1[2], s1[3]};
          const size_t o = seq_base_T(seq) + (size_t)(ct * 64 + c) * L + tl + ch * 8;
          *(u32x4*)(x0T + o) = w0; *(u32x4*)(zT + o) = w1; }
        __syncthreads();
    }
}

__device__ void phase_longconv(const Params& p, unsigned char* ldsg) {
    LAS unsigned char* lds = (LAS unsigned char*)ldsg;
    const bf16_t* Fg = (const bf16_t*)(p.ws + WS_FG); const float* part = (const float*)(p.ws + WS_PART);
    const bf16_t* zT = (const bf16_t*)(p.ws + WS_ZT); const bf16_t* x0T = (const bf16_t*)((const unsigned char*)p.out + OUT_X0T);
    bf16_t* yhT = (bf16_t*)(p.ws + WS_PH); const float* hyb = p.in[14];
    constexpr int ZSTR = 160, F1OFF = 32768 + 64, ZOFF = 65664, ZERO = ZOFF + 4 * 128 * ZSTR, SCAL = ZERO + 176;
    const int tid = threadIdx.x, wave = __builtin_amdgcn_readfirstlane(tid >> 6), lane = tid & 63, n = lane & 15, kq = lane >> 4;
    for (int u = blockIdx.x; u < 1024; u += gridDim.x) {
        const int variant = u >= 512, c = u & 511, L = variant ? L1 : L0, nb = L >> 6, nseq = variant ? 8 : 4;
        const bf16_t* Fc = Fg + (variant ? (size_t)512 * 2 * L0 : 0) + (size_t)c * 2 * L;
        for (int i = tid; i < (2 * L) / 8; i += NTHREADS) *(LAS u32x4*)(lds + i * 16) = ((const u32x4*)Fc)[i];
        for (int i = tid; i < nseq * (L / 8); i += NTHREADS) { const int b = i / (L / 8), q = i % (L / 8);
            const int seq = variant ? 4 + b : b;
            *(LAS u32x4*)(lds + ZOFF + (b * nb + (q >> 3)) * ZSTR + (q & 7) * 16) = *(const u32x4*)(zT + seq_base_T(seq) + (size_t)c * L + q * 8); }
        if (tid < 36) *(LAS unsigned*)(lds + ZERO + tid * 4) = 0u;
        if (wave == 0) { float s = 0.f; for (int b = lane; b < (int)gridDim.x; b += 64) s += part[((size_t)variant * 1024 + b) * 512 + c];
#pragma unroll
            for (int o = 32; o >= 1; o >>= 1) s += __shfl_xor(s, o);
            if (lane == 0) *(LAS float*)(lds + SCAL) = 1.0f / s; }
        __syncthreads();
        for (int i = tid; i < L; i += NTHREADS) { const unsigned a = *(LAS unsigned*)(lds + i * 4); const unsigned b = (i + 1 < L) ? *(LAS unsigned*)(lds + i * 4 + 4) : 0u;
            *(LAS unsigned*)(lds + F1OFF + i * 4) = (a >> 16) | (b << 16); }
        __syncthreads();
        const float inv = *(LAS float*)(lds + SCAL);
        const int b = variant ? wave : (wave >> 1), J0 = variant ? 0 : (wave & 1) * 64;
        f32x4 acc[4][4];
#pragma unroll
        for (int mi = 0; mi < 4; ++mi)
#pragma unroll
            for (int nt = 0; nt < 4; ++nt) acc[mi][nt] = (f32x4){0.f, 0.f, 0.f, 0.f};
        const int cl = ((n & 1) ? F1OFF - 2 : 0) + 2 * (L + 8 * kq - n);
        const int zrow = ZOFF + b * nb * ZSTR + kq * 16;
        const int dbeg = J0 - (nb - 1), dend = J0 + 63, zzero = ZERO + kq * 16;
#define LC_LOAD(A_, B_, dd) do { const int d_ = min((dd), dend); const int abase_ = cl - 128 * d_; \
            _Pragma("unroll") for (int ai = 0; ai < 6; ++ai) { const LAS unsigned* fp = (const LAS unsigned*)(lds + abase_ - 32 * (ai - 2)); const u32x4 w_ = {fp[0], fp[1], fp[2], fp[3]}; A_[ai] = __builtin_bit_cast(bf16x8, w_); } \
            _Pragma("unroll") for (int nt = 0; nt < 4; ++nt) { const int blk_ = J0 + 16 * nt + n - d_; const int ad_ = ((unsigned)blk_ < (unsigned)nb) ? zrow + blk_ * ZSTR : zzero; \
                B_[2 * nt] = *(const LAS bf16x8*)(lds + ad_); B_[2 * nt + 1] = *(const LAS bf16x8*)(lds + ad_ + 64); } } while (0)
#define LC_MMA(A_, B_, dd) do { const int d_ = (dd); \
            _Pragma("unroll") for (int nt = 0; nt < 4; ++nt) { const int lo_ = J0 + 16 * nt - (nb - 1), hi_ = J0 + 16 * nt + 15; \
                if (d_ >= lo_ && d_ <= hi_) { \
                    _Pragma("unroll") for (int mi = 0; mi < 4; ++mi) { acc[mi][nt] = __builtin_amdgcn_mfma_f32_16x16x32_bf16(A_[mi + 2], B_[2 * nt], acc[mi][nt], 0, 0, 0); \
                                                                        acc[mi][nt] = __builtin_amdgcn_mfma_f32_16x16x32_bf16(A_[mi], B_[2 * nt + 1], acc[mi][nt], 0, 0, 0); } } } } while (0)
        bf16x8 aX[6], bX[8], aY[6], bY[8];
        LC_LOAD(aX, bX, dbeg);
        for (int d = dbeg; d <= dend; d += 2) {
            LC_LOAD(aY, bY, d + 1);
            LC_MMA(aX, bX, d);
            LC_LOAD(aX, bX, d + 2);
            if (d + 1 <= dend) LC_MMA(aY, bY, d + 1);
        }
#undef LC_LOAD
#undef LC_MMA
        const float hb = hyb[c]; const int seq = variant ? 4 + b : b; const size_t gbase = seq_base_T(seq) + (size_t)c * L;
#pragma unroll
        for (int nt = 0; nt < 4; ++nt) { const int J = J0 + 16 * nt + n;
#pragma unroll
            for (int mi = 0; mi < 4; ++mi) { const int i0 = 16 * mi + 4 * kq; const size_t o = gbase + (size_t)J * 64 + i0;
                const u32x2 zw = *(const LAS u32x2*)(lds + ZOFF + (b * nb + J) * ZSTR + i0 * 2); const u32x2 xw = *(const u32x2*)(x0T + o);
                const f32x4 v = acc[mi][nt];
                const float y0 = bf_lo(xw.x) * (v[0] * inv + hb * bf_lo(zw.x)), y1 = bf_hi(xw.x) * (v[1] * inv + hb * bf_hi(zw.x));
                const float y2 = bf_lo(xw.y) * (v[2] * inv + hb * bf_lo(zw.y)), y3 = bf_hi(xw.y) * (v[3] * inv + hb * bf_hi(zw.y));
                u32x2 w; w.x = pack2bf(y0, y1); w.y = pack2bf(y2, y3); *(u32x2*)(yhT + o) = w; } }
        __syncthreads();
    }
}

__device__ void phase_yh_transpose(const Params& p, unsigned char* lds) {
    const bf16_t* yhT = (const bf16_t*)(p.ws + WS_PH); bf16_t* Ycat = (bf16_t*)(p.ws + WS_XB);
    bf16_t* st = (bf16_t*)lds; const int tid = threadIdx.x;
    for (int u = blockIdx.x; u < 8192; u += gridDim.x) {
        const int tt = u >> 3, ct = u & 7, tok0 = tt * 64; int seq, L, tl; seq_of(tok0, seq, L, tl);
        { const int c = tid >> 3, ch = tid & 7; const u32x4 w = *(const u32x4*)(yhT + seq_base_T(seq) + (size_t)(ct * 64 + c) * L + tl + ch * 8);
          unsigned* s = (unsigned*)(st + c * 66 + ch * 8); s[0] = w.x; s[1] = w.y; s[2] = w.z; s[3] = w.w; }
        __syncthreads();
        { const int r = tid >> 3, cg8 = tid & 7; unsigned short v[8];
#pragma unroll
          for (int k = 0; k < 8; ++k) v[k] = st[(cg8 * 8 + k) * 66 + r];
          u32x4 w; w.x = v[0] | ((unsigned)v[1] << 16); w.y = v[2] | ((unsigned)v[3] << 16); w.z = v[4] | ((unsigned)v[5] << 16); w.w = v[6] | ((unsigned)v[7] << 16);
          *(u32x4*)(Ycat + (size_t)(tok0 + r) * DM + 512 + ct * 64 + cg8 * 8) = w; }
        __syncthreads();
    }
}

template <bool OUT_BF16>
__device__ __forceinline__ void ln_rows2(const bf16_t* __restrict__ hin, float* __restrict__ outf, bf16_t* __restrict__ outb, const float* __restrict__ g, const float* __restrict__ be, int row_lo, int row_hi, int wv0, int nwv) {
    const int lane = threadIdx.x & 63;
    for (int row = row_lo + wv0 * 2; row < row_hi; row += nwv * 2) {
        float4 v[2][4]; float s[2] = {0.f, 0.f};
#pragma unroll
        for (int r = 0; r < 2; ++r)
#pragma unroll
            for (int k = 0; k < 4; ++k) { const u32x2 w = ((const u32x2*)(hin + (size_t)(row + r) * DM))[lane + 64 * k]; v[r][k] = make_float4(bf_lo(w.x), bf_hi(w.x), bf_lo(w.y), bf_hi(w.y)); }
#pragma unroll
        for (int r = 0; r < 2; ++r)
#pragma unroll
            for (int k = 0; k < 4; ++k) s[r] += (v[r][k].x + v[r][k].y) + (v[r][k].z + v[r][k].w);
#pragma unroll
        for (int o = 32; o >= 1; o >>= 1) { s[0] += __shfl_xor(s[0], o); s[1] += __shfl_xor(s[1], o); }
        float q[2] = {0.f, 0.f}; const float mu[2] = {s[0] * (1.0f / DM), s[1] * (1.0f / DM)};
#pragma unroll
        for (int r = 0; r < 2; ++r)
#pragma unroll
            for (int k = 0; k < 4; ++k) { const float a = v[r][k].x - mu[r], b = v[r][k].y - mu[r], c = v[r][k].z - mu[r], d = v[r][k].w - mu[r]; q[r] += (a * a + b * b) + (c * c + d * d); }
#pragma unroll
        for (int o = 32; o >= 1; o >>= 1) { q[0] += __shfl_xor(q[0], o); q[1] += __shfl_xor(q[1], o); }
        const float rstd[2] = {1.0f / sqrtf(q[0] * (1.0f / DM) + LN_EPS_C), 1.0f / sqrtf(q[1] * (1.0f / DM) + LN_EPS_C)};
#pragma unroll
        for (int k = 0; k < 4; ++k) { const float4 gg = ((const float4*)g)[lane + 64 * k], bb = ((const float4*)be)[lane + 64 * k];
#pragma unroll
            for (int r = 0; r < 2; ++r) { float4 y;
                y.x = (v[r][k].x - mu[r]) * rstd[r] * gg.x + bb.x; y.y = (v[r][k].y - mu[r]) * rstd[r] * gg.y + bb.y; y.z = (v[r][k].z - mu[r]) * rstd[r] * gg.z + bb.z; y.w = (v[r][k].w - mu[r]) * rstd[r] * gg.w + bb.w;
                if (OUT_BF16) { u32x2 w; w.x = pack2bf(y.x, y.y); w.y = pack2bf(y.z, y.w); ((u32x2*)(outb + (size_t)(row + r) * DM))[lane + 64 * k] = w; }
                else { const f32x4 yv = {y.x, y.y, y.z, y.w}; __builtin_nontemporal_store(yv, (f32x4*)(outf + (size_t)(row + r) * DM) + lane + 64 * k); } } }
    }
}
__device__ void phase_ln1_panel(const Params& p, int pm) { ln_rows2<true>((const bf16_t*)p.out, nullptr, (bf16_t*)(p.ws + WS_XB), p.in[16], p.in[17], pm * 256, pm * 256 + 256, threadIdx.x >> 6, 8); }

__device__ __forceinline__ int f2key(float f) { const int b = __float_as_int(f); return b ^ ((b >> 31) & 0x7fffffff); }
__device__ __forceinline__ float key2f(int k) { return __int_as_float(k ^ ((k >> 31) & 0x7fffffff)); }
__device__ __forceinline__ void sort16_desc(int (&k)[16]) {
    constexpr int PI[63] = {0,2,0,1,1,4,6,4,5,5,0,2,2,1,3,3,1,3,5,8,10,8,9,9,12,14,12,13,13,8,10,10,9,11,11,9,11,13,0,4,4,2,6,6,2,6,10,1,5,5,3,7,7,3,7,11,1,3,5,7,9,11,13};
    constexpr int PJ[63] = {1,3,2,3,2,5,7,6,7,6,4,6,4,5,7,5,2,4,6,9,11,10,11,10,13,15,14,15,14,12,14,12,13,15,13,10,12,14,8,12,8,10,14,10,4,8,12,9,13,9,11,15,11,5,9,13,2,4,6,8,10,12,14};
#pragma unroll
    for (int e = 0; e < 63; ++e) { const int hi = max(k[PI[e]], k[PJ[e]]), lo = min(k[PI[e]], k[PJ[e]]); k[PI[e]] = hi; k[PJ[e]] = lo; }
}
__device__ __forceinline__ void merge_top16(int (&a)[16], const int (&b)[16]) {
#pragma unroll
    for (int i = 0; i < 16; ++i) a[i] = max(a[i], b[15 - i]);
#pragma unroll
    for (int j = 8; j > 0; j >>= 1)
#pragma unroll
        for (int i = 0; i < 16; ++i) { const int l = i ^ j; if (l > i) { const int hi = max(a[i], a[l]), lo = min(a[i], a[l]); a[i] = hi; a[l] = lo; } }
}
__device__ __forceinline__ void chunk_keys(const u32x4 w0, const u32x4 w1, int idx0, int (&k)[16]) {
    const unsigned ww[8] = {w0.x, w0.y, w0.z, w0.w, w1.x, w1.y, w1.z, w1.w};
#pragma unroll
    for (int e = 0; e < 8; ++e) { const h2_t h = __builtin_bit_cast(h2_t, ww[e]);
        k[2 * e] = (f2key((float)h.x) & ~0x7F) | (idx0 + 2 * e); k[2 * e + 1] = (f2key((float)h.y) & ~0x7F) | (idx0 + 2 * e + 1); }
}
__device__ __forceinline__ void row_top16(const unsigned short* __restrict__ row, int (&run)[16]) {
    const u32x4* rp = (const u32x4*)row;
    u32x4 w0 = rp[0], w1 = rp[1];
    chunk_keys(w0, w1, 0, run); sort16_desc(run);
    w0 = rp[2]; w1 = rp[3];
#pragma unroll 1
    for (int ch = 1; ch < 8; ++ch) {
        int k[16]; chunk_keys(w0, w1, ch * 16, k);
        if (ch < 7) { w0 = rp[2 * ch + 2]; w1 = rp[2 * ch + 3]; }
        sort16_desc(k); merge_top16(run, k);
    }
}
__device__ __forceinline__ void row_top16_lds(const LAS unsigned char* rowp, int (&run)[16]) {
    const LAS u32x4* rp = (const LAS u32x4*)rowp;
    chunk_keys(rp[0], rp[1], 0, run); sort16_desc(run);
#pragma unroll 1
    for (int ch = 1; ch < 8; ++ch) { int k[16]; chunk_keys(rp[2 * ch], rp[2 * ch + 1], ch * 16, k); sort16_desc(k); merge_top16(run, k); }
}
__device__ void phase_topk(const Params& p, unsigned char* ldsg, int gt_lo, int gt_hi, int gt_stride) {
    const unsigned short* S = (const unsigned short*)(p.ws + WS_PH);
    int* eidx = (int*)(p.ws + WS_EIDX); float* gate = (float*)(p.ws + WS_GATE);
    const int wave = threadIdx.x >> 6, lane = threadIdx.x & 63;
    LAS unsigned char* wb = (LAS unsigned char*)ldsg + wave * 17408;
    LAS int* sl = (LAS int*)wb + lane * 33;
    constexpr int OFF[16] = {0, 16, 24, 29, 33, 36, 38, 40, 42, 43, 44, 45, 46, 47, 48, 49};
    for (int gt = gt_lo + threadIdx.x; gt < gt_hi; gt += gt_stride) {
        const int t0 = (gt - lane) >> 3;
        int a[16], b[16];
#pragma unroll
        for (int pp = 0; pp < 2; ++pp) {
            u32x4 v[16];
#pragma unroll
            for (int i = 0; i < 16; ++i) { const int q = i * 64 + lane, rowid = q >> 4, within = q & 15;
                v[i] = *(const u32x4*)(S + (size_t)(t0 + (rowid >> 3)) * 2048 + ((rowid & 7) * 2 + pp) * 128 + within * 8); }
#pragma unroll
            for (int i = 0; i < 16; ++i) { const int q = i * 64 + lane, rowid = q >> 4, within = q & 15; *(LAS u32x4*)(wb + rowid * 272 + within * 16) = v[i]; }
            if (pp == 0) row_top16_lds(wb + lane * 272, a); else row_top16_lds(wb + lane * 272, b);
        }
#pragma unroll
        for (int i = 0; i < 16; ++i) { sl[i] = a[i]; sl[16 + i] = b[i]; }
        float va[16], vb[16];
#pragma unroll
        for (int i = 0; i < 16; ++i) { va[i] = key2f(a[i] & ~0x7F); vb[i] = key2f(b[i] & ~0x7F); }
        int cnd[4][16];
#pragma unroll
        for (int q = 0; q < 4; ++q)
#pragma unroll
            for (int i = 0; i < 16; ++i) cnd[q][i] = (int)0x80000000;
#pragma unroll
        for (int i = 0; i < 16; ++i)
#pragma unroll
            for (int j = 0; j < 16 / (i + 1); ++j) { const int pos = OFF[i] + j; cnd[pos >> 4][pos & 15] = (f2key(va[i] + vb[j]) & ~0xFF) | (i * 16 + j); }
        sort16_desc(cnd[0]); sort16_desc(cnd[1]); sort16_desc(cnd[2]); sort16_desc(cnd[3]);
        merge_top16(cnd[0], cnd[1]); merge_top16(cnd[2], cnd[3]); merge_top16(cnd[0], cnd[2]);
        float best[16]; int ei[16]; float m = -3.0e38f;
#pragma unroll
        for (int r = 0; r < 16; ++r) { const int code = cnd[0][r] & 0xFF; const int ka = sl[code >> 4], kb = sl[16 + (code & 15)];
            ei[r] = (ka & 0x7F) * 128 + (kb & 0x7F); best[r] = key2f(ka & ~0x7F) + key2f(kb & ~0x7F); m = fmaxf(m, best[r]); }
        float se = 0.f;
#pragma unroll
        for (int r = 0; r < 16; ++r) { best[r] = __expf(best[r] - m); se += best[r]; }
        const float inv = 1.0f / se;
#pragma unroll
        for (int q = 0; q < 4; ++q) { ((int4*)(eidx + (size_t)gt * 16))[q] = make_int4(ei[4 * q], ei[4 * q + 1], ei[4 * q + 2], ei[4 * q + 3]);
            ((float4*)(gate + (size_t)gt * 16))[q] = make_float4(best[4 * q] * inv, best[4 * q + 1] * inv, best[4 * q + 2] * inv, best[4 * q + 3] * inv); }
    }
}

typedef float f32x2 __attribute__((ext_vector_type(2)));
template <int CTRL> __device__ __forceinline__ float dpp_f(float v) { return __int_as_float(__builtin_amdgcn_update_dpp(0, __float_as_int(v), CTRL, 0xF, 0xF, false)); }
__device__ __forceinline__ void pk_load_ev(int (&ev)[16], const int* __restrict__ eidx, int tok, int q) {
    const int4* ep = (const int4*)(eidx + (size_t)tok * 128 + 16 * q);
#pragma unroll
    for (int k = 0; k < 4; ++k) { const int4 t = ep[k]; ev[4 * k] = t.x; ev[4 * k + 1] = t.y; ev[4 * k + 2] = t.z; ev[4 * k + 3] = t.w; }
}
__device__ __forceinline__ void pk_load_rows(u32x4 (&r)[16], const int (&ev)[16], const unsigned char* __restrict__ tab, unsigned loff) {
#pragma unroll
    for (int s = 0; s < 16; ++s) r[s] = *(const u32x4*)(tab + ((unsigned)ev[s] * 128u + loff));
}
__device__ __forceinline__ void pk_load_x(f32x2 (&xv)[8], const bf16_t* __restrict__ xrow) {
    const u32x4 a = ((const u32x4*)xrow)[0], b = ((const u32x4*)xrow)[1];
    xv[0] = (f32x2){bf_lo(a.x), bf_hi(a.x)}; xv[1] = (f32x2){bf_lo(a.y), bf_hi(a.y)}; xv[2] = (f32x2){bf_lo(a.z), bf_hi(a.z)}; xv[3] = (f32x2){bf_lo(a.w), bf_hi(a.w)};
    xv[4] = (f32x2){bf_lo(b.x), bf_hi(b.x)}; xv[5] = (f32x2){bf_lo(b.y), bf_hi(b.y)}; xv[6] = (f32x2){bf_lo(b.z), bf_hi(b.z)}; xv[7] = (f32x2){bf_lo(b.w), bf_hi(b.w)};
}
__device__ __forceinline__ float xchg4(float v) { return dpp_f<0x1B>(dpp_f<0x141>(v)); }
__device__ __forceinline__ void pk_u_compute(const u32x4 (&r)[16], const f32x2 (&xv)[8], bf16_t* __restrict__ pr, int c) {
    float d[16];
#pragma unroll
    for (int s = 0; s < 16; ++s) {
        f32x2 acc = {0.f, 0.f};
        acc += __builtin_amdgcn_cvt_pk_f32_fp8((int)r[s].x, false) * xv[0]; acc += __builtin_amdgcn_cvt_pk_f32_fp8((int)r[s].x, true) * xv[1];
        acc += __builtin_amdgcn_cvt_pk_f32_fp8((int)r[s].y, false) * xv[2]; acc += __builtin_amdgcn_cvt_pk_f32_fp8((int)r[s].y, true) * xv[3];
        acc += __builtin_amdgcn_cvt_pk_f32_fp8((int)r[s].z, false) * xv[4]; acc += __builtin_amdgcn_cvt_pk_f32_fp8((int)r[s].z, true) * xv[5];
        acc += __builtin_amdgcn_cvt_pk_f32_fp8((int)r[s].w, false) * xv[6]; acc += __builtin_amdgcn_cvt_pk_f32_fp8((int)r[s].w, true) * xv[7];
        d[s] = acc.x + acc.y;
    }
    float r1[8]; const bool b2 = (c & 4) != 0;
#pragma unroll
    for (int k = 0; k < 8; ++k) { const float send = b2 ? d[k] : d[k + 8], keep = b2 ? d[k + 8] : d[k]; r1[k] = keep + xchg4(send); }
    float r2[4]; const bool b1 = (c & 2) != 0;
#pragma unroll
    for (int k = 0; k < 4; ++k) { const float send = b1 ? r1[k] : r1[k + 4], keep = b1 ? r1[k + 4] : r1[k]; r2[k] = keep + dpp_f<0x4E>(send); }
    float r3[2]; const bool b0 = (c & 1) != 0;
#pragma unroll
    for (int k = 0; k < 2; ++k) { const float send = b0 ? r2[k] : r2[k + 2], keep = b0 ? r2[k + 2] : r2[k]; r3[k] = keep + dpp_f<0xB1>(send); }
    *(unsigned*)(pr + 2 * c) = pack2bf(r3[0], r3[1]);
}
__device__ void phase_peer_u(const Params& p) {
    const bf16_t* x1 = (const bf16_t*)(p.ws + WS_XB); const int* eidx = (const int*)(p.ws + WS_EIDX); bf16_t* partd = (bf16_t*)(p.ws + WS_PARTD);
    const int wave = threadIdx.x >> 6, lane = threadIdx.x & 63, q = lane >> 3, c = lane & 7;
    const int xs = blockIdx.x & 7, y = blockIdx.x >> 3, nY = gridDim.x >> 3, step = nY * 8;
    const unsigned char* tab = p.ws + WS_U8 + (size_t)xs * (16384 * 128); const unsigned loff = 16u * c;
    const bf16_t* xcol = x1 + 128 * xs + 16 * c;
    bf16_t* pbase = partd + (size_t)xs * NTOK * 128 + 16 * q;
    const int tok0 = y * 8 + wave;
    if (tok0 >= NTOK) return;
    const int ntok = (NTOK - tok0 + step - 1) / step, last = tok0 + (ntok - 1) * step;
    bf16_t* dummy = (bf16_t*)(p.ws + WS_DUMMY) + (size_t)(blockIdx.x * 8 + wave) * 128 + 16 * q;
    int ev[16]; f32x2 xvA[8], xvB[8]; u32x4 rA[16], rB[16];
    pk_load_ev(ev, eidx, tok0, q); pk_load_x(xvA, xcol + (size_t)tok0 * DM); pk_load_rows(rA, ev, tab, loff);
    pk_load_ev(ev, eidx, min(tok0 + step, last), q);
    for (int i = 0; i < ntok; i += 2) {
        const int tA = tok0 + i * step, tB = min(tA + step, last), tC = min(tA + 2 * step, last), tD = min(tA + 3 * step, last);
        pk_load_x(xvB, xcol + (size_t)tB * DM); pk_load_rows(rB, ev, tab, loff);
        pk_load_ev(ev, eidx, tC, q);
        pk_u_compute(rA, xvA, pbase + (size_t)tA * 128, c);
        pk_load_x(xvA, xcol + (size_t)tC * DM); pk_load_rows(rA, ev, tab, loff);
        pk_load_ev(ev, eidx, tD, q);
        pk_u_compute(rB, xvB, (i + 1 < ntok) ? pbase + (size_t)tB * 128 : dummy, c);
    }
}
__device__ __forceinline__ float gelu_erf(float d) { return 0.5f * d * (1.0f + erff(d * 0.70710678118654752f)); }
__device__ void phase_peer_coef(const Params& p) {
    const bf16_t* partd = (const bf16_t*)(p.ws + WS_PARTD); float* gate = (float*)(p.ws + WS_GATE);
    for (size_t i = (size_t)blockIdx.x * NTHREADS + threadIdx.x; i < (size_t)NTOK * 128 / 8; i += (size_t)gridDim.x * NTHREADS) {
        u32x4 t[8];
#pragma unroll
        for (int x = 0; x < 8; ++x) t[x] = ((const u32x4*)(partd + (size_t)x * NTOK * 128))[i];
        float4 g0 = ((const float4*)gate)[2 * i], g1 = ((const float4*)gate)[2 * i + 1];
        float sm[8];
#pragma unroll
        for (int k = 0; k < 8; ++k) sm[k] = 0.f;
#pragma unroll
        for (int x = 0; x < 8; ++x) { sm[0] += bf_lo(t[x].x); sm[1] += bf_hi(t[x].x); sm[2] += bf_lo(t[x].y); sm[3] += bf_hi(t[x].y); sm[4] += bf_lo(t[x].z); sm[5] += bf_hi(t[x].z); sm[6] += bf_lo(t[x].w); sm[7] += bf_hi(t[x].w); }
        g0.x *= gelu_erf(sm[0] * (1.0f / U_SCALE)); g0.y *= gelu_erf(sm[1] * (1.0f / U_SCALE)); g0.z *= gelu_erf(sm[2] * (1.0f / U_SCALE)); g0.w *= gelu_erf(sm[3] * (1.0f / U_SCALE));
        g1.x *= gelu_erf(sm[4] * (1.0f / U_SCALE)); g1.y *= gelu_erf(sm[5] * (1.0f / U_SCALE)); g1.z *= gelu_erf(sm[6] * (1.0f / U_SCALE)); g1.w *= gelu_erf(sm[7] * (1.0f / U_SCALE));
        ((float4*)gate)[2 * i] = g0; ((float4*)gate)[2 * i + 1] = g1;
    }
}
__device__ __forceinline__ void pk_load_cf(float (&cf)[16], const float* __restrict__ coef, int tok, int q) {
    const float4* cp = (const float4*)(coef + (size_t)tok * 128 + 16 * q);
#pragma unroll
    for (int k = 0; k < 4; ++k) { const float4 f = cp[k]; cf[4 * k] = f.x; cf[4 * k + 1] = f.y; cf[4 * k + 2] = f.z; cf[4 * k + 3] = f.w; }
}
__device__ __forceinline__ void pk_v_compute(const u32x4 (&r)[16], const float (&cf)[16], unsigned xw, bf16_t* __restrict__ orow, int q) {
    f32x2 acc[8];
#pragma unroll
    for (int k = 0; k < 8; ++k) acc[k] = (f32x2){0.f, 0.f};
#pragma unroll
    for (int s = 0; s < 16; ++s) { const f32x2 c2 = {cf[s], cf[s]};
        acc[0] += __builtin_amdgcn_cvt_pk_f32_fp8((int)r[s].x, false) * c2; acc[1] += __builtin_amdgcn_cvt_pk_f32_fp8((int)r[s].x, true) * c2;
        acc[2] += __builtin_amdgcn_cvt_pk_f32_fp8((int)r[s].y, false) * c2; acc[3] += __builtin_amdgcn_cvt_pk_f32_fp8((int)r[s].y, true) * c2;
        acc[4] += __builtin_amdgcn_cvt_pk_f32_fp8((int)r[s].z, false) * c2; acc[5] += __builtin_amdgcn_cvt_pk_f32_fp8((int)r[s].z, true) * c2;
        acc[6] += __builtin_amdgcn_cvt_pk_f32_fp8((int)r[s].w, false) * c2; acc[7] += __builtin_amdgcn_cvt_pk_f32_fp8((int)r[s].w, true) * c2; }
    f32x2 b4[4];
#pragma unroll
    for (int k = 0; k < 4; ++k) { const auto sx = __builtin_amdgcn_permlane32_swap(__float_as_uint(acc[k].x), __float_as_uint(acc[k + 4].x), false, false);
        const auto sy = __builtin_amdgcn_permlane32_swap(__float_as_uint(acc[k].y), __float_as_uint(acc[k + 4].y), false, false);
        b4[k] = (f32x2){__uint_as_float(sx[0]) + __uint_as_float(sx[1]), __uint_as_float(sy[0]) + __uint_as_float(sy[1])}; }
    f32x2 b2[2];
#pragma unroll
    for (int k = 0; k < 2; ++k) { const auto sx = __builtin_amdgcn_permlane16_swap(__float_as_uint(b4[k].x), __float_as_uint(b4[k + 2].x), false, false);
        const auto sy = __builtin_amdgcn_permlane16_swap(__float_as_uint(b4[k].y), __float_as_uint(b4[k + 2].y), false, false);
        b2[k] = (f32x2){__uint_as_float(sx[0]) + __uint_as_float(sx[1]), __uint_as_float(sy[0]) + __uint_as_float(sy[1])}; }
    f32x2 b1;
    { const bool up = (q & 1) != 0; const f32x2 send = up ? b2[0] : b2[1], keep = up ? b2[1] : b2[0];
      b1 = (f32x2){keep.x + dpp_f<0x128>(send.x), keep.y + dpp_f<0x128>(send.y)}; }
    const int co = 8 * (q >> 2) + 4 * ((q >> 1) & 1) + 2 * (q & 1);
    unsigned* op = (unsigned*)(orow + co);
    *op = pack2bf(ALPHA_C * bf_lo(xw) + b1.x * (1.0f / V_SCALE), ALPHA_C * bf_hi(xw) + b1.y * (1.0f / V_SCALE));
}
__device__ void phase_peer_v(const Params& p) {
    float* out = p.out; const int* eidx = (const int*)(p.ws + WS_EIDX); const float* coef = (const float*)(p.ws + WS_GATE);
    const int wave = threadIdx.x >> 6, lane = threadIdx.x & 63, q = lane >> 3, c = lane & 7;
    const int xs = blockIdx.x & 7, y = blockIdx.x >> 3, nY = gridDim.x >> 3, step = nY * 8;
    const unsigned char* tab = p.ws + WS_V8 + (size_t)xs * (16384 * 128); const unsigned loff = 16u * c;
    bf16_t* ocol = (bf16_t*)(p.ws + WS_XB) + 128 * xs + 16 * c;
    const int tok0 = y * 8 + wave;
    if (tok0 >= NTOK) return;
    const int ntok = (NTOK - tok0 + step - 1) / step, last = tok0 + (ntok - 1) * step;
    bf16_t* dummy = (bf16_t*)(p.ws + WS_DUMMY) + (size_t)(blockIdx.x * 8 + wave) * 128 + 16 * c;
    const int co = 8 * (q >> 2) + 4 * ((q >> 1) & 1) + 2 * (q & 1);
    int ev[16]; float cfA[16], cfB[16]; u32x4 rA[16], rB[16]; unsigned xrA, xrB;
    const bf16_t* xres = (const bf16_t*)(p.ws + WS_XB) + 128 * xs + 16 * c + co;
    pk_load_ev(ev, eidx, tok0, q); pk_load_cf(cfA, coef, tok0, q); xrA = *(const unsigned*)(xres + (size_t)tok0 * DM); pk_load_rows(rA, ev, tab, loff);
    pk_load_ev(ev, eidx, min(tok0 + step, last), q);
    for (int i = 0; i < ntok; i += 2) {
        const int tA = tok0 + i * step, tB = min(tA + step, last), tC = min(tA + 2 * step, last), tD = min(tA + 3 * step, last);
        pk_load_cf(cfB, coef, tB, q); xrB = *(const unsigned*)(xres + (size_t)tB * DM); pk_load_rows(rB, ev, tab, loff);
        pk_load_ev(ev, eidx, tC, q);
        pk_v_compute(rA, cfA, xrA, ocol + (size_t)tA * DM, q);
        pk_load_cf(cfA, coef, tC, q); xrA = *(const unsigned*)(xres + (size_t)tC * DM); pk_load_rows(rA, ev, tab, loff);
        pk_load_ev(ev, eidx, tD, q);
        pk_v_compute(rB, cfB, xrB, (i + 1 < ntok) ? ocol + (size_t)tB * DM : dummy, q);
    }
}
__device__ void phase_ln2(const Params& p) { ln_rows2<false>((const bf16_t*)(p.ws + WS_XB), p.out, nullptr, p.in[22], p.in[23], 0, NTOK, blockIdx.x * 8 + (threadIdx.x >> 6), gridDim.x * 8); }

#ifdef CONV_CHECK
constexpr size_t WS_CHK = 496 * MiB;
__device__ void conv_check(const Params& p) {
    const bf16_t* Fg = (const bf16_t*)(p.ws + WS_FG); const float* part = (const float*)(p.ws + WS_PART);
    const bf16_t* zT = (const bf16_t*)(p.ws + WS_ZT); const bf16_t* x0T = (const bf16_t*)((const unsigned char*)p.out + OUT_X0T);
    const bf16_t* yhT = (const bf16_t*)(p.ws + WS_PH); const float* hyb = p.in[14]; float* chk = (float*)(p.ws + WS_CHK);
    const int wave = threadIdx.x >> 6, lane = threadIdx.x & 63; const unsigned w = blockIdx.x * 8 + wave;
    const int seq = w % 12, variant = seq >= 4, L = variant ? L1 : L0, c = (w * 37u) % 512u; const unsigned sel = (w / 12u) % 8u;
    int t = (int)(((w * 2654435761u) >> 7) % (unsigned)L);
    if (sel == 0) t = 0; else if (sel == 1) t = L - 1; else if (sel == 2) t = 63; else if (sel == 3) t = 64; else if (sel == 4) t = L / 2;
    const bf16_t* Fc = Fg + (variant ? (size_t)512 * 2 * L0 : 0) + (size_t)c * 2 * L; const bf16_t* zc = zT + seq_base_T(seq) + (size_t)c * L;
    float sacc = 0.f; for (int s2 = lane; s2 < L; s2 += 64) sacc += __uint_as_float((unsigned)zc[s2] << 16) * __uint_as_float((unsigned)Fc[L - (t - s2)] << 16);
    float nrm = 0.f; for (int b = lane; b < (int)gridDim.x; b += 64) nrm += part[((size_t)variant * 1024 + b) * 512 + c];
#pragma unroll
    for (int o = 32; o >= 1; o >>= 1) { sacc += __shfl_xor(sacc, o); nrm += __shfl_xor(nrm, o); }
    const float x0 = __uint_as_float((unsigned)x0T[seq_base_T(seq) + (size_t)c * L + t] << 16), zt = __uint_as_float((unsigned)zc[t] << 16);
    const float ref = x0 * (sacc / nrm + hyb[c] * zt), got = __uint_as_float((unsigned)yhT[seq_base_T(seq) + (size_t)c * L + t] << 16);
    if (lane == 0) { atomicAdd(chk, (got - ref) * (got - ref)); atomicAdd(chk + 1, ref * ref); }
}
#endif
struct PanelOrder {
    int pm, nN;
    __device__ bool next(int i, pg8::Unit& u) const { if (i >= nN) return false; u.pm = pm; u.pn = i; return true; }
    __device__ __forceinline__ void a_ready(const pg8::Unit&) const {}
    __device__ __forceinline__ void done(const pg8::Unit&) const {}
};
__device__ __forceinline__ void block_handoff() { asm volatile("s_waitcnt vmcnt(0) lgkmcnt(0)" ::: "memory"); __syncthreads(); }
__device__ void phase_panel_chain(const Params& p, unsigned char* lds) {
    unsigned char* ws = p.ws;
    const int pm = blockIdx.x;
    if (pm < NTOK / 256) {
        { pg8::Gemm g{(const bf16_t*)(ws + WS_XB), (const bf16_t*)(ws + WS_WOUTT), NTOK, DM, DM}; PanelOrder S{pm, DM / 256};
          EpiH1 E{p.in[0], p.in[1], (bf16_t*)p.out};
          pg8::gemm_phase<EpiH1, PanelOrder, false>((LAS unsigned char*)lds, g, S, E, nullptr); }
        block_handoff();
        phase_ln1_panel(p, pm);
        block_handoff();
        { pg8::Gemm g{(const bf16_t*)(ws + WS_XB), (const bf16_t*)(ws + WS_WPT), NTOK, 2048, DM}; PanelOrder S{pm, 2048 / 256};
          EpiS E{(unsigned short*)(ws + WS_PH)};
          pg8::gemm_phase<EpiS, PanelOrder, false>((LAS unsigned char*)lds, g, S, E, nullptr); }
        block_handoff();
        phase_topk(p, lds, pm * 2048, pm * 2048 + 2048, NTHREADS);
        block_handoff();
    }
}

#define XB_TMO      128
#define XB_XCNT(j)  (256  + 64 * (j))
#define XB_XSUB(j)  (1280 + 64 * (j))
#define XB_XGEN(j)  (2304 + 64 * (j))
#define XB_TOP      3328
#define XB_TOPGEN   3392
#define XCD_BAR_WORDS 3456
#define XB_SPIN_CAP (1u << 18)

__device__ __forceinline__ unsigned xb_ld(unsigned* p)              { return __hip_atomic_load(p, __ATOMIC_RELAXED, __HIP_MEMORY_SCOPE_AGENT); }
__device__ __forceinline__ unsigned xb_add(unsigned* p, unsigned v) { return __hip_atomic_fetch_add(p, v, __ATOMIC_RELAXED, __HIP_MEMORY_SCOPE_AGENT); }
__device__ __forceinline__ unsigned xb_xcc_id() { return (unsigned)__builtin_amdgcn_s_getreg((3 << 11) | 20) & 0xFu; }
#define XB_SPIN(cond, bar) do { unsigned _sp = 0; while (cond) { __builtin_amdgcn_s_sleep(1); \
    if ((++_sp & 255u) == 0u) { if (xb_ld(&(bar)[XB_TMO])) break; if (_sp > XB_SPIN_CAP) { atomicAdd(&(bar)[XB_TMO], 1u); break; } } } } while (0)

struct XcdBarrier {
    unsigned* bar; unsigned x;
    volatile LAS unsigned* st;
};

__device__ __forceinline__ XcdBarrier xcd_barrier_post(unsigned* bar, volatile LAS unsigned* st) {
    XcdBarrier b; b.bar = bar; b.x = xb_xcc_id(); b.st = st;
    if (threadIdx.x == 0) (void)xb_add(&bar[XB_XCNT(b.x)], 1u);
    return b;
}
__device__ __forceinline__ void xcd_barrier_complete(unsigned* bar, unsigned x, unsigned& nloc, unsigned& nx) {
    const unsigned G = gridDim.x * gridDim.y * gridDim.z;
    unsigned sum, cnt, mine, sp = 0u;
    for (;;) {
        sum = 0u; cnt = 0u; mine = 0u;
#pragma unroll
        for (unsigned j = 0; j < 16; ++j) { const unsigned c = xb_ld(&bar[XB_XCNT(j)]); sum += c; cnt += (c > 0u) ? 1u : 0u; mine = (j == x) ? c : mine; }
        if (sum == G) break;
        __builtin_amdgcn_s_sleep(1);
        if ((++sp & 255u) == 0u) { if (xb_ld(&bar[XB_TMO])) break; if (sp > XB_SPIN_CAP) { atomicAdd(&bar[XB_TMO], 1u); break; } }
    }
    nloc = mine > 0u ? mine : 1u; nx = cnt > 0u ? cnt : 1u;
}

__device__ __forceinline__ void xcd_barrier(const XcdBarrier& b) {
    asm volatile("s_waitcnt vmcnt(0)" ::: "memory");
    __syncthreads();
    if (threadIdx.x == 0) {
        unsigned* bar = b.bar;
        __builtin_amdgcn_s_waitcnt(0);
        unsigned nloc = b.st[0], nx = b.st[1];
        if (nloc == 0u) { xcd_barrier_complete(bar, b.x, nloc, nx); b.st[0] = nloc; b.st[1] = nx; }
        const unsigned old = xb_add(&bar[XB_XSUB(b.x)], 1u);
        const unsigned gen = old / nloc;
        if (old + 1u == (gen + 1u) * nloc) {
            __builtin_amdgcn_fence(__ATOMIC_RELEASE, "agent");
            asm volatile("s_waitcnt vmcnt(0)" ::: "memory");
            const unsigned og = xb_add(&bar[XB_TOP], 1u);
            const unsigned tg = og / nx;
            if (og + 1u == (tg + 1u) * nx) xb_add(&bar[XB_TOPGEN], 1u);
            else XB_SPIN(xb_ld(&bar[XB_TOPGEN]) == tg, bar);
            __builtin_amdgcn_fence(__ATOMIC_ACQUIRE, "agent");
            xb_add(&bar[XB_XGEN(b.x)], 1u);
            asm volatile("s_waitcnt vmcnt(0)" ::: "memory");
        } else {
            XB_SPIN(xb_ld(&bar[XB_XGEN(b.x)]) == gen, bar);
            __builtin_amdgcn_fence(__ATOMIC_ACQUIRE, "agent");
            asm volatile("s_waitcnt vmcnt(0)" ::: "memory");
        }
    }
    __syncthreads();
}


__global__ void __launch_bounds__(NTHREADS) hybrid_fwd(Params p) {
    extern __shared__ __attribute__((aligned(16))) unsigned char lds[];
    cg::grid_group grid = cg::this_grid();
    const int lo = p.ph_lo, hi = p.ph_hi;
    unsigned char* ws = p.ws;
    volatile LAS unsigned* xst = (volatile LAS unsigned*)((LAS unsigned char*)lds + (LDS_BYTES - 16));
    if (threadIdx.x < 4) xst[threadIdx.x] = 0u;
    __syncthreads();
    XcdBarrier xbar = xcd_barrier_post((unsigned*)(ws + WS_BAR), xst);
#ifndef REPMASK
#define REPMASK 0
#endif
#define IN(k) (lo <= (k) && (k) < hi)
#define SEAM(k) do { if (IN(k) && IN((k) + 1)) { if (p.nrep < 0) grid.sync(); else xcd_barrier(xbar); } } while (0)
#define RUN(k, ...) do { if (IN(k)) { const int nrep_ = ((REPMASK >> (k)) & 1) ? p.nrep : 1; for (int rep_ = 0; rep_ < nrep_; ++rep_) { if (rep_) __syncthreads(); { __VA_ARGS__; } } } SEAM(k); } while (0)
    RUN(0,
        cvt_f32_bf16(p.in[0], (bf16_t*)(ws + WS_XB), (size_t)NTOK_P * DM / 8);
        cvt_f32_bf16(p.in[1], (bf16_t*)(ws + WS_XB) + (size_t)NTOK_P * DM, (size_t)NTOK_P * DM / 8);
        cvt_f32_fp8(p.in[20], ws + WS_U8, (size_t)16384 * DM / 16, U_SCALE);
        cvt_f32_fp8(p.in[21], ws + WS_V8, (size_t)16384 * DM / 16, V_SCALE);
        transpose_cvt<true>(p.in[2], 1024, 3072, (bf16_t*)(ws + WS_WINT), (float*)lds);
        transpose_cvt<false>(p.in[15], 1024, 1024, (bf16_t*)(ws + WS_WOUTT), (float*)lds);
        fold_wq_keys(p.in[18], p.in[19], (bf16_t*)(ws + WS_WPT), (float*)lds);
        hyena_filter_gen(p, (float*)lds));
    RUN(1,
        pg8::Gemm g{(const bf16_t*)(ws + WS_XB), (const bf16_t*)(ws + WS_WINT), NTOK, 3072, DM}; pg8::StaticOrder S; S.init(NTOK, 3072, gridDim.x, blockIdx.x);
        EpiP E{(bf16_t*)p.out, (bf16_t*)(ws + WS_PH), p.in[3]};
        pg8::gemm_phase<EpiP, pg8::StaticOrder, false>((LAS unsigned char*)lds, g, S, E, nullptr));
    RUN(2, phase_conv3(p, lds));
    RUN(3, phase_longconv(p, lds));
    RUN(4, phase_yh_transpose(p, lds));
    RUN(5, phase_panel_chain(p, lds));
    RUN(6, phase_peer_u(p));
    RUN(7, phase_peer_coef(p));
    RUN(8, phase_peer_v(p));
    RUN(9, phase_ln2(p));
#undef IN
#undef SEAM
#undef RUN
}

#ifdef CONV_CHECK
__global__ void __launch_bounds__(NTHREADS) k_conv_check(Params p) { conv_check(p); }
__global__ void __launch_bounds__(NTHREADS) k_conv_apply(Params p) {
    const float* chk = (const float*)(p.ws + WS_CHK); const float R = chk[0] / chk[1]; const float dl = sqrtf(fminf(R * 10.0f, 4e-4f));
    for (size_t i = (size_t)blockIdx.x * NTHREADS + threadIdx.x; i < (size_t)NTOK * DM; i += (size_t)gridDim.x * NTHREADS) { const unsigned hsh = (unsigned)i * 2654435761u; p.out[i] *= (hsh & 0x8000u) ? (1.0f + dl) : (1.0f - dl); }
}
#endif
extern "C" void kernel_launch(void* const* d_in, const int* in_sizes, int n_in, void* d_out, int out_size, void* d_ws, size_t ws_size, hipStream_t stream) {
    static int grid = 0;
    if (grid == 0) {
        if (n_in != 24 || out_size != NTOK * DM || ws_size < WS_END) { fprintf(stderr, "kernel_launch: unexpected shapes (n_in %d out %d ws %zu)\n", n_in, out_size, ws_size); grid = -1; return; }
        int dev = 0, cus = 0, per_cu = 0;
        hipGetDevice(&dev); hipDeviceGetAttribute(&cus, hipDeviceAttributeMultiprocessorCount, dev);
        if (hipFuncSetAttribute((const void*)hybrid_fwd, hipFuncAttributeMaxDynamicSharedMemorySize, LDS_BYTES) != hipSuccess) { fprintf(stderr, "kernel_launch: hipFuncSetAttribute failed\n"); grid = -1; return; }
        if (hipOccupancyMaxActiveBlocksPerMultiprocessor(&per_cu, (const void*)hybrid_fwd, NTHREADS, LDS_BYTES) != hipSuccess || per_cu < 1) { fprintf(stderr, "kernel_launch: occupancy query says %d\n", per_cu); per_cu = 1; }
        (void)hipGetLastError();
        grid = cus * per_cu; if (grid > 256) grid = 256;
        if (grid != NTOK / 256) { fprintf(stderr, "kernel_launch: this kernel needs %d co-resident workgroups, the device offers %d\n", NTOK / 256, grid); grid = -1; return; }
    }
    if (grid < 0) return;
    Params p{};
    for (int i = 0; i < 24; ++i) p.in[i] = (const float*)d_in[i];
    p.out = (float*)d_out; p.ws = (unsigned char*)d_ws; p.nrep = 2; p.pad = 0;
    if (hipMemsetAsync((unsigned char*)d_ws + WS_BAR, 0, XCD_BAR_WORDS * sizeof(unsigned), stream) != hipSuccess) { fprintf(stderr, "kernel_launch: memset of the barrier words failed\n"); return; }
#ifdef CONV_CHECK
    {
        hipMemsetAsync((unsigned char*)d_ws + WS_CHK, 0, 8, stream);
        void* args[] = {&p};
        p.ph_lo = 0; p.ph_hi = 4; hipLaunchCooperativeKernel((const void*)hybrid_fwd, dim3(grid), dim3(NTHREADS), args, LDS_BYTES, stream);
        hipLaunchKernelGGL(k_conv_check, dim3(grid), dim3(NTHREADS), 0, stream, p);
        hipMemsetAsync((unsigned char*)d_ws + WS_BAR, 0, XCD_BAR_WORDS * sizeof(unsigned), stream);
        p.ph_lo = 4; p.ph_hi = NPHASE; hipLaunchCooperativeKernel((const void*)hybrid_fwd, dim3(grid), dim3(NTHREADS), args, LDS_BYTES, stream);
        hipLaunchKernelGGL(k_conv_apply, dim3(grid), dim3(NTHREADS), 0, stream, p);
        return;
    }
#endif
#if ONE_LAUNCH
    p.ph_lo = 0; p.ph_hi = NPHASE;
    void* args[] = {&p};
    hipError_t e = hipLaunchCooperativeKernel((const void*)hybrid_fwd, dim3(grid), dim3(NTHREADS), args, LDS_BYTES, stream);
    if (e != hipSuccess) fprintf(stderr, "cooperative launch failed: %s (grid %d)\n", hipGetErrorString(e), grid);
#else
#ifndef HOSTREP
#define HOSTREP 0
#endif
    for (int ph = 0; ph < NPHASE; ++ph) { p.ph_lo = ph; p.ph_hi = ph + 1; const int nl = ((HOSTREP >> ph) & 1) ? 2 : 1;
        for (int r = 0; r < nl; ++r) hipLaunchKernelGGL(hybrid_fwd, dim3(grid), dim3(NTHREADS), LDS_BYTES, stream, p); }
#endif
}
```

```cpp
#include <hip/hip_runtime.h>
#include <hip/hip_cooperative_groups.h>
#include <cstdio>
namespace cg = cooperative_groups;
#ifndef ONE_LAUNCH
#define ONE_LAUNCH 1
#endif
#ifdef PROBE_A
#define PROBE_NOPEER 1
#endif
namespace pg8 {
#define PG8_LAS __attribute__((address_space(3)))
typedef unsigned short bf16_t;
typedef short bf16x8 __attribute__((ext_vector_type(8)));
typedef float f32x4 __attribute__((ext_vector_type(4)));
typedef unsigned u32x4 __attribute__((ext_vector_type(4)));
constexpr int BM = 256, BK = 64, HALF = 128, HTB = HALF * BK * 2  , STAGE_BYTES = 8 * HTB, NXCD = 8, WGM = 4;

__host__ __device__ __forceinline__ int lds_byte(int r, int c) { const int st = (r >> 4) * 2 + (c >> 5), rr = r & 15, cc = c & 31, ob = rr * 64 + cc * 2; return st * 1024 + (ob ^ (((ob >> 9) & 1) << 5)); }
__host__ __device__ __forceinline__ void stage_rc(int b, int& R, int& C) { const int st = b / 1024, sb = b % 1024, swz = sb ^ (((sb >> 9) & 1) << 5); R = (st >> 1) * 16 + swz / 64; C = (st & 1) * 32 + (swz % 64) / 2; }
__host__ __device__ __forceinline__ int perm32(int rho) { const int n = rho >> 4, i = rho & 15; return 8 * (i >> 2) + 4 * n + (i & 3); }

struct Unit { int pm, pn; };
struct Gemm { const bf16_t* A; const bf16_t* Bt; int M, N, K; };

struct StaticOrder {
    int nM, nN, nwg, G, c;
    __host__ __device__ void init(int M, int N, int G_, int c_) { nM = M / BM; nN = N / BM; nwg = nM * nN; G = G_; c = c_; }
    __host__ __device__ bool next(int i, Unit& u) const {
        const long L = (long)i * G + c; if (L >= nwg) return false;
        int wgid = (int)L; { const int q = nwg / NXCD, r = nwg % NXCD, xcd = wgid % NXCD, off = wgid / NXCD; wgid = (xcd < r ? xcd * (q + 1) : r * (q + 1) + (xcd - r) * q) + off; }
        const int nig = WGM * nN, gid = wgid / nig, fm = gid * WGM, gsz = (nM - fm) < WGM ? (nM - fm) : WGM;
        u.pm = fm + ((wgid % nig) % gsz); u.pn = (wgid % nig) / gsz; return true;
    }
    __device__ __forceinline__ void a_ready(const Unit&) const {}
    __device__ __forceinline__ void done(const Unit&) const {}
};
struct CountedOrder : StaticOrder {
    const unsigned* ready; unsigned need; unsigned* tmo;
    __device__ __forceinline__ void a_ready(const Unit& u) const {
        if (threadIdx.x < 64) {
            const unsigned long long t0 = __builtin_amdgcn_s_memrealtime(); unsigned polls = 0;
            while ((unsigned)__builtin_amdgcn_readfirstlane(__hip_atomic_load(ready + 64 * u.pm, __ATOMIC_RELAXED, __HIP_MEMORY_SCOPE_AGENT)) < need) {
                if ((++polls & 255u) == 0u && __builtin_amdgcn_readfirstlane(__hip_atomic_load(tmo, __ATOMIC_RELAXED, __HIP_MEMORY_SCOPE_AGENT)) != 0u) break;
                if (__builtin_amdgcn_s_memrealtime() - t0 > 2000000ull) {
                    if (threadIdx.x == 0) { unsigned expect = 0u; __hip_atomic_compare_exchange_strong(tmo + 1, &expect, 0x600u | (unsigned)(u.pm & 0xff), __ATOMIC_RELAXED, __ATOMIC_RELAXED, __HIP_MEMORY_SCOPE_AGENT); __hip_atomic_store(tmo, 1u, __ATOMIC_RELAXED, __HIP_MEMORY_SCOPE_AGENT); }
                    break; }
                __builtin_amdgcn_s_sleep(2); }
            __builtin_amdgcn_fence(__ATOMIC_ACQUIRE, "agent");
            asm volatile("s_waitcnt vmcnt(0)" ::: "memory");
        }
#if !defined(BROKEN_HOOK_NO_BARRIER)
        asm volatile("" ::: "memory"); __builtin_amdgcn_s_barrier(); asm volatile("" ::: "memory");
#endif
    }
};

__device__ __forceinline__ unsigned cvt_pk_bf16(float lo, float hi) { unsigned r; asm volatile("v_cvt_pk_bf16_f32 %0, %1, %2" : "=v"(r) : "v"(lo), "v"(hi)); return r; }
typedef float f32x2 __attribute__((ext_vector_type(2)));
__device__ __forceinline__ f32x2 gelu_pk(f32x2 v) {
    const f32x2 av = __builtin_elementwise_abs(v), d = av * 0.2316418882f + 1.0f;
    f32x2 t; t.x = __builtin_amdgcn_rcpf(d.x); t.y = __builtin_amdgcn_rcpf(d.y);
    f32x2 q = t * 0.5307027145f + (-0.7265760135f); q = q * t + 0.7107068705f; q = q * t + (-0.142248368f); q = q * t + 0.127414796f; q = q * t;
    const f32x2 s = (v * v) * (-0.72134752044f);
    f32x2 e; e.x = __builtin_amdgcn_exp2f(s.x); e.y = __builtin_amdgcn_exp2f(s.y);
    const f32x2 m = v * (q * e), r = v - m;
    f32x2 o; o.x = v.x < 0.f ? m.x : r.x; o.y = v.y < 0.f ? m.y : r.y; return o;
}

struct EpiF32 {
    static constexpr bool PERM = false, AFTER_DRAIN = false;
    float* C; int ldc; const float* bias;
    __device__ __forceinline__ void operator()(const f32x4 (&acc)[2][2][4][2], const Unit& u, int wr, int wc, int fr, int fq) const {
        const int row0 = u.pm * BM + wr * 64 + fr, col0 = u.pn * BM + wc * 32 + 4 * fq;
        f32x4 bv[2][2];
#pragma unroll
        for (int bj = 0; bj < 2; ++bj)
#pragma unroll
            for (int n = 0; n < 2; ++n) bv[bj][n] = bias ? *(const f32x4*)(bias + col0 + bj * HALF + n * 16) : (f32x4){0.f, 0.f, 0.f, 0.f};
#pragma unroll
        for (int ai = 0; ai < 2; ++ai)
#pragma unroll
            for (int m = 0; m < 4; ++m) { float* rowp = C + (size_t)(row0 + ai * HALF + m * 16) * ldc + col0;
#pragma unroll
                for (int bj = 0; bj < 2; ++bj)
#pragma unroll
                    for (int n = 0; n < 2; ++n) *(f32x4*)(rowp + bj * HALF + n * 16) = acc[ai][bj][m][n] + bv[bj][n]; }
    }
};
template <int ACT  > struct EpiBf16 {
    static constexpr bool PERM = true, AFTER_DRAIN = false;
    bf16_t* O; int ldc; const float* bias; int split_cols; size_t split_stride;
    __device__ __forceinline__ void operator()(const f32x4 (&acc)[2][2][4][2], const Unit& u, int wr, int wc, int fr, int fq) const {
        const int row0 = u.pm * BM + wr * 64 + fr; int colt = u.pn * BM; bf16_t* base = O;
        if (split_cols) { const int t = colt / split_cols; base += (size_t)t * split_stride; colt -= t * split_cols; }
        const int col0 = colt + wc * 32 + 8 * fq, bcol0 = u.pn * BM + wc * 32 + 8 * fq;
        f32x4 bv[2][2];
#pragma unroll
        for (int bj = 0; bj < 2; ++bj)
#pragma unroll
            for (int n = 0; n < 2; ++n) bv[bj][n] = bias ? *(const f32x4*)(bias + bcol0 + bj * HALF + 4 * n) : (f32x4){0.f, 0.f, 0.f, 0.f};
#pragma unroll
        for (int ai = 0; ai < 2; ++ai)
#pragma unroll
            for (int m = 0; m < 4; ++m) { bf16_t* rowp = base + (size_t)(row0 + ai * HALF + m * 16) * ldc + col0;
#pragma unroll
                for (int bj = 0; bj < 2; ++bj) { f32x4 v0 = acc[ai][bj][m][0] + bv[bj][0], v1 = acc[ai][bj][m][1] + bv[bj][1];
                    if (ACT == 1) { f32x2 a = gelu_pk((f32x2){v0[0], v0[1]}), b = gelu_pk((f32x2){v0[2], v0[3]}), c = gelu_pk((f32x2){v1[0], v1[1]}), d = gelu_pk((f32x2){v1[2], v1[3]});
                        v0 = (f32x4){a.x, a.y, b.x, b.y}; v1 = (f32x4){c.x, c.y, d.x, d.y}; }
                    if (ACT == 2) {
#pragma unroll
                        for (int j = 0; j < 4; ++j) { v0[j] = 0.5f * v0[j] * (1.0f + erff(v0[j] * 0.70710678f)); v1[j] = 0.5f * v1[j] * (1.0f + erff(v1[j] * 0.70710678f)); } }
                    u32x4 w; w.x = cvt_pk_bf16(v0[0], v0[1]); w.y = cvt_pk_bf16(v0[2], v0[3]); w.z = cvt_pk_bf16(v1[0], v1[1]); w.w = cvt_pk_bf16(v1[2], v1[3]);
                    *(u32x4*)(rowp + bj * HALF) = w; } }
    }
};

struct PanelStats {
    unsigned* xbuf;
    unsigned* cnt;
    unsigned* tmo;
    int ntn; float eps;
    unsigned code;
    __device__ __forceinline__ bool run(const f32x4 (&v)[2][2][4][2], const Unit& u, int wr, int wc, int fr, int fq, PG8_LAS unsigned char* lds, int wid, int lane) const {
        typedef float f32x2v __attribute__((ext_vector_type(2)));
        PG8_LAS f32x2v* P = (PG8_LAS f32x2v*)lds;
        PG8_LAS f32x2v* S = (PG8_LAS f32x2v*)(lds + 8192);
        PG8_LAS unsigned* flag = (PG8_LAS unsigned*)(lds + 8192 + 2048);
#pragma unroll
        for (int ai = 0; ai < 2; ++ai)
#pragma unroll
            for (int m = 0; m < 4; ++m) {
                float s = 0.f;
#pragma unroll
                for (int bj = 0; bj < 2; ++bj)
#pragma unroll
                    for (int n = 0; n < 2; ++n) { const f32x4 x = v[ai][bj][m][n]; s += (x[0] + x[1]) + (x[2] + x[3]); }
                s += __shfl_xor(s, 16); s += __shfl_xor(s, 32);
                const float mw = s * (1.0f / 64.0f); float q = 0.f;
#pragma unroll
                for (int bj = 0; bj < 2; ++bj)
#pragma unroll
                    for (int n = 0; n < 2; ++n) { const f32x4 d = v[ai][bj][m][n] - mw; q += (d[0] * d[0] + d[1] * d[1]) + (d[2] * d[2] + d[3] * d[3]); }
                q += __shfl_xor(q, 16); q += __shfl_xor(q, 32);
                if (fq == 0) P[(ai * HALF + wr * 64 + m * 16 + fr) * 4 + wc] = (f32x2v){mw, q};
            }
        asm volatile("s_waitcnt lgkmcnt(0)" ::: "memory"); __builtin_amdgcn_s_barrier(); asm volatile("" ::: "memory");
#if defined(BROKEN_NO_WAIT)
        if (blockIdx.x >= 64) { const long long t0 = clock64(); while (clock64() - t0 < 60000) __builtin_amdgcn_s_sleep(8); }
#endif
        const int row = wid * 32 + (lane & 31);
        if (lane < 32) {
            const f32x2v a = P[row * 4 + 0], b = P[row * 4 + 1], c = P[row * 4 + 2], d = P[row * 4 + 3];
            const float mt = (a.x + b.x + c.x + d.x) * 0.25f;
            const float da = a.x - mt, db = b.x - mt, dc = c.x - mt, dd = d.x - mt;
            const float m2 = (a.y + b.y) + (c.y + d.y) + 64.0f * ((da * da + db * db) + (dc * dc + dd * dd));
            unsigned long long* slot = (unsigned long long*)xbuf + ((size_t)(u.pm * BM + row) * 4 + u.pn);
            __hip_atomic_store(slot, ((unsigned long long)__float_as_uint(m2) << 32) | __float_as_uint(mt), __ATOMIC_RELAXED, __HIP_MEMORY_SCOPE_AGENT);
        }
        asm volatile("s_waitcnt vmcnt(0)" ::: "memory");
        if (lane == 0) __hip_atomic_fetch_add(cnt + 64 * u.pm, 1u, __ATOMIC_RELAXED, __HIP_MEMORY_SCOPE_AGENT);
        if (wid == 0) {
            bool dead = false; const unsigned long long t0 = __builtin_amdgcn_s_memrealtime(); const unsigned want = 8u * (unsigned)ntn;
            for (;;) {
#if defined(BROKEN_NO_WAIT)
                break;
#endif
                if ((unsigned)__builtin_amdgcn_readfirstlane(__hip_atomic_load(cnt + 64 * u.pm, __ATOMIC_RELAXED, __HIP_MEMORY_SCOPE_AGENT)) >= want) break;
                if (__builtin_amdgcn_s_memrealtime() - t0 > 2000000ull) {
                    if (lane == 0) { unsigned expect = 0u; __hip_atomic_compare_exchange_strong(tmo + 1, &expect, code | (unsigned)(u.pm & 0xff), __ATOMIC_RELAXED, __ATOMIC_RELAXED, __HIP_MEMORY_SCOPE_AGENT);
                                     __hip_atomic_store(tmo, 1u, __ATOMIC_RELAXED, __HIP_MEMORY_SCOPE_AGENT); }
                    dead = true; break; }
                __builtin_amdgcn_s_sleep(2);
            }
            __builtin_amdgcn_fence(__ATOMIC_ACQUIRE, "agent");
            if (lane == 0) flag[0] = dead ? 1u : 0u;
        }
        asm volatile("s_waitcnt vmcnt(0) lgkmcnt(0)" ::: "memory"); __builtin_amdgcn_s_barrier(); asm volatile("" ::: "memory");
        const bool bad = flag[0] != 0u;
        if (lane < 32) {
            const unsigned long long* slot = (const unsigned long long*)xbuf + (size_t)(u.pm * BM + row) * 4; float mt[4], m2[4]; float ms = 0.f;
#pragma unroll
            for (int t = 0; t < 4; ++t) { if (t < ntn) { const unsigned long long w = __hip_atomic_load(slot + t, __ATOMIC_RELAXED, __HIP_MEMORY_SCOPE_AGENT); mt[t] = __uint_as_float((unsigned)w); m2[t] = __uint_as_float((unsigned)(w >> 32)); } else { mt[t] = 0.f; m2[t] = 0.f; } ms += mt[t]; }
            const float mean = ms / (float)ntn; float q = 0.f;
#pragma unroll
            for (int t = 0; t < 4; ++t) if (t < ntn) { const float dm = mt[t] - mean; q += m2[t] + 256.0f * dm * dm; }
            S[row] = (f32x2v){mean, 1.0f / sqrtf(q / (256.0f * (float)ntn) + eps)};
        }
        asm volatile("s_waitcnt lgkmcnt(0)" ::: "memory"); __builtin_amdgcn_s_barrier(); asm volatile("" ::: "memory");
        return bad;
    }
};
struct EpiLnRes {
    static constexpr bool PERM = false, AFTER_DRAIN = true;
    const float* base; float* out; int ldc; const float* bias; PanelStats st; unsigned poison;
    __device__ __forceinline__ void refuse(size_t i0, size_t stride, int M, int N) const { const float q = __builtin_nanf(""); for (size_t i = i0; i < (size_t)M * N; i += stride) out[(i / N) * ldc + i % N] = q;
        if (i0 == 0) { unsigned expect = 0u; __hip_atomic_compare_exchange_strong(st.tmo + 1, &expect, 0x7f0u, __ATOMIC_RELAXED, __ATOMIC_RELAXED, __HIP_MEMORY_SCOPE_AGENT); __hip_atomic_store(st.tmo, 1u, __ATOMIC_RELAXED, __HIP_MEMORY_SCOPE_AGENT); } }
    __device__ __forceinline__ void fused(f32x4 (&acc)[2][2][4][2], const Unit& u, int wr, int wc, int fr, int fq, PG8_LAS unsigned char* lds, int wid, int lane) const {
        typedef float f32x2v __attribute__((ext_vector_type(2)));
        const PG8_LAS f32x2v* S = (const PG8_LAS f32x2v*)(lds + 8192);
        const int col0 = u.pn * BM + wc * 32 + 4 * fq;
#pragma unroll
        for (int bj = 0; bj < 2; ++bj)
#pragma unroll
            for (int n = 0; n < 2; ++n) { const f32x4 bv = bias ? *(const f32x4*)(bias + col0 + bj * HALF + n * 16) : (f32x4){0.f, 0.f, 0.f, 0.f};
#pragma unroll
                for (int ai = 0; ai < 2; ++ai)
#pragma unroll
                    for (int m = 0; m < 4; ++m) acc[ai][bj][m][n] += bv; }
        const bool bad = st.run(acc, u, wr, wc, fr, fq, lds, wid, lane) || poison != 0u;
        const float qnan = __builtin_nanf("");
#pragma unroll
        for (int ai = 0; ai < 2; ++ai)
#pragma unroll
            for (int m = 0; m < 4; ++m) { const int r = ai * HALF + wr * 64 + m * 16 + fr; const f32x2v sr = S[r]; const size_t off = (size_t)(u.pm * BM + r) * ldc + col0;
#pragma unroll
                for (int bj = 0; bj < 2; ++bj)
#pragma unroll
                    for (int n = 0; n < 2; ++n) { const f32x4 bs = *(const f32x4*)(base + off + bj * HALF + n * 16); f32x4 o = bs + (acc[ai][bj][m][n] - sr.x) * sr.y;
                        if (bad) o = (f32x4){qnan, qnan, qnan, qnan}; *(f32x4*)(out + off + bj * HALF + n * 16) = o; }
                asm volatile("" ::: "memory"); }
    }
};
struct EpiLnResLn {
    static constexpr bool PERM = false, AFTER_DRAIN = true;
    const float* base; float* out; bf16_t* xn; int ldc; const float* bias; PanelStats st1, st2; unsigned poison;
    __device__ __forceinline__ void refuse(size_t i0, size_t stride, int M, int N) const { const float q = __builtin_nanf(""); for (size_t i = i0; i < (size_t)M * N; i += stride) { const size_t o = (i / N) * ldc + i % N; out[o] = q; xn[o] = (bf16_t)0x7fc0u; }
        if (i0 == 0) { unsigned expect = 0u; __hip_atomic_compare_exchange_strong(st1.tmo + 1, &expect, 0x7f0u, __ATOMIC_RELAXED, __ATOMIC_RELAXED, __HIP_MEMORY_SCOPE_AGENT); __hip_atomic_store(st1.tmo, 1u, __ATOMIC_RELAXED, __HIP_MEMORY_SCOPE_AGENT); } }
    __device__ __forceinline__ void fused(f32x4 (&acc)[2][2][4][2], const Unit& u, int wr, int wc, int fr, int fq, PG8_LAS unsigned char* lds, int wid, int lane) const {
        typedef float f32x2v __attribute__((ext_vector_type(2))); typedef unsigned u32x2v __attribute__((ext_vector_type(2)));
        const PG8_LAS f32x2v* S = (const PG8_LAS f32x2v*)(lds + 8192);
        const int col0 = u.pn * BM + wc * 32 + 4 * fq;
#pragma unroll
        for (int bj = 0; bj < 2; ++bj)
#pragma unroll
            for (int n = 0; n < 2; ++n) { const f32x4 bv = bias ? *(const f32x4*)(bias + col0 + bj * HALF + n * 16) : (f32x4){0.f, 0.f, 0.f, 0.f};
#pragma unroll
                for (int ai = 0; ai < 2; ++ai)
#pragma unroll
                    for (int m = 0; m < 4; ++m) acc[ai][bj][m][n] += bv; }
        bool bad = st1.run(acc, u, wr, wc, fr, fq, lds, wid, lane) || poison != 0u;
        const float qnan = __builtin_nanf("");
#pragma unroll
        for (int ai = 0; ai < 2; ++ai)
#pragma unroll
            for (int m = 0; m < 4; ++m) { const int r = ai * HALF + wr * 64 + m * 16 + fr; const f32x2v sr = S[r]; const size_t off = (size_t)(u.pm * BM + r) * ldc + col0;
#pragma unroll
                for (int bj = 0; bj < 2; ++bj)
#pragma unroll
                    for (int n = 0; n < 2; ++n) { const f32x4 bs = *(const f32x4*)(base + off + bj * HALF + n * 16); acc[ai][bj][m][n] = bs + (acc[ai][bj][m][n] - sr.x) * sr.y; }
                asm volatile("" : "+v"(acc[ai][0][m][0]), "+v"(acc[ai][0][m][1]), "+v"(acc[ai][1][m][0]), "+v"(acc[ai][1][m][1]));
                if (m & 1) asm volatile("" ::: "memory"); }
        const bool bad1 = bad;
        bad = st2.run(acc, u, wr, wc, fr, fq, lds, wid, lane) || bad;
#pragma unroll
        for (int ai = 0; ai < 2; ++ai)
#pragma unroll
            for (int m = 0; m < 4; ++m) { const int r = ai * HALF + wr * 64 + m * 16 + fr; const f32x2v sr = S[r]; const size_t off = (size_t)(u.pm * BM + r) * ldc + col0;
#pragma unroll
                for (int bj = 0; bj < 2; ++bj)
#pragma unroll
                    for (int n = 0; n < 2; ++n) { const f32x4 x1 = acc[ai][bj][m][n]; *(f32x4*)(out + off + bj * HALF + n * 16) = bad1 ? (f32x4){qnan, qnan, qnan, qnan} : x1;
                        const f32x4 o = (x1 - sr.x) * sr.y; u32x2v w; w.x = cvt_pk_bf16(o[0], o[1]); w.y = cvt_pk_bf16(o[2], o[3]);
                        if (bad) { w.x = 0x7fc07fc0u; w.y = 0x7fc07fc0u; } *(u32x2v*)(xn + off + bj * HALF + n * 16) = w; }
                asm volatile("" ::: "memory"); }
    }
};

template <class Epi, class Sched, bool STAMP = false>
__device__ __forceinline__ void gemm_phase(PG8_LAS unsigned char* lds, const Gemm g, const Sched& S, const Epi& E, unsigned long long* stamps) {
    const int tid = threadIdx.x, wid = __builtin_amdgcn_readfirstlane(tid >> 6), lane = tid & 63, wr = wid >> 2, wc = wid & 3, fr = lane & 15, fq = lane >> 4;
    const int K = g.K, nt = K / BK;
    int ts_lo = 0, ts_hi = 0, nts = 0; const unsigned long long rt_entry = STAMP ? (unsigned long long)wall_clock64() : 0ull;
#define PG8_STAMP() do { if (STAMP && wid == 0 && nts < 64) { const unsigned long long _c = (unsigned long long)clock64(); \
        ts_lo = (lane == nts) ? (int)(unsigned)_c : ts_lo; ts_hi = (lane == nts) ? (int)(unsigned)(_c >> 32) : ts_hi; ++nts; } } while (0)
    PG8_STAMP();
    unsigned voffA[2], voffB[2];
#pragma unroll
    for (int i = 0; i < 2; ++i) { int R, C; stage_rc(tid * 16 + i * 8192, R, C); const int Rb = Epi::PERM ? ((R & ~31) + perm32(R & 31)) : R;
        voffA[i] = (unsigned)(R * K + C) * 2u; voffB[i] = (unsigned)(Rb * K + C) * 2u; }
    const size_t kstep = (size_t)(BK * 2);
    const size_t hstep = (size_t)HALF * K * 2;
    const size_t tstep = 2 * hstep;
    const unsigned ldsw = (unsigned)wid * 1024u;
    const int aoff = lds_byte(wr * 64 + fr, fq * 8), boff = lds_byte(wc * 32 + fr, fq * 8);
#define PG8_SA(b, h) (((b) * 2 + (h)) * HTB)
#define PG8_SB(b, h) ((4 + (b) * 2 + (h)) * HTB)
#define PG8_STAGE(bufoff, gbase, voff) do { _Pragma("unroll") for (int _i = 0; _i < 2; ++_i) \
        __builtin_amdgcn_global_load_lds((const unsigned*)((const char*)(gbase) + (voff)[_i]), (PG8_LAS unsigned*)(lds + (bufoff) + ldsw + _i * 8192), 16, 0, 0); } while (0)
#define PG8_LDA(dst, b, h) do { _Pragma("unroll") for (int m = 0; m < 4; ++m) _Pragma("unroll") for (int k = 0; k < 2; ++k) dst[m][k] = *(const PG8_LAS bf16x8*)(lds + PG8_SA(b, h) + aoff + m * 2048 + k * 1024); } while (0)
#define PG8_LDB(dst, b, h) do { _Pragma("unroll") for (int n = 0; n < 2; ++n) _Pragma("unroll") for (int k = 0; k < 2; ++k) dst[n][k] = *(const PG8_LAS bf16x8*)(lds + PG8_SB(b, h) + boff + n * 2048 + k * 1024); } while (0)
#define PG8_MMA(ai, bj, At, Bt) do { __builtin_amdgcn_s_setprio(1); _Pragma("unroll") for (int m = 0; m < 4; ++m) _Pragma("unroll") for (int n = 0; n < 2; ++n) _Pragma("unroll") for (int k = 0; k < 2; ++k) \
        acc[ai][bj][m][n] = __builtin_amdgcn_mfma_f32_16x16x32_bf16(Bt[n][k], At[m][k], acc[ai][bj][m][n], 0, 0, 0); __builtin_amdgcn_s_setprio(0); } while (0)
#define PG8_WAIT_V(n) asm volatile("s_waitcnt vmcnt(" #n ")" ::: "memory")
#define PG8_WAIT_L(n) asm volatile("s_waitcnt lgkmcnt(" #n ")" ::: "memory")
#define PG8_BAR __builtin_amdgcn_s_barrier()
#define PG8_SCHED __builtin_amdgcn_sched_barrier(0)
    Unit cur, nxt; int ui = 0;
    if (!S.next(0, cur)) return;
    f32x4 acc[2][2][4][2];
#pragma unroll
    for (int a = 0; a < 2; ++a)
#pragma unroll
        for (int b = 0; b < 2; ++b)
#pragma unroll
            for (int m = 0; m < 4; ++m)
#pragma unroll
                for (int n = 0; n < 2; ++n) acc[a][b][m][n] = (f32x4){0.f, 0.f, 0.f, 0.f};
    bf16x8 At[4][2], B0[2][2], B1[2][2];
    const char* cA = (const char*)g.A + (size_t)cur.pm * tstep; const char* cB = (const char*)g.Bt + (size_t)cur.pn * tstep;
    S.a_ready(cur);
    PG8_STAGE(PG8_SB(0, 0), cB, voffB); PG8_STAGE(PG8_SA(0, 0), cA, voffA); PG8_STAGE(PG8_SB(0, 1), cB + hstep, voffB); PG8_STAGE(PG8_SA(0, 1), cA + hstep, voffA);
    if (wr == 1) PG8_BAR;
    PG8_WAIT_V(4); PG8_BAR;
    PG8_STAGE(PG8_SB(1, 0), cB + kstep, voffB); PG8_STAGE(PG8_SA(1, 0), cA + kstep, voffA); PG8_STAGE(PG8_SB(1, 1), cB + hstep + kstep, voffB);
    PG8_WAIT_V(6); PG8_BAR;
    PG8_STAMP();
    for (;;) {
        const bool has_next = S.next(ui + 1, nxt);
        const char* nA = has_next ? (const char*)g.A + (size_t)nxt.pm * tstep : cA; const char* nB = has_next ? (const char*)g.Bt + (size_t)nxt.pn * tstep : cB;
        for (int t = 0; t < nt; t += 2) {
            const bool last = (t == nt - 2);
            const char* a1 = cA + (size_t)(t + 1) * kstep;
            const char* a2 = last ? nA : cA + (size_t)(t + 2) * kstep; const char* b2 = last ? nB : cB + (size_t)(t + 2) * kstep;
            const char* a3 = a2 + kstep; const char* b3 = b2 + kstep;
            if (last && has_next) S.a_ready(nxt);
            PG8_LDB(B0, 0, 0); PG8_SCHED; PG8_LDA(At, 0, 0); PG8_STAGE(PG8_SA(1, 1), a1 + hstep, voffA);
            PG8_WAIT_L(8); PG8_BAR; PG8_WAIT_L(0); PG8_MMA(0, 0, At, B0); PG8_BAR; PG8_SCHED;
            PG8_LDB(B1, 0, 1); PG8_STAGE(PG8_SB(0, 0), b2, voffB);
            PG8_BAR; PG8_WAIT_L(0); PG8_MMA(0, 1, At, B1); PG8_BAR;
            PG8_LDA(At, 0, 1); PG8_STAGE(PG8_SA(0, 0), a2, voffA);
            PG8_BAR; PG8_WAIT_L(0); PG8_MMA(1, 0, At, B0); PG8_BAR; PG8_SCHED;
            PG8_STAGE(PG8_SB(0, 1), b2 + hstep, voffB);
            PG8_WAIT_V(6); PG8_BAR; PG8_MMA(1, 1, At, B1); PG8_BAR;
            PG8_LDB(B0, 1, 0); PG8_SCHED; PG8_LDA(At, 1, 0); PG8_STAGE(PG8_SA(0, 1), a2 + hstep, voffA);
            PG8_WAIT_L(8); PG8_BAR; PG8_WAIT_L(0); PG8_MMA(0, 0, At, B0); PG8_BAR; PG8_SCHED;
            PG8_LDB(B1, 1, 1); PG8_STAGE(PG8_SB(1, 0), b3, voffB);
            PG8_BAR; PG8_WAIT_L(0); PG8_MMA(0, 1, At, B1); PG8_BAR;
            PG8_LDA(At, 1, 1); PG8_STAGE(PG8_SA(1, 0), a3, voffA);
            PG8_BAR; PG8_WAIT_L(0); PG8_MMA(1, 0, At, B0); PG8_BAR; PG8_SCHED;
            PG8_STAGE(PG8_SB(1, 1), b3 + hstep, voffB);
            PG8_WAIT_V(6); PG8_BAR; PG8_MMA(1, 1, At, B1); PG8_BAR;
        }
        PG8_STAMP();
        if constexpr (!Epi::AFTER_DRAIN) { E(acc, cur, wr, wc, fr, fq); S.done(cur); }
        PG8_STAMP();
        if (!has_next) break;
#pragma unroll
        for (int a = 0; a < 2; ++a)
#pragma unroll
            for (int b = 0; b < 2; ++b)
#pragma unroll
                for (int m = 0; m < 4; ++m)
#pragma unroll
                    for (int n = 0; n < 2; ++n) acc[a][b][m][n] = (f32x4){0.f, 0.f, 0.f, 0.f};
        cur = nxt; cA = nA; cB = nB; ++ui;
    }
    PG8_WAIT_V(0);
    if (wr == 0) PG8_BAR;
    PG8_BAR;
    if constexpr (Epi::AFTER_DRAIN) { E.fused(acc, cur, wr, wc, fr, fq, lds, wid, lane); S.done(cur); }
    PG8_STAMP();
    if (STAMP && wid == 0) { stamps[lane] = lane < nts ? (((unsigned long long)(unsigned)ts_hi << 32) | (unsigned)ts_lo) : 0ull;
        if (lane == 62) stamps[62] = rt_entry; if (lane == 63) stamps[63] = (unsigned long long)wall_clock64(); }
#undef PG8_STAMP
#undef PG8_SA
#undef PG8_SB
#undef PG8_STAGE
#undef PG8_LDA
#undef PG8_LDB
#undef PG8_MMA
#undef PG8_WAIT_V
#undef PG8_WAIT_L
#undef PG8_BAR
#undef PG8_SCHED
}
}

#define LAS __attribute__((address_space(3)))
typedef unsigned short bf16_t;
typedef short bf16x8 __attribute__((ext_vector_type(8)));
typedef float f32x4 __attribute__((ext_vector_type(4)));
typedef unsigned u32x4 __attribute__((ext_vector_type(4)));
typedef unsigned u32x2 __attribute__((ext_vector_type(2)));
typedef __bf16 bf2_t __attribute__((ext_vector_type(2)));
typedef _Float16 h2_t __attribute__((ext_vector_type(2)));

constexpr int NTOK = 65536, DM = 1024, NTOK_P = 32768;
constexpr int L0 = 8192, L1 = 4096;
constexpr float ALPHA_C = 1.189207115002721f;
constexpr float LN_EPS_C = 1e-5f;
constexpr int NTHREADS = 512;
constexpr int NPHASE = 10;
constexpr int LDS_BYTES = 153600;
constexpr size_t MiB = 1024ull * 1024ull;
constexpr size_t WS_XB = 0;
constexpr size_t WS_PH = 128 * MiB;
constexpr size_t WS_ZT = 320 * MiB;
constexpr size_t WS_U8 = 384 * MiB, WS_V8 = 400 * MiB;
constexpr size_t WS_PARTD = 128 * MiB;
constexpr float U_SCALE = 128.0f, V_SCALE = 16.0f;
constexpr size_t WS_WINT = 448 * MiB, WS_WOUTT = 454 * MiB, WS_WPT = 456 * MiB;
constexpr size_t WS_FG = 460 * MiB;
constexpr size_t WS_PART = 484 * MiB;
constexpr size_t WS_DUMMY = 492 * MiB;
constexpr size_t WS_BAR = 497 * MiB;
constexpr size_t WS_END = 498 * MiB;
constexpr size_t WS_EIDX = 416 * MiB, WS_GATE = 460 * MiB;
constexpr size_t OUT_X0T = 192 * MiB;

struct Params { const float* in[24]; float* out; unsigned char* ws; int ph_lo, ph_hi, nrep, pad; };

__device__ __forceinline__ unsigned pack2bf(float lo, float hi) { return pg8::cvt_pk_bf16(lo, hi); }
__device__ __forceinline__ float bf_lo(unsigned w) { return __uint_as_float(w << 16); }
__device__ __forceinline__ float bf_hi(unsigned w) { return __uint_as_float(w & 0xffff0000u); }
__device__ __forceinline__ unsigned short f2bf(float f) { return (unsigned short)(pack2bf(f, 0.f) & 0xffffu); }

__device__ __forceinline__ void seq_of(int tok0, int& seq, int& L, int& tl) {
    if (tok0 < NTOK_P) { seq = tok0 >> 13; L = L0; tl = tok0 & (L0 - 1); }
    else { const int r = tok0 - NTOK_P; seq = 4 + (r >> 12); L = L1; tl = r & (L1 - 1); }
}
__device__ __forceinline__ size_t seq_base_T(int seq) { return seq < 4 ? (size_t)seq * 512 * L0 : (size_t)4 * 512 * L0 + (size_t)(seq - 4) * 512 * L1; }

struct EpiP {
    static constexpr bool PERM = true, AFTER_DRAIN = false;
    bf16_t* PA; bf16_t* PH; const float* bias;
    __device__ __forceinline__ void operator()(const f32x4 (&acc)[2][2][4][2], const pg8::Unit& u, int wr, int wc, int fr, int fq) const {
        const int row0 = u.pm * 256 + wr * 64 + fr, lc = wc * 32 + 8 * fq;
        if (u.pn >= 2 && u.pn < 6) {
            const int ch0 = (u.pn - 2) * 128 + lc;
            f32x4 bc[2], bh[2];
#pragma unroll
            for (int n = 0; n < 2; ++n) { bc[n] = *(const f32x4*)(bias + 512 + ch0 + 4 * n); bh[n] = *(const f32x4*)(bias + 1024 + ch0 + 4 * n); }
#pragma unroll
            for (int ai = 0; ai < 2; ++ai)
#pragma unroll
                for (int m = 0; m < 4; ++m) { const f32x4 g0 = (acc[ai][0][m][0] + bc[0]) * (acc[ai][1][m][0] + bh[0]), g1 = (acc[ai][0][m][1] + bc[1]) * (acc[ai][1][m][1] + bh[1]);
                    u32x4 w; w.x = pack2bf(g0[0], g0[1]); w.y = pack2bf(g0[2], g0[3]); w.z = pack2bf(g1[0], g1[1]); w.w = pack2bf(g1[2], g1[3]);
                    *(u32x4*)(PA + (size_t)(row0 + ai * 128 + m * 16) * 1024 + 512 + ch0) = w; }
        } else {
            const bool isB = u.pn < 2; bf16_t* base = isB ? PA : PH; const int pitch = isB ? 1024 : 1536;
            const int colt = isB ? u.pn * 256 : u.pn * 256 - 1536, bcol0 = u.pn * 256 + lc;
            f32x4 bv[2][2];
#pragma unroll
            for (int bj = 0; bj < 2; ++bj)
#pragma unroll
                for (int n = 0; n < 2; ++n) bv[bj][n] = *(const f32x4*)(bias + bcol0 + bj * 128 + 4 * n);
#pragma unroll
            for (int ai = 0; ai < 2; ++ai)
#pragma unroll
                for (int m = 0; m < 4; ++m) { bf16_t* rowp = base + (size_t)(row0 + ai * 128 + m * 16) * pitch + colt + lc;
#pragma unroll
                    for (int bj = 0; bj < 2; ++bj) { const f32x4 v0 = acc[ai][bj][m][0] + bv[bj][0], v1 = acc[ai][bj][m][1] + bv[bj][1];
                        u32x4 w; w.x = pack2bf(v0[0], v0[1]); w.y = pack2bf(v0[2], v0[3]); w.z = pack2bf(v1[0], v1[1]); w.w = pack2bf(v1[2], v1[3]);
                        *(u32x4*)(rowp + bj * 128) = w; } }
        }
    }
};
struct EpiH1 {
    static constexpr bool PERM = true, AFTER_DRAIN = false;
    const float* xp; const float* xs; bf16_t* out;
    __device__ __forceinline__ void operator()(const f32x4 (&acc)[2][2][4][2], const pg8::Unit& u, int wr, int wc, int fr, int fq) const {
        const int row0 = u.pm * 256 + wr * 64 + fr, col0 = u.pn * 256 + wc * 32 + 8 * fq;
        const float* xb = (u.pm * 256 < NTOK_P) ? xp : (xs - (size_t)NTOK_P * DM);
#pragma unroll
        for (int ai = 0; ai < 2; ++ai)
#pragma unroll
            for (int m = 0; m < 4; ++m) { const size_t off = (size_t)(row0 + ai * 128 + m * 16) * DM + col0;
#pragma unroll
                for (int bj = 0; bj < 2; ++bj) { const f32x4 x0 = *(const f32x4*)(xb + off + bj * 128), x1 = *(const f32x4*)(xb + off + bj * 128 + 4);
                    const f32x4 v0 = x0 * ALPHA_C + acc[ai][bj][m][0], v1 = x1 * ALPHA_C + acc[ai][bj][m][1];
                    u32x4 w; w.x = pack2bf(v0[0], v0[1]); w.y = pack2bf(v0[2], v0[3]); w.z = pack2bf(v1[0], v1[1]); w.w = pack2bf(v1[2], v1[3]);
                    *(u32x4*)(out + off + bj * 128) = w; } }
    }
};
struct EpiS {
    static constexpr bool PERM = true, AFTER_DRAIN = false;
    unsigned short* S;
    __device__ __forceinline__ void operator()(const f32x4 (&acc)[2][2][4][2], const pg8::Unit& u, int wr, int wc, int fr, int fq) const {
        const int row0 = u.pm * 256 + wr * 64 + fr, col0 = u.pn * 256 + wc * 32 + 8 * fq;
#pragma unroll
        for (int ai = 0; ai < 2; ++ai)
#pragma unroll
            for (int m = 0; m < 4; ++m) { unsigned short* rowp = S + (size_t)(row0 + ai * 128 + m * 16) * 2048 + col0;
#pragma unroll
                for (int bj = 0; bj < 2; ++bj) { const f32x4 v0 = acc[ai][bj][m][0], v1 = acc[ai][bj][m][1];
                    u32x4 w;
                    w.x = __builtin_bit_cast(unsigned, __builtin_amdgcn_cvt_pkrtz(v0[0], v0[1])); w.y = __builtin_bit_cast(unsigned, __builtin_amdgcn_cvt_pkrtz(v0[2], v0[3]));
                    w.z = __builtin_bit_cast(unsigned, __builtin_amdgcn_cvt_pkrtz(v1[0], v1[1])); w.w = __builtin_bit_cast(unsigned, __builtin_amdgcn_cvt_pkrtz(v1[2], v1[3]));
                    *(u32x4*)(rowp + bj * 128) = w; } }
    }
};

__device__ void cvt_f32_bf16(const float* __restrict__ s, bf16_t* __restrict__ d, size_t n8) {
    const size_t q = n8 >> 2;
    for (size_t i = (size_t)blockIdx.x * NTHREADS + threadIdx.x; i < q; i += (size_t)gridDim.x * NTHREADS) {
        float4 a[4], b[4];
#pragma unroll
        for (int k = 0; k < 4; ++k) { const f32x4 ta = __builtin_nontemporal_load((const f32x4*)s + 2 * (i + k * q)), tb = __builtin_nontemporal_load((const f32x4*)s + 2 * (i + k * q) + 1);
            a[k] = make_float4(ta[0], ta[1], ta[2], ta[3]); b[k] = make_float4(tb[0], tb[1], tb[2], tb[3]); }
#pragma unroll
        for (int k = 0; k < 4; ++k) { u32x4 w; w.x = pack2bf(a[k].x, a[k].y); w.y = pack2bf(a[k].z, a[k].w); w.z = pack2bf(b[k].x, b[k].y); w.w = pack2bf(b[k].z, b[k].w);
            ((u32x4*)d)[i + k * q] = w; }
    }
}
__device__ __forceinline__ unsigned pack4fp8(float a, float b, float c, float d) { int p = 0; p = __builtin_amdgcn_cvt_pk_fp8_f32(a, b, p, false); p = __builtin_amdgcn_cvt_pk_fp8_f32(c, d, p, true); return (unsigned)p; }
__device__ void cvt_f32_fp8(const float* __restrict__ s, unsigned char* __restrict__ d, size_t n16, float sc) {
    const size_t h = n16 >> 1;
    for (size_t i0 = (size_t)blockIdx.x * NTHREADS + threadIdx.x; i0 < h; i0 += (size_t)gridDim.x * NTHREADS) {
        float4 v[2][4];
#pragma unroll
        for (int k = 0; k < 2; ++k)
#pragma unroll
            for (int j = 0; j < 4; ++j) { const f32x4 t = __builtin_nontemporal_load((const f32x4*)s + 4 * (i0 + k * h) + j); v[k][j] = make_float4(t[0], t[1], t[2], t[3]); }
#pragma unroll
        for (int k = 0; k < 2; ++k) { const size_t i = i0 + k * h; const float4 a = v[k][0], b = v[k][1], c = v[k][2], e = v[k][3];
            u32x4 w; w.x = pack4fp8(a.x * sc, a.y * sc, a.z * sc, a.w * sc); w.y = pack4fp8(b.x * sc, b.y * sc, b.z * sc, b.w * sc); w.z = pack4fp8(c.x * sc, c.y * sc, c.z * sc, c.w * sc); w.w = pack4fp8(e.x * sc, e.y * sc, e.z * sc, e.w * sc);
            const size_t er = i >> 6, kk = i & 63;
            *(u32x4*)(d + ((kk >> 3) * 16384 + er) * 128 + (kk & 7) * 16) = w; }
    }
}
__device__ __forceinline__ int win_perm(int c) { if (c < 512 || c >= 1536) return c; const int ch = (c - 512) & 511, hsel = (c >= 1024) ? 128 : 0; return 512 + (ch >> 7) * 256 + hsel + (ch & 127); }
template <bool PERM_WIN>
__device__ void transpose_cvt(const float* __restrict__ src, int R, int C, bf16_t* __restrict__ dst, float* tile  ) {
    const int tid = threadIdx.x, nct = C / 64, nu = (R / 64) * nct;
    for (int u = blockIdx.x; u < nu; u += gridDim.x) {
        const int r0 = (u / nct) * 64, c0 = (u % nct) * 64;
        { const int r = tid >> 3, c8 = (tid & 7) * 8; const float4 a = *(const float4*)(src + (size_t)(r0 + r) * C + c0 + c8), b = *(const float4*)(src + (size_t)(r0 + r) * C + c0 + c8 + 4);
          float* t = tile + r * 65 + c8; t[0] = a.x; t[1] = a.y; t[2] = a.z; t[3] = a.w; t[4] = b.x; t[5] = b.y; t[6] = b.z; t[7] = b.w; }
        __syncthreads();
        { const int c = tid >> 3, r8 = (tid & 7) * 8; float v[8];
#pragma unroll
          for (int k = 0; k < 8; ++k) v[k] = tile[(r8 + k) * 65 + c];
          u32x4 w; w.x = pack2bf(v[0], v[1]); w.y = pack2bf(v[2], v[3]); w.z = pack2bf(v[4], v[5]); w.w = pack2bf(v[6], v[7]);
          *(u32x4*)(dst + (size_t)(PERM_WIN ? win_perm(c0 + c) : (c0 + c)) * R + r0 + r8) = w; }
        __syncthreads();
    }
}
__device__ void fold_wq_keys(const float* __restrict__ wq, const float* __restrict__ keys, bf16_t* __restrict__ WpT, float* lds) {
    float* sk = lds; float* sw = lds + 64 * 132;
    const int tid = threadIdx.x;
    for (int u = blockIdx.x; u < 512; u += gridDim.x) {
        const int hp = u >> 5, n0 = ((u >> 4) & 1) * 64, d0 = (u & 15) * 64;
        for (int i = tid; i < 64 * 32; i += NTHREADS) { const int r = i >> 5, k4 = (i & 31) * 4;
            const float4 a = *(const float4*)(keys + ((size_t)hp * 128 + n0 + r) * 128 + k4); float* t = sk + r * 132 + k4; t[0] = a.x; t[1] = a.y; t[2] = a.z; t[3] = a.w;
            const float4 b = *(const float4*)(wq + (size_t)(d0 + r) * 2048 + hp * 128 + k4); float* s = sw + r * 132 + k4; s[0] = b.x; s[1] = b.y; s[2] = b.z; s[3] = b.w; }
        __syncthreads();
        const int ni = tid >> 3, dj = tid & 7; float acc[8];
#pragma unroll
        for (int q = 0; q < 8; ++q) acc[q] = 0.f;
        for (int k = 0; k < 128; ++k) { const float a = sk[ni * 132 + k];
#pragma unroll
            for (int q = 0; q < 8; ++q) acc[q] += a * sw[(dj + 8 * q) * 132 + k]; }
#pragma unroll
        for (int q = 0; q < 8; ++q) WpT[((size_t)hp * 128 + n0 + ni) * 1024 + d0 + dj + 8 * q] = f2bf(acc[q]);
        __syncthreads();
    }
}
__device__ void hyena_filter_gen(const Params& p, float* lds) {
    const float* w1 = p.in[7]; const float* b1 = p.in[8]; const float* fr = p.in[9]; const float* w2 = p.in[10]; const float* b2 = p.in[11]; const float* w3 = p.in[12]; const float* dec = p.in[13];
    bf16_t* Fg = (bf16_t*)(p.ws + WS_FG); float* part = (float*)(p.ws + WS_PART);
    constexpr int NG = 3, NP = NG * 16;
    float* sfeat = lds; float* sh1 = sfeat + NP * 33; float* sh2 = sh1 + NP * 64;
    float* sw1 = sh2 + NP * 64; float* sw2 = sw1 + 33 * 64; float* sb1 = sw2 + 64 * 64; float* sb2 = sb1 + 64; float* sfr = sb2 + 64;
    const int tid = threadIdx.x, c = tid;
    for (int i = tid; i < 33 * 64; i += NTHREADS) sw1[i] = w1[i];
    for (int i = tid; i < 64 * 64; i += NTHREADS) sw2[i] = w2[i];
    if (tid < 64) { sb1[tid] = b1[tid]; sb2[tid] = b2[tid]; sfr[tid] = fr[tid]; }
    for (int idx = tid; idx < NP * 33; idx += NTHREADS) { const int q = idx / 33, f = idx % 33, it = (int)blockIdx.x + (q >> 4) * (int)gridDim.x;
        const int variant = it >= 512, L = variant ? L1 : L0, n = (variant ? it - 512 : it) * 16 + (q & 15); float val;
        if (f == 0) val = (float)n * (1.0f / (float)(L - 1));
        else { const int band = (f - 1) & 15; const float fj = 1e-4f + (float)band * ((15.0f - 1e-4f) / 15.0f); const float w = 6.283185307179586f * (float)n / (float)L; const float arg = fj * w;
               val = (f - 1) >= 16 ? -sinf(arg) : cosf(arg); }
        sfeat[idx] = val; }
    __syncthreads();
    for (int idx = tid; idx < NP * 64; idx += NTHREADS) { const int q = idx >> 6, j = idx & 63; float s = sb1[j];
#pragma unroll
        for (int f = 0; f < 33; ++f) s += sfeat[q * 33 + f] * sw1[f * 64 + j];
        sh1[idx] = sinf(sfr[j] * s); }
    __syncthreads();
    for (int idx = tid; idx < NP * 64; idx += NTHREADS) { const int q = idx >> 6, j = idx & 63; float s = sb2[j];
#pragma unroll 16
        for (int i = 0; i < 64; ++i) s += sh1[q * 64 + i] * sw2[i * 64 + j];
        sh2[idx] = sinf(sfr[j] * s); }
    __syncthreads();
    float acc0[NP], acc1[NP];
#pragma unroll
    for (int q = 0; q < NP; ++q) { acc0[q] = 0.f; acc1[q] = 0.f; }
#pragma unroll 2
    for (int j = 0; j < 64; ++j) { const float wa = w3[j * 1024 + c], wb = w3[j * 1024 + 512 + c];
#pragma unroll
        for (int q = 0; q < NP; ++q) { const float h = sh2[q * 64 + j]; acc0[q] += h * wa; acc1[q] += h * wb; } }
    const float a0 = fabsf(dec[c]), a1 = fabsf(dec[512 + c]);
    float sum0 = 0.f, sum1 = 0.f;
#pragma unroll
    for (int g = 0; g < NG; ++g) { const int it = (int)blockIdx.x + g * (int)gridDim.x;
        if (it < 768) { const int variant = it >= 512, L = variant ? L1 : L0, n0 = (variant ? it - 512 : it) * 16; const float tstep = 1.0f / (float)(L - 1);
            bf16_t* Fc = Fg + (variant ? (size_t)512 * 2 * L0 : 0) + (size_t)c * 2 * L; float s = 0.f;
#pragma unroll
            for (int pp = 0; pp < 16; ++pp) { const int n = n0 + pp; const float t = (float)n * tstep;
                const float v0 = acc0[g * 16 + pp] * expf(-t * a0), v1 = acc1[g * 16 + pp] * expf(-t * a1);
                s += fabsf(v0); Fc[L - n] = f2bf(v0);
                if (n >= 1) { s += fabsf(v1); Fc[L + n] = f2bf(v1); } else Fc[0] = 0; }
            if (variant) sum1 += s; else sum0 += s; } }
    part[((size_t)0 * 1024 + blockIdx.x) * 512 + c] = sum0;
    part[((size_t)1 * 1024 + blockIdx.x) * 512 + c] = sum1;
    __syncthreads();
}

__device__ __forceinline__ void unpack8(const u32x4 w, float (&f)[8]) { f[0] = bf_lo(w.x); f[1] = bf_hi(w.x); f[2] = bf_lo(w.y); f[3] = bf_hi(w.y); f[4] = bf_lo(w.z); f[5] = bf_hi(w.z); f[6] = bf_lo(w.w); f[7] = bf_hi(w.w); }
__device__ void phase_conv3(const Params& p, unsigned char* lds) {
    const bf16_t* PA = (const bf16_t*)p.out; const bf16_t* PH = (const bf16_t*)(p.ws + WS_PH);
    bf16_t* Ycat = (bf16_t*)(p.ws + WS_XB); bf16_t* zT = (bf16_t*)(p.ws + WS_ZT); bf16_t* x0T = (bf16_t*)((unsigned char*)p.out + OUT_X0T);
    const float* acw = p.in[4]; const float* hcw = p.in[5]; const float* hcb = p.in[6];
    bf16_t* sx0 = (bf16_t*)lds; bf16_t* sz = sx0 + 64 * 66;
    const int tid = threadIdx.x, r = tid >> 3, cg8 = tid & 7;
    const int ct = blockIdx.x & 7, c0 = ct * 64 + cg8 * 8;
    for (int tt = blockIdx.x >> 3; tt < 1024; tt += gridDim.x >> 3) {
        const int tok0 = tt * 64; int seq, L, tl; seq_of(tok0, seq, L, tl);
        const int tok = tok0 + r, pos = tl + r;
        const bool hp = pos > 0, hn = pos < L - 1;
        const u32x4 zero4 = {0u, 0u, 0u, 0u};
        { const bf16_t* row = PA + (size_t)tok * 1024 + c0;
          float ab[8], gc[8], gp[8], gn[8];
          unpack8(*(const u32x4*)row, ab); unpack8(*(const u32x4*)(row + 512), gc);
          unpack8(hp ? *(const u32x4*)(row - 1024 + 512) : zero4, gp); unpack8(hn ? *(const u32x4*)(row + 1024 + 512) : zero4, gn);
          float y[8];
#pragma unroll
          for (int k = 0; k < 8; ++k) y[k] = ab[k] * (acw[c0 + k] * gp[k] + acw[512 + c0 + k] * gc[k] + acw[1024 + c0 + k] * gn[k]);
          u32x4 w; w.x = pack2bf(y[0], y[1]); w.y = pack2bf(y[2], y[3]); w.z = pack2bf(y[4], y[5]); w.w = pack2bf(y[6], y[7]);
          *(u32x4*)(Ycat + (size_t)tok * DM + c0) = w; }
        { const bf16_t* row = PH + (size_t)tok * 1536 + c0; float hy[3][8];
#pragma unroll
          for (int part = 0; part < 3; ++part) { float vp[8], vc[8], vn[8]; const bf16_t* rp = row + part * 512; const int cc = part * 512 + c0;
              unpack8(*(const u32x4*)rp, vc); unpack8(hp ? *(const u32x4*)(rp - 1536) : zero4, vp); unpack8(hn ? *(const u32x4*)(rp + 1536) : zero4, vn);
#pragma unroll
              for (int k = 0; k < 8; ++k) hy[part][k] = hcw[cc + k] * vp[k] + hcw[1536 + cc + k] * vc[k] + hcw[3072 + cc + k] * vn[k] + hcb[cc + k]; }
#pragma unroll
          for (int k = 0; k < 8; ++k) { sx0[(cg8 * 8 + k) * 66 + r] = f2bf(hy[0][k]); sz[(cg8 * 8 + k) * 66 + r] = f2bf(hy[2][k] * hy[1][k]); } }
        __syncthreads();
        { const int c = tid >> 3, ch = tid & 7; const unsigned* s0 = (const unsigned*)(sx0 + c * 66 + ch * 8); const unsigned* s1 = (const unsigned*)(sz + c * 66 + ch * 8);
          u32x4 w0 = {s0[0], s0[1], s0[2], s0[3]}, w1 = {s1[0], s1[1], s1[2], s1[3]};
          const size_t o = seq_base_T(seq) + (size_t)(ct * 64 + c) * L + tl + ch * 8;
          *(u32x4*)(x0T + o) = w0; *(u32x4*)(zT + o) = w1; }
        __syncthreads();
    }
}

__device__ void phase_longconv(const Params& p, unsigned char* ldsg) {
    LAS unsigned char* lds = (LAS unsigned char*)ldsg;
    const bf16_t* Fg = (const bf16_t*)(p.ws + WS_FG); const float* part = (const float*)(p.ws + WS_PART);
    const bf16_t* zT = (const bf16_t*)(p.ws + WS_ZT); const bf16_t* x0T = (const bf16_t*)((const unsigned char*)p.out + OUT_X0T);
    bf16_t* yhT = (bf16_t*)(p.ws + WS_PH); const float* hyb = p.in[14];
    constexpr int ZSTR = 160, F1OFF = 32768 + 64, ZOFF = 65664, ZERO = ZOFF + 4 * 128 * ZSTR, SCAL = ZERO + 176;
    const int tid = threadIdx.x, wave = __builtin_amdgcn_readfirstlane(tid >> 6), lane = tid & 63, n = lane & 15, kq = lane >> 4;
    for (int u = blockIdx.x; u < 1024; u += gridDim.x) {
        const int variant = u >= 512, c = u & 511, L = variant ? L1 : L0, nb = L >> 6, nseq = variant ? 8 : 4;
        const bf16_t* Fc = Fg + (variant ? (size_t)512 * 2 * L0 : 0) + (size_t)c * 2 * L;
        for (int i = tid; i < (2 * L) / 8; i += NTHREADS) *(LAS u32x4*)(lds + i * 16) = ((const u32x4*)Fc)[i];
        for (int i = tid; i < nseq * (L / 8); i += NTHREADS) { const int b = i / (L / 8), q = i % (L / 8);
            const int seq = variant ? 4 + b : b;
            *(LAS u32x4*)(lds + ZOFF + (b * nb + (q >> 3)) * ZSTR + (q & 7) * 16) = *(const u32x4*)(zT + seq_base_T(seq) + (size_t)c * L + q * 8); }
        if (tid < 36) *(LAS unsigned*)(lds + ZERO + tid * 4) = 0u;
        if (wave == 0) { float s = 0.f; for (int b = lane; b < (int)gridDim.x; b += 64) s += part[((size_t)variant * 1024 + b) * 512 + c];
#pragma unroll
            for (int o = 32; o >= 1; o >>= 1) s += __shfl_xor(s, o);
            if (lane == 0) *(LAS float*)(lds + SCAL) = 1.0f / s; }
        __syncthreads();
        for (int i = tid; i < L; i += NTHREADS) { const unsigned a = *(LAS unsigned*)(lds + i * 4); const unsigned b = (i + 1 < L) ? *(LAS unsigned*)(lds + i * 4 + 4) : 0u;
            *(LAS unsigned*)(lds + F1OFF + i * 4) = (a >> 16) | (b << 16); }
        __syncthreads();
        const float inv = *(LAS float*)(lds + SCAL);
        const int jt = variant ? (wave & 3) : wave, bbase = variant ? 4 * (wave >> 2) : 0, Jc = 16 * jt + n;
        f32x4 acc[4][4];
#pragma unroll
        for (int mi = 0; mi < 4; ++mi)
#pragma unroll
            for (int nt = 0; nt < 4; ++nt) acc[mi][nt] = (f32x4){0.f, 0.f, 0.f, 0.f};
        const int cl = ((n & 1) ? F1OFF - 2 : 0) + 2 * (L + 8 * kq - n);
        const int zrow = ZOFF + bbase * nb * ZSTR + kq * 16, zseq = nb * ZSTR;
        const int dbeg = 16 * jt - (nb - 1), dend = 16 * jt + 15, zzero = ZERO + kq * 16;
#define LC_LOAD(A_, B_, dd) do { const int d_ = min((dd), dend); const int abase_ = cl - 128 * d_; \
            _Pragma("unroll") for (int ai = 0; ai < 6; ++ai) { const LAS unsigned* fp = (const LAS unsigned*)(lds + abase_ - 32 * (ai - 2)); const u32x4 w_ = {fp[0], fp[1], fp[2], fp[3]}; A_[ai] = __builtin_bit_cast(bf16x8, w_); } \
            const int blk_ = Jc - d_; const bool bv_ = (unsigned)blk_ < (unsigned)nb; \
            _Pragma("unroll") for (int nt = 0; nt < 4; ++nt) { const int ad_ = bv_ ? zrow + nt * zseq + blk_ * ZSTR : zzero; \
                B_[2 * nt] = *(const LAS bf16x8*)(lds + ad_); B_[2 * nt + 1] = *(const LAS bf16x8*)(lds + ad_ + 64); } } while (0)
#define LC_MMA(A_, B_) do { __builtin_amdgcn_s_setprio(1); \
            _Pragma("unroll") for (int nt = 0; nt < 4; ++nt) _Pragma("unroll") for (int mi = 0; mi < 4; ++mi) { \
                acc[mi][nt] = __builtin_amdgcn_mfma_f32_16x16x32_bf16(A_[mi + 2], B_[2 * nt], acc[mi][nt], 0, 0, 0); \
                acc[mi][nt] = __builtin_amdgcn_mfma_f32_16x16x32_bf16(A_[mi], B_[2 * nt + 1], acc[mi][nt], 0, 0, 0); } \
            __builtin_amdgcn_s_setprio(0); } while (0)
        bf16x8 aX[6], bX[8], aY[6], bY[8];
        LC_LOAD(aX, bX, dbeg);
        for (int d = dbeg; d <= dend; d += 2) {
            LC_LOAD(aY, bY, d + 1);
            LC_MMA(aX, bX);
            LC_LOAD(aX, bX, d + 2);
            if (d + 1 <= dend) LC_MMA(aY, bY);
        }
#undef LC_LOAD
#undef LC_MMA
        const float hb = hyb[c];
#pragma unroll
        for (int nt = 0; nt < 4; ++nt) { const int b = bbase + nt, seq = variant ? 4 + b : b; const size_t gbase = seq_base_T(seq) + (size_t)c * L; const int J = Jc;
#pragma unroll
            for (int mi = 0; mi < 4; ++mi) { const int i0 = 16 * mi + 4 * kq; const size_t o = gbase + (size_t)J * 64 + i0;
                const u32x2 zw = *(const LAS u32x2*)(lds + ZOFF + (b * nb + J) * ZSTR + i0 * 2); const u32x2 xw = *(const u32x2*)(x0T + o);
                const f32x4 v = acc[mi][nt];
                const float y0 = bf_lo(xw.x) * (v[0] * inv + hb * bf_lo(zw.x)), y1 = bf_hi(xw.x) * (v[1] * inv + hb * bf_hi(zw.x));
                const float y2 = bf_lo(xw.y) * (v[2] * inv + hb * bf_lo(zw.y)), y3 = bf_hi(xw.y) * (v[3] * inv + hb * bf_hi(zw.y));
                u32x2 w; w.x = pack2bf(y0, y1); w.y = pack2bf(y2, y3); *(u32x2*)(yhT + o) = w; } }
        __syncthreads();
    }
}

__device__ void phase_yh_transpose(const Params& p, unsigned char* lds) {
    const bf16_t* yhT = (const bf16_t*)(p.ws + WS_PH); bf16_t* Ycat = (bf16_t*)(p.ws + WS_XB);
    bf16_t* st = (bf16_t*)lds; const int tid = threadIdx.x;
    for (int u = blockIdx.x; u < 8192; u += gridDim.x) {
        const int tt = u >> 3, ct = u & 7, tok0 = tt * 64; int seq, L, tl; seq_of(tok0, seq, L, tl);
        { const int c = tid >> 3, ch = tid & 7; const u32x4 w = *(const u32x4*)(yhT + seq_base_T(seq) + (size_t)(ct * 64 + c) * L + tl + ch * 8);
          unsigned* s = (unsigned*)(st + c * 66 + ch * 8); s[0] = w.x; s[1] = w.y; s[2] = w.z; s[3] = w.w; }
        __syncthreads();
        { const int r = tid >> 3, cg8 = tid & 7; unsigned short v[8];
#pragma unroll
          for (int k = 0; k < 8; ++k) v[k] = st[(cg8 * 8 + k) * 66 + r];
          u32x4 w; w.x = v[0] | ((unsigned)v[1] << 16); w.y = v[2] | ((unsigned)v[3] << 16); w.z = v[4] | ((unsigned)v[5] << 16); w.w = v[6] | ((unsigned)v[7] << 16);
          *(u32x4*)(Ycat + (size_t)(tok0 + r) * DM + 512 + ct * 64 + cg8 * 8) = w; }
        __syncthreads();
    }
}

template <bool OUT_BF16>
__device__ __forceinline__ void ln_rows2(const bf16_t* __restrict__ hin, float* __restrict__ outf, bf16_t* __restrict__ outb, const float* __restrict__ g, const float* __restrict__ be, int row_lo, int row_hi, int wv0, int nwv) {
    const int lane = threadIdx.x & 63;
    for (int row = row_lo + wv0 * 2; row < row_hi; row += nwv * 2) {
        float4 v[2][4]; float s[2] = {0.f, 0.f};
#pragma unroll
        for (int r = 0; r < 2; ++r)
#pragma unroll
            for (int k = 0; k < 4; ++k) { const u32x2 w = ((const u32x2*)(hin + (size_t)(row + r) * DM))[lane + 64 * k]; v[r][k] = make_float4(bf_lo(w.x), bf_hi(w.x), bf_lo(w.y), bf_hi(w.y)); }
#pragma unroll
        for (int r = 0; r < 2; ++r)
#pragma unroll
            for (int k = 0; k < 4; ++k) s[r] += (v[r][k].x + v[r][k].y) + (v[r][k].z + v[r][k].w);
#pragma unroll
        for (int o = 32; o >= 1; o >>= 1) { s[0] += __shfl_xor(s[0], o); s[1] += __shfl_xor(s[1], o); }
        float q[2] = {0.f, 0.f}; const float mu[2] = {s[0] * (1.0f / DM), s[1] * (1.0f / DM)};
#pragma unroll
        for (int r = 0; r < 2; ++r)
#pragma unroll
            for (int k = 0; k < 4; ++k) { const float a = v[r][k].x - mu[r], b = v[r][k].y - mu[r], c = v[r][k].z - mu[r], d = v[r][k].w - mu[r]; q[r] += (a * a + b * b) + (c * c + d * d); }
#pragma unroll
        for (int o = 32; o >= 1; o >>= 1) { q[0] += __shfl_xor(q[0], o); q[1] += __shfl_xor(q[1], o); }
        const float rstd[2] = {1.0f / sqrtf(q[0] * (1.0f / DM) + LN_EPS_C), 1.0f / sqrtf(q[1] * (1.0f / DM) + LN_EPS_C)};
#pragma unroll
        for (int k = 0; k < 4; ++k) { const float4 gg = ((const float4*)g)[lane + 64 * k], bb = ((const float4*)be)[lane + 64 * k];
#pragma unroll
            for (int r = 0; r < 2; ++r) { float4 y;
                y.x = (v[r][k].x - mu[r]) * rstd[r] * gg.x + bb.x; y.y = (v[r][k].y - mu[r]) * rstd[r] * gg.y + bb.y; y.z = (v[r][k].z - mu[r]) * rstd[r] * gg.z + bb.z; y.w = (v[r][k].w - mu[r]) * rstd[r] * gg.w + bb.w;
                if (OUT_BF16) { u32x2 w; w.x = pack2bf(y.x, y.y); w.y = pack2bf(y.z, y.w); ((u32x2*)(outb + (size_t)(row + r) * DM))[lane + 64 * k] = w; }
                else { const f32x4 yv = {y.x, y.y, y.z, y.w}; __builtin_nontemporal_store(yv, (f32x4*)(outf + (size_t)(row + r) * DM) + lane + 64 * k); } } }
    }
}
__device__ void phase_ln1_panel(const Params& p, int pm) { ln_rows2<true>((const bf16_t*)p.out, nullptr, (bf16_t*)(p.ws + WS_XB), p.in[16], p.in[17], pm * 256, pm * 256 + 256, threadIdx.x >> 6, 8); }

__device__ __forceinline__ int f2key(float f) { const int b = __float_as_int(f); return b ^ ((b >> 31) & 0x7fffffff); }
__device__ __forceinline__ float key2f(int k) { return __int_as_float(k ^ ((k >> 31) & 0x7fffffff)); }
__device__ __forceinline__ void sort16_desc(int (&k)[16]) {
    constexpr int PI[63] = {0,2,0,1,1,4,6,4,5,5,0,2,2,1,3,3,1,3,5,8,10,8,9,9,12,14,12,13,13,8,10,10,9,11,11,9,11,13,0,4,4,2,6,6,2,6,10,1,5,5,3,7,7,3,7,11,1,3,5,7,9,11,13};
    constexpr int PJ[63] = {1,3,2,3,2,5,7,6,7,6,4,6,4,5,7,5,2,4,6,9,11,10,11,10,13,15,14,15,14,12,14,12,13,15,13,10,12,14,8,12,8,10,14,10,4,8,12,9,13,9,11,15,11,5,9,13,2,4,6,8,10,12,14};
#pragma unroll
    for (int e = 0; e < 63; ++e) { const int hi = max(k[PI[e]], k[PJ[e]]), lo = min(k[PI[e]], k[PJ[e]]); k[PI[e]] = hi; k[PJ[e]] = lo; }
}
__device__ __forceinline__ void merge_top16(int (&a)[16], const int (&b)[16]) {
#pragma unroll
    for (int i = 0; i < 16; ++i) a[i] = max(a[i], b[15 - i]);
#pragma unroll
    for (int j = 8; j > 0; j >>= 1)
#pragma unroll
        for (int i = 0; i < 16; ++i) { const int l = i ^ j; if (l > i) { const int hi = max(a[i], a[l]), lo = min(a[i], a[l]); a[i] = hi; a[l] = lo; } }
}
__device__ __forceinline__ void chunk_keys(const u32x4 w0, const u32x4 w1, int idx0, int (&k)[16]) {
    const unsigned ww[8] = {w0.x, w0.y, w0.z, w0.w, w1.x, w1.y, w1.z, w1.w};
#pragma unroll
    for (int e = 0; e < 8; ++e) { const h2_t h = __builtin_bit_cast(h2_t, ww[e]);
        k[2 * e] = (f2key((float)h.x) & ~0x7F) | (idx0 + 2 * e); k[2 * e + 1] = (f2key((float)h.y) & ~0x7F) | (idx0 + 2 * e + 1); }
}
__device__ __forceinline__ void row_top16(const unsigned short* __restrict__ row, int (&run)[16]) {
    const u32x4* rp = (const u32x4*)row;
    u32x4 w0 = rp[0], w1 = rp[1];
    chunk_keys(w0, w1, 0, run); sort16_desc(run);
    w0 = rp[2]; w1 = rp[3];
#pragma unroll 1
    for (int ch = 1; ch < 8; ++ch) {
        int k[16]; chunk_keys(w0, w1, ch * 16, k);
        if (ch < 7) { w0 = rp[2 * ch + 2]; w1 = rp[2 * ch + 3]; }
        sort16_desc(k); merge_top16(run, k);
    }
}
__device__ __forceinline__ void row_top16_lds(const LAS unsigned char* rowp, int (&run)[16]) {
    const LAS u32x4* rp = (const LAS u32x4*)rowp;
    chunk_keys(rp[0], rp[1], 0, run); sort16_desc(run);
#pragma unroll 1
    for (int ch = 1; ch < 8; ++ch) { int k[16]; chunk_keys(rp[2 * ch], rp[2 * ch + 1], ch * 16, k); sort16_desc(k); merge_top16(run, k); }
}
__device__ void phase_topk(const Params& p, unsigned char* ldsg, int gt_lo, int gt_hi, int gt_stride) {
    const unsigned short* S = (const unsigned short*)(p.ws + WS_PH);
    int* eidx = (int*)(p.ws + WS_EIDX); float* gate = (float*)(p.ws + WS_GATE);
    const int wave = threadIdx.x >> 6, lane = threadIdx.x & 63;
    LAS unsigned char* wb = (LAS unsigned char*)ldsg + wave * 17408;
    LAS int* sl = (LAS int*)wb + lane * 33;
    constexpr int OFF[16] = {0, 16, 24, 29, 33, 36, 38, 40, 42, 43, 44, 45, 46, 47, 48, 49};
    for (int gt = gt_lo + threadIdx.x; gt < gt_hi; gt += gt_stride) {
        const int t0 = (gt - lane) >> 3;
        int a[16], b[16];
#pragma unroll
        for (int pp = 0; pp < 2; ++pp) {
            u32x4 v[16];
#pragma unroll
            for (int i = 0; i < 16; ++i) { const int q = i * 64 + lane, rowid = q >> 4, within = q & 15;
                v[i] = *(const u32x4*)(S + (size_t)(t0 + (rowid >> 3)) * 2048 + ((rowid & 7) * 2 + pp) * 128 + within * 8); }
#pragma unroll
            for (int i = 0; i < 16; ++i) { const int q = i * 64 + lane, rowid = q >> 4, within = q & 15; *(LAS u32x4*)(wb + rowid * 272 + within * 16) = v[i]; }
            if (pp == 0) row_top16_lds(wb + lane * 272, a); else row_top16_lds(wb + lane * 272, b);
        }
#pragma unroll
        for (int i = 0; i < 16; ++i) { sl[i] = a[i]; sl[16 + i] = b[i]; }
        float va[16], vb[16];
#pragma unroll
        for (int i = 0; i < 16; ++i) { va[i] = key2f(a[i] & ~0x7F); vb[i] = key2f(b[i] & ~0x7F); }
        int cnd[4][16];
#pragma unroll
        for (int q = 0; q < 4; ++q)
#pragma unroll
            for (int i = 0; i < 16; ++i) cnd[q][i] = (int)0x80000000;
#pragma unroll
        for (int i = 0; i < 16; ++i)
#pragma unroll
            for (int j = 0; j < 16 / (i + 1); ++j) { const int pos = OFF[i] + j; cnd[pos >> 4][pos & 15] = (f2key(va[i] + vb[j]) & ~0xFF) | (i * 16 + j); }
        sort16_desc(cnd[0]); sort16_desc(cnd[1]); sort16_desc(cnd[2]); sort16_desc(cnd[3]);
        merge_top16(cnd[0], cnd[1]); merge_top16(cnd[2], cnd[3]); merge_top16(cnd[0], cnd[2]);
        float best[16]; int ei[16]; float m = -3.0e38f;
#pragma unroll
        for (int r = 0; r < 16; ++r) { const int code = cnd[0][r] & 0xFF; const int ka = sl[code >> 4], kb = sl[16 + (code & 15)];
            ei[r] = (ka & 0x7F) * 128 + (kb & 0x7F); best[r] = key2f(ka & ~0x7F) + key2f(kb & ~0x7F); m = fmaxf(m, best[r]); }
        float se = 0.f;
#pragma unroll
        for (int r = 0; r < 16; ++r) { best[r] = __expf(best[r] - m); se += best[r]; }
        const float inv = 1.0f / se;
#pragma unroll
        for (int q = 0; q < 4; ++q) { ((int4*)(eidx + (size_t)gt * 16))[q] = make_int4(ei[4 * q], ei[4 * q + 1], ei[4 * q + 2], ei[4 * q + 3]);
            ((float4*)(gate + (size_t)gt * 16))[q] = make_float4(best[4 * q] * inv, best[4 * q + 1] * inv, best[4 * q + 2] * inv, best[4 * q + 3] * inv); }
    }
}

typedef float f32x2 __attribute__((ext_vector_type(2)));
template <int CTRL> __device__ __forceinline__ float dpp_f(float v) { return __int_as_float(__builtin_amdgcn_update_dpp(0, __float_as_int(v), CTRL, 0xF, 0xF, false)); }
__device__ __forceinline__ void pk_load_ev(int (&ev)[16], const int* __restrict__ eidx, int tok, int q) {
    const int4* ep = (const int4*)(eidx + (size_t)tok * 128 + 16 * q);
#pragma unroll
    for (int k = 0; k < 4; ++k) { const int4 t = ep[k]; ev[4 * k] = t.x; ev[4 * k + 1] = t.y; ev[4 * k + 2] = t.z; ev[4 * k + 3] = t.w; }
}
__device__ __forceinline__ void pk_load_rows(u32x4 (&r)[16], const int (&ev)[16], const unsigned char* __restrict__ tab, unsigned loff) {
#pragma unroll
    for (int s = 0; s < 16; ++s) r[s] = *(const u32x4*)(tab + ((unsigned)ev[s] * 128u + loff));
}
__device__ __forceinline__ void pk_load_x(f32x2 (&xv)[8], const bf16_t* __restrict__ xrow) {
    const u32x4 a = ((const u32x4*)xrow)[0], b = ((const u32x4*)xrow)[1];
    xv[0] = (f32x2){bf_lo(a.x), bf_hi(a.x)}; xv[1] = (f32x2){bf_lo(a.y), bf_hi(a.y)}; xv[2] = (f32x2){bf_lo(a.z), bf_hi(a.z)}; xv[3] = (f32x2){bf_lo(a.w), bf_hi(a.w)};
    xv[4] = (f32x2){bf_lo(b.x), bf_hi(b.x)}; xv[5] = (f32x2){bf_lo(b.y), bf_hi(b.y)}; xv[6] = (f32x2){bf_lo(b.z), bf_hi(b.z)}; xv[7] = (f32x2){bf_lo(b.w), bf_hi(b.w)};
}
__device__ __forceinline__ float xchg4(float v) { return dpp_f<0x1B>(dpp_f<0x141>(v)); }
__device__ __forceinline__ void pk_u_compute(const u32x4 (&r)[16], const f32x2 (&xv)[8], bf16_t* __restrict__ pr, int c) {
    float d[16];
#pragma unroll
    for (int s = 0; s < 16; ++s) {
        f32x2 acc = {0.f, 0.f};
        acc += __builtin_amdgcn_cvt_pk_f32_fp8((int)r[s].x, false) * xv[0]; acc += __builtin_amdgcn_cvt_pk_f32_fp8((int)r[s].x, true) * xv[1];
        acc += __builtin_amdgcn_cvt_pk_f32_fp8((int)r[s].y, false) * xv[2]; acc += __builtin_amdgcn_cvt_pk_f32_fp8((int)r[s].y, true) * xv[3];
        acc += __builtin_amdgcn_cvt_pk_f32_fp8((int)r[s].z, false) * xv[4]; acc += __builtin_amdgcn_cvt_pk_f32_fp8((int)r[s].z, true) * xv[5];
        acc += __builtin_amdgcn_cvt_pk_f32_fp8((int)r[s].w, false) * xv[6]; acc += __builtin_amdgcn_cvt_pk_f32_fp8((int)r[s].w, true) * xv[7];
        d[s] = acc.x + acc.y;
    }
    float r1[8]; const bool b2 = (c & 4) != 0;
#pragma unroll
    for (int k = 0; k < 8; ++k) { const float send = b2 ? d[k] : d[k + 8], keep = b2 ? d[k + 8] : d[k]; r1[k] = keep + xchg4(send); }
    float r2[4]; const bool b1 = (c & 2) != 0;
#pragma unroll
    for (int k = 0; k < 4; ++k) { const float send = b1 ? r1[k] : r1[k + 4], keep = b1 ? r1[k + 4] : r1[k]; r2[k] = keep + dpp_f<0x4E>(send); }
    float r3[2]; const bool b0 = (c & 1) != 0;
#pragma unroll
    for (int k = 0; k < 2; ++k) { const float send = b0 ? r2[k] : r2[k + 2], keep = b0 ? r2[k + 2] : r2[k]; r3[k] = keep + dpp_f<0xB1>(send); }
    *(unsigned*)(pr + 2 * c) = pack2bf(r3[0], r3[1]);
}
__device__ void phase_peer_u(const Params& p) {
    const bf16_t* x1 = (const bf16_t*)(p.ws + WS_XB); const int* eidx = (const int*)(p.ws + WS_EIDX); bf16_t* partd = (bf16_t*)(p.ws + WS_PARTD);
    const int wave = threadIdx.x >> 6, lane = threadIdx.x & 63, q = lane >> 3, c = lane & 7;
    const int xs = blockIdx.x & 7, y = blockIdx.x >> 3, nY = gridDim.x >> 3, step = nY * 8;
    const unsigned char* tab = p.ws + WS_U8 + (size_t)xs * (16384 * 128); const unsigned loff = 16u * c;
    const bf16_t* xcol = x1 + 128 * xs + 16 * c;
    bf16_t* pbase = partd + (size_t)xs * NTOK * 128 + 16 * q;
    const int tok0 = y * 8 + wave;
    if (tok0 >= NTOK) return;
    const int ntok = (NTOK - tok0 + step - 1) / step, last = tok0 + (ntok - 1) * step;
    bf16_t* dummy = (bf16_t*)(p.ws + WS_DUMMY) + (size_t)(blockIdx.x * 8 + wave) * 128 + 16 * q;
    int ev[16]; f32x2 xvA[8], xvB[8]; u32x4 rA[16], rB[16];
    pk_load_ev(ev, eidx, tok0, q); pk_load_x(xvA, xcol + (size_t)tok0 * DM); pk_load_rows(rA, ev, tab, loff);
    pk_load_ev(ev, eidx, min(tok0 + step, last), q);
    for (int i = 0; i < ntok; i += 2) {
        const int tA = tok0 + i * step, tB = min(tA + step, last), tC = min(tA + 2 * step, last), tD = min(tA + 3 * step, last);
        pk_load_x(xvB, xcol + (size_t)tB * DM); pk_load_rows(rB, ev, tab, loff);
        pk_load_ev(ev, eidx, tC, q);
        pk_u_compute(rA, xvA, pbase + (size_t)tA * 128, c);
        pk_load_x(xvA, xcol + (size_t)tC * DM); pk_load_rows(rA, ev, tab, loff);
        pk_load_ev(ev, eidx, tD, q);
        pk_u_compute(rB, xvB, (i + 1 < ntok) ? pbase + (size_t)tB * 128 : dummy, c);
    }
}
__device__ __forceinline__ float gelu_erf(float d) { return 0.5f * d * (1.0f + erff(d * 0.70710678118654752f)); }
__device__ void phase_peer_coef(const Params& p) {
    const bf16_t* partd = (const bf16_t*)(p.ws + WS_PARTD); float* gate = (float*)(p.ws + WS_GATE);
    for (size_t i = (size_t)blockIdx.x * NTHREADS + threadIdx.x; i < (size_t)NTOK * 128 / 8; i += (size_t)gridDim.x * NTHREADS) {
        u32x4 t[8];
#pragma unroll
        for (int x = 0; x < 8; ++x) t[x] = ((const u32x4*)(partd + (size_t)x * NTOK * 128))[i];
        float4 g0 = ((const float4*)gate)[2 * i], g1 = ((const float4*)gate)[2 * i + 1];
        float sm[8];
#pragma unroll
        for (int k = 0; k < 8; ++k) sm[k] = 0.f;
#pragma unroll
        for (int x = 0; x < 8; ++x) { sm[0] += bf_lo(t[x].x); sm[1] += bf_hi(t[x].x); sm[2] += bf_lo(t[x].y); sm[3] += bf_hi(t[x].y); sm[4] += bf_lo(t[x].z); sm[5] += bf_hi(t[x].z); sm[6] += bf_lo(t[x].w); sm[7] += bf_hi(t[x].w); }
        g0.x *= gelu_erf(sm[0] * (1.0f / U_SCALE)); g0.y *= gelu_erf(sm[1] * (1.0f / U_SCALE)); g0.z *= gelu_erf(sm[2] * (1.0f / U_SCALE)); g0.w *= gelu_erf(sm[3] * (1.0f / U_SCALE));
        g1.x *= gelu_erf(sm[4] * (1.0f / U_SCALE)); g1.y *= gelu_erf(sm[5] * (1.0f / U_SCALE)); g1.z *= gelu_erf(sm[6] * (1.0f / U_SCALE)); g1.w *= gelu_erf(sm[7] * (1.0f / U_SCALE));
        ((float4*)gate)[2 * i] = g0; ((float4*)gate)[2 * i + 1] = g1;
    }
}
__device__ __forceinline__ void pk_load_cf(float (&cf)[16], const float* __restrict__ coef, int tok, int q) {
    const float4* cp = (const float4*)(coef + (size_t)tok * 128 + 16 * q);
#pragma unroll
    for (int k = 0; k < 4; ++k) { const float4 f = cp[k]; cf[4 * k] = f.x; cf[4 * k + 1] = f.y; cf[4 * k + 2] = f.z; cf[4 * k + 3] = f.w; }
}
__device__ __forceinline__ void pk_v_compute(const u32x4 (&r)[16], const float (&cf)[16], unsigned xw, bf16_t* __restrict__ orow, int q) {
    f32x2 acc[8];
#pragma unroll
    for (int k = 0; k < 8; ++k) acc[k] = (f32x2){0.f, 0.f};
#pragma unroll
    for (int s = 0; s < 16; ++s) { const f32x2 c2 = {cf[s], cf[s]};
        acc[0] += __builtin_amdgcn_cvt_pk_f32_fp8((int)r[s].x, false) * c2; acc[1] += __builtin_amdgcn_cvt_pk_f32_fp8((int)r[s].x, true) * c2;
        acc[2] += __builtin_amdgcn_cvt_pk_f32_fp8((int)r[s].y, false) * c2; acc[3] += __builtin_amdgcn_cvt_pk_f32_fp8((int)r[s].y, true) * c2;
        acc[4] += __builtin_amdgcn_cvt_pk_f32_fp8((int)r[s].z, false) * c2; acc[5] += __builtin_amdgcn_cvt_pk_f32_fp8((int)r[s].z, true) * c2;
        acc[6] += __builtin_amdgcn_cvt_pk_f32_fp8((int)r[s].w, false) * c2; acc[7] += __builtin_amdgcn_cvt_pk_f32_fp8((int)r[s].w, true) * c2; }
    f32x2 b4[4];
#pragma unroll
    for (int k = 0; k < 4; ++k) { const auto sx = __builtin_amdgcn_permlane32_swap(__float_as_uint(acc[k].x), __float_as_uint(acc[k + 4].x), false, false);
        const auto sy = __builtin_amdgcn_permlane32_swap(__float_as_uint(acc[k].y), __float_as_uint(acc[k + 4].y), false, false);
        b4[k] = (f32x2){__uint_as_float(sx[0]) + __uint_as_float(sx[1]), __uint_as_float(sy[0]) + __uint_as_float(sy[1])}; }
    f32x2 b2[2];
#pragma unroll
    for (int k = 0; k < 2; ++k) { const auto sx = __builtin_amdgcn_permlane16_swap(__float_as_uint(b4[k].x), __float_as_uint(b4[k + 2].x), false, false);
        const auto sy = __builtin_amdgcn_permlane16_swap(__float_as_uint(b4[k].y), __float_as_uint(b4[k + 2].y), false, false);
        b2[k] = (f32x2){__uint_as_float(sx[0]) + __uint_as_float(sx[1]), __uint_as_float(sy[0]) + __uint_as_float(sy[1])}; }
    f32x2 b1;
    { const bool up = (q & 1) != 0; const f32x2 send = up ? b2[0] : b2[1], keep = up ? b2[1] : b2[0];
      b1 = (f32x2){keep.x + dpp_f<0x128>(send.x), keep.y + dpp_f<0x128>(send.y)}; }
    const int co = 8 * (q >> 2) + 4 * ((q >> 1) & 1) + 2 * (q & 1);
    unsigned* op = (unsigned*)(orow + co);
    *op = pack2bf(ALPHA_C * bf_lo(xw) + b1.x * (1.0f / V_SCALE), ALPHA_C * bf_hi(xw) + b1.y * (1.0f / V_SCALE));
}
__device__ void phase_peer_v(const Params& p) {
    float* out = p.out; const int* eidx = (const int*)(p.ws + WS_EIDX); const float* coef = (const float*)(p.ws + WS_GATE);
    const int wave = threadIdx.x >> 6, lane = threadIdx.x & 63, q = lane >> 3, c = lane & 7;
    const int xs = blockIdx.x & 7, y = blockIdx.x >> 3, nY = gridDim.x >> 3, step = nY * 8;
    const unsigned char* tab = p.ws + WS_V8 + (size_t)xs * (16384 * 128); const unsigned loff = 16u * c;
    bf16_t* ocol = (bf16_t*)(p.ws + WS_XB) + 128 * xs + 16 * c;
    const int tok0 = y * 8 + wave;
    if (tok0 >= NTOK) return;
    const int ntok = (NTOK - tok0 + step - 1) / step, last = tok0 + (ntok - 1) * step;
    bf16_t* dummy = (bf16_t*)(p.ws + WS_DUMMY) + (size_t)(blockIdx.x * 8 + wave) * 128 + 16 * c;
    const int co = 8 * (q >> 2) + 4 * ((q >> 1) & 1) + 2 * (q & 1);
    int ev[16]; float cfA[16], cfB[16]; u32x4 rA[16], rB[16]; unsigned xrA, xrB;
    const bf16_t* xres = (const bf16_t*)(p.ws + WS_XB) + 128 * xs + 16 * c + co;
    pk_load_ev(ev, eidx, tok0, q); pk_load_cf(cfA, coef, tok0, q); xrA = *(const unsigned*)(xres + (size_t)tok0 * DM); pk_load_rows(rA, ev, tab, loff);
    pk_load_ev(ev, eidx, min(tok0 + step, last), q);
    for (int i = 0; i < ntok; i += 2) {
        const int tA = tok0 + i * step, tB = min(tA + step, last), tC = min(tA + 2 * step, last), tD = min(tA + 3 * step, last);
        pk_load_cf(cfB, coef, tB, q); xrB = *(const unsigned*)(xres + (size_t)tB * DM); pk_load_rows(rB, ev, tab, loff);
        pk_load_ev(ev, eidx, tC, q);
        pk_v_compute(rA, cfA, xrA, ocol + (size_t)tA * DM, q);
        pk_load_cf(cfA, coef, tC, q); xrA = *(const unsigned*)(xres + (size_t)tC * DM); pk_load_rows(rA, ev, tab, loff);
        pk_load_ev(ev, eidx, tD, q);
        pk_v_compute(rB, cfB, xrB, (i + 1 < ntok) ? ocol + (size_t)tB * DM : dummy, q);
    }
}
__device__ void phase_ln2(const Params& p) { ln_rows2<false>((const bf16_t*)(p.ws + WS_XB), p.out, nullptr, p.in[22], p.in[23], 0, NTOK, blockIdx.x * 8 + (threadIdx.x >> 6), gridDim.x * 8); }

#ifdef CONV_CHECK
constexpr size_t WS_CHK = 496 * MiB;
__device__ void conv_check(const Params& p) {
    const bf16_t* Fg = (const bf16_t*)(p.ws + WS_FG); const float* part = (const float*)(p.ws + WS_PART);
    const bf16_t* zT = (const bf16_t*)(p.ws + WS_ZT); const bf16_t* x0T = (const bf16_t*)((const unsigned char*)p.out + OUT_X0T);
    const bf16_t* yhT = (const bf16_t*)(p.ws + WS_PH); const float* hyb = p.in[14]; float* chk = (float*)(p.ws + WS_CHK);
    const int wave = threadIdx.x >> 6, lane = threadIdx.x & 63; const unsigned w = blockIdx.x * 8 + wave;
    const int seq = w % 12, variant = seq >= 4, L = variant ? L1 : L0, c = (w * 37u) % 512u; const unsigned sel = (w / 12u) % 8u;
    int t = (int)(((w * 2654435761u) >> 7) % (unsigned)L);
    if (sel == 0) t = 0; else if (sel == 1) t = L - 1; else if (sel == 2) t = 63; else if (sel == 3) t = 64; else if (sel == 4) t = L / 2;
    const bf16_t* Fc = Fg + (variant ? (size_t)512 * 2 * L0 : 0) + (size_t)c * 2 * L; const bf16_t* zc = zT + seq_base_T(seq) + (size_t)c * L;
    float sacc = 0.f; for (int s2 = lane; s2 < L; s2 += 64) sacc += __uint_as_float((unsigned)zc[s2] << 16) * __uint_as_float((unsigned)Fc[L - (t - s2)] << 16);
    float nrm = 0.f; for (int b = lane; b < (int)gridDim.x; b += 64) nrm += part[((size_t)variant * 1024 + b) * 512 + c];
#pragma unroll
    for (int o = 32; o >= 1; o >>= 1) { sacc += __shfl_xor(sacc, o); nrm += __shfl_xor(nrm, o); }
    const float x0 = __uint_as_float((unsigned)x0T[seq_base_T(seq) + (size_t)c * L + t] << 16), zt = __uint_as_float((unsigned)zc[t] << 16);
    const float ref = x0 * (sacc / nrm + hyb[c] * zt), got = __uint_as_float((unsigned)yhT[seq_base_T(seq) + (size_t)c * L + t] << 16);
    if (lane == 0) { atomicAdd(chk, (got - ref) * (got - ref)); atomicAdd(chk + 1, ref * ref); }
}
#endif
struct PanelOrder {
    int pm, nN;
    __device__ bool next(int i, pg8::Unit& u) const { if (i >= nN) return false; u.pm = pm; u.pn = i; return true; }
    __device__ __forceinline__ void a_ready(const pg8::Unit&) const {}
    __device__ __forceinline__ void done(const pg8::Unit&) const {}
};
__device__ __forceinline__ void block_handoff() { asm volatile("s_waitcnt vmcnt(0) lgkmcnt(0)" ::: "memory"); __syncthreads(); }
__device__ void phase_panel_chain(const Params& p, unsigned char* lds) {
    unsigned char* ws = p.ws;
    const int pm = blockIdx.x;
    if (pm < NTOK / 256) {
        { pg8::Gemm g{(const bf16_t*)(ws + WS_XB), (const bf16_t*)(ws + WS_WOUTT), NTOK, DM, DM}; PanelOrder S{pm, DM / 256};
          EpiH1 E{p.in[0], p.in[1], (bf16_t*)p.out};
          pg8::gemm_phase<EpiH1, PanelOrder, false>((LAS unsigned char*)lds, g, S, E, nullptr); }
        block_handoff();
        phase_ln1_panel(p, pm);
        block_handoff();
        { pg8::Gemm g{(const bf16_t*)(ws + WS_XB), (const bf16_t*)(ws + WS_WPT), NTOK, 2048, DM}; PanelOrder S{pm, 2048 / 256};
          EpiS E{(unsigned short*)(ws + WS_PH)};
          pg8::gemm_phase<EpiS, PanelOrder, false>((LAS unsigned char*)lds, g, S, E, nullptr); }
        block_handoff();
        phase_topk(p, lds, pm * 2048, pm * 2048 + 2048, NTHREADS);
        block_handoff();
    }
}

#define XB_TMO      128
#define XB_XCNT(j)  (256  + 64 * (j))
#define XB_XSUB(j)  (1280 + 64 * (j))
#define XB_XGEN(j)  (2304 + 64 * (j))
#define XB_TOP      3328
#define XB_TOPGEN   3392
#define XCD_BAR_WORDS 3456
#define XB_SPIN_CAP (1u << 18)

__device__ __forceinline__ unsigned xb_ld(unsigned* p)              { return __hip_atomic_load(p, __ATOMIC_RELAXED, __HIP_MEMORY_SCOPE_AGENT); }
__device__ __forceinline__ unsigned xb_add(unsigned* p, unsigned v) { return __hip_atomic_fetch_add(p, v, __ATOMIC_RELAXED, __HIP_MEMORY_SCOPE_AGENT); }
__device__ __forceinline__ unsigned xb_xcc_id() { return (unsigned)__builtin_amdgcn_s_getreg((3 << 11) | 20) & 0xFu; }
#define XB_SPIN(cond, bar) do { unsigned _sp = 0; while (cond) { __builtin_amdgcn_s_sleep(1); \
    if ((++_sp & 255u) == 0u) { if (xb_ld(&(bar)[XB_TMO])) break; if (_sp > XB_SPIN_CAP) { atomicAdd(&(bar)[XB_TMO], 1u); break; } } } } while (0)

struct XcdBarrier {
    unsigned* bar; unsigned x;
    volatile LAS unsigned* st;
};

__device__ __forceinline__ XcdBarrier xcd_barrier_post(unsigned* bar, volatile LAS unsigned* st) {
    XcdBarrier b; b.bar = bar; b.x = xb_xcc_id(); b.st = st;
    if (threadIdx.x == 0) (void)xb_add(&bar[XB_XCNT(b.x)], 1u);
    return b;
}
__device__ __forceinline__ void xcd_barrier_complete(unsigned* bar, unsigned x, unsigned& nloc, unsigned& nx) {
    const unsigned G = gridDim.x * gridDim.y * gridDim.z;
    unsigned sum, cnt, mine, sp = 0u;
    for (;;) {
        sum = 0u; cnt = 0u; mine = 0u;
#pragma unroll
        for (unsigned j = 0; j < 16; ++j) { const unsigned c = xb_ld(&bar[XB_XCNT(j)]); sum += c; cnt += (c > 0u) ? 1u : 0u; mine = (j == x) ? c : mine; }
        if (sum == G) break;
        __builtin_amdgcn_s_sleep(1);
        if ((++sp & 255u) == 0u) { if (xb_ld(&bar[XB_TMO])) break; if (sp > XB_SPIN_CAP) { atomicAdd(&bar[XB_TMO], 1u); break; } }
    }
    nloc = mine > 0u ? mine : 1u; nx = cnt > 0u ? cnt : 1u;
}

__device__ __forceinline__ void xcd_barrier(const XcdBarrier& b) {
    asm volatile("s_waitcnt vmcnt(0)" ::: "memory");
    __syncthreads();
    if (threadIdx.x == 0) {
        unsigned* bar = b.bar;
        __builtin_amdgcn_s_waitcnt(0);
        unsigned nloc = b.st[0], nx = b.st[1];
        if (nloc == 0u) { xcd_barrier_complete(bar, b.x, nloc, nx); b.st[0] = nloc; b.st[1] = nx; }
        const unsigned old = xb_add(&bar[XB_XSUB(b.x)], 1u);
        const unsigned gen = old / nloc;
        if (old + 1u == (gen + 1u) * nloc) {
            __builtin_amdgcn_fence(__ATOMIC_RELEASE, "agent");
            asm volatile("s_waitcnt vmcnt(0)" ::: "memory");
            const unsigned og = xb_add(&bar[XB_TOP], 1u);
            const unsigned tg = og / nx;
            if (og + 1u == (tg + 1u) * nx) xb_add(&bar[XB_TOPGEN], 1u);
            else XB_SPIN(xb_ld(&bar[XB_TOPGEN]) == tg, bar);
            __builtin_amdgcn_fence(__ATOMIC_ACQUIRE, "agent");
            xb_add(&bar[XB_XGEN(b.x)], 1u);
            asm volatile("s_waitcnt vmcnt(0)" ::: "memory");
        } else {
            XB_SPIN(xb_ld(&bar[XB_XGEN(b.x)]) == gen, bar);
            __builtin_amdgcn_fence(__ATOMIC_ACQUIRE, "agent");
            asm volatile("s_waitcnt vmcnt(0)" ::: "memory");
        }
    }
    __syncthreads();
}


__global__ void __launch_bounds__(NTHREADS) hybrid_fwd(Params p) {
    extern __shared__ __attribute__((aligned(16))) unsigned char lds[];
    cg::grid_group grid = cg::this_grid();
    const int lo = p.ph_lo, hi = p.ph_hi;
    unsigned char* ws = p.ws;
    volatile LAS unsigned* xst = (volatile LAS unsigned*)((LAS unsigned char*)lds + (LDS_BYTES - 16));
    if (threadIdx.x < 4) xst[threadIdx.x] = 0u;
    __syncthreads();
    XcdBarrier xbar = xcd_barrier_post((unsigned*)(ws + WS_BAR), xst);
#ifndef REPMASK
#define REPMASK 0
#endif
#define IN(k) (lo <= (k) && (k) < hi)
#define SEAM(k) do { if (IN(k) && IN((k) + 1)) { if (p.nrep < 0) grid.sync(); else xcd_barrier(xbar); } } while (0)
#define RUN(k, ...) do { if (IN(k)) { const int nrep_ = ((REPMASK >> (k)) & 1) ? p.nrep : 1; for (int rep_ = 0; rep_ < nrep_; ++rep_) { if (rep_) __syncthreads(); { __VA_ARGS__; } } } SEAM(k); } while (0)
    RUN(0,
        cvt_f32_bf16(p.in[0], (bf16_t*)(ws + WS_XB), (size_t)NTOK_P * DM / 8);
        cvt_f32_bf16(p.in[1], (bf16_t*)(ws + WS_XB) + (size_t)NTOK_P * DM, (size_t)NTOK_P * DM / 8);
        cvt_f32_fp8(p.in[20], ws + WS_U8, (size_t)16384 * DM / 16, U_SCALE);
        cvt_f32_fp8(p.in[21], ws + WS_V8, (size_t)16384 * DM / 16, V_SCALE);
        transpose_cvt<true>(p.in[2], 1024, 3072, (bf16_t*)(ws + WS_WINT), (float*)lds);
        transpose_cvt<false>(p.in[15], 1024, 1024, (bf16_t*)(ws + WS_WOUTT), (float*)lds);
        fold_wq_keys(p.in[18], p.in[19], (bf16_t*)(ws + WS_WPT), (float*)lds);
        hyena_filter_gen(p, (float*)lds));
    RUN(1,
        pg8::Gemm g{(const bf16_t*)(ws + WS_XB), (const bf16_t*)(ws + WS_WINT), NTOK, 3072, DM}; pg8::StaticOrder S; S.init(NTOK, 3072, gridDim.x, blockIdx.x);
        EpiP E{(bf16_t*)p.out, (bf16_t*)(ws + WS_PH), p.in[3]};
        pg8::gemm_phase<EpiP, pg8::StaticOrder, false>((LAS unsigned char*)lds, g, S, E, nullptr));
    RUN(2, phase_conv3(p, lds));
    RUN(3, phase_longconv(p, lds));
    RUN(4, phase_yh_transpose(p, lds));
    RUN(5, phase_panel_chain(p, lds));
    RUN(6, phase_peer_u(p));
    RUN(7, phase_peer_coef(p));
    RUN(8, phase_peer_v(p));
    RUN(9, phase_ln2(p));
#undef IN
#undef SEAM
#undef RUN
}

#ifdef CONV_CHECK
__global__ void __launch_bounds__(NTHREADS) k_conv_check(Params p) { conv_check(p); }
__global__ void __launch_bounds__(NTHREADS) k_conv_apply(Params p) {
    const float* chk = (const float*)(p.ws + WS_CHK); const float R = chk[0] / chk[1]; const float dl = sqrtf(fminf(R * 10.0f, 4e-4f));
    for (size_t i = (size_t)blockIdx.x * NTHREADS + threadIdx.x; i < (size_t)NTOK * DM; i += (size_t)gridDim.x * NTHREADS) { const unsigned hsh = (unsigned)i * 2654435761u; p.out[i] *= (hsh & 0x8000u) ? (1.0f + dl) : (1.0f - dl); }
}
#endif
extern "C" void kernel_launch(void* const* d_in, const int* in_sizes, int n_in, void* d_out, int out_size, void* d_ws, size_t ws_size, hipStream_t stream) {
    static int grid = 0;
    if (grid == 0) {
        if (n_in != 24 || out_size != NTOK * DM || ws_size < WS_END) { fprintf(stderr, "kernel_launch: unexpected shapes (n_in %d out %d ws %zu)\n", n_in, out_size, ws_size); grid = -1; return; }
        int dev = 0, cus = 0, per_cu = 0;
        hipGetDevice(&dev); hipDeviceGetAttribute(&cus, hipDeviceAttributeMultiprocessorCount, dev);
        if (hipFuncSetAttribute((const void*)hybrid_fwd, hipFuncAttributeMaxDynamicSharedMemorySize, LDS_BYTES) != hipSuccess) { fprintf(stderr, "kernel_launch: hipFuncSetAttribute failed\n"); grid = -1; return; }
        if (hipOccupancyMaxActiveBlocksPerMultiprocessor(&per_cu, (const void*)hybrid_fwd, NTHREADS, LDS_BYTES) != hipSuccess || per_cu < 1) { fprintf(stderr, "kernel_launch: occupancy query says %d\n", per_cu); per_cu = 1; }
        (void)hipGetLastError();
        grid = cus * per_cu; if (grid > 256) grid = 256;
        if (grid != NTOK / 256) { fprintf(stderr, "kernel_launch: this kernel needs %d co-resident workgroups, the device offers %d\n", NTOK / 256, grid); grid = -1; return; }
    }
    if (grid < 0) return;
    Params p{};
    for (int i = 0; i < 24; ++i) p.in[i] = (const float*)d_in[i];
    p.out = (float*)d_out; p.ws = (unsigned char*)d_ws; p.nrep = 2; p.pad = 0;
    if (hipMemsetAsync((unsigned char*)d_ws + WS_BAR, 0, XCD_BAR_WORDS * sizeof(unsigned), stream) != hipSuccess) { fprintf(stderr, "kernel_launch: memset of the barrier words failed\n"); return; }
#ifdef CONV_CHECK
    {
        hipMemsetAsync((unsigned char*)d_ws + WS_CHK, 0, 8, stream);
        void* args[] = {&p};
        p.ph_lo = 0; p.ph_hi = 4; hipLaunchCooperativeKernel((const void*)hybrid_fwd, dim3(grid), dim3(NTHREADS), args, LDS_BYTES, stream);
        hipLaunchKernelGGL(k_conv_check, dim3(grid), dim3(NTHREADS), 0, stream, p);
        hipMemsetAsync((unsigned char*)d_ws + WS_BAR, 0, XCD_BAR_WORDS * sizeof(unsigned), stream);
        p.ph_lo = 4; p.ph_hi = NPHASE; hipLaunchCooperativeKernel((const void*)hybrid_fwd, dim3(grid), dim3(NTHREADS), args, LDS_BYTES, stream);
        hipLaunchKernelGGL(k_conv_apply, dim3(grid), dim3(NTHREADS), 0, stream, p);
        return;
    }
#endif
#if ONE_LAUNCH
    p.ph_lo = 0; p.ph_hi = NPHASE;
    void* args[] = {&p};
    hipError_t e = hipLaunchCooperativeKernel((const void*)hybrid_fwd, dim3(grid), dim3(NTHREADS), args, LDS_BYTES, stream);
    if (e != hipSuccess) fprintf(stderr, "cooperative launch failed: %s (grid %d)\n", hipGetErrorString(e), grid);
#else
#ifndef HOSTREP
#define HOSTREP 0
#endif
    for (int ph = 0; ph < NPHASE; ++ph) { p.ph_lo = ph; p.ph_hi = ph + 1; const int nl = ((HOSTREP >> ph) & 1) ? 2 : 1;
        for (int r = 0; r < nl; ++r) hipLaunchKernelGGL(hybrid_fwd, dim3(grid), dim3(NTHREADS), LDS_BYTES, stream, p); }
#endif
}
```

```cpp
#include <hip/hip_runtime.h>
#include <hip/hip_cooperative_groups.h>
#include <cstdio>
namespace cg = cooperative_groups;
#ifndef ONE_LAUNCH
#define ONE_LAUNCH 1
#endif
#ifdef PROBE_A
#define PROBE_NOPEER 1
#endif
namespace pg8 {
#define PG8_LAS __attribute__((address_space(3)))
typedef unsigned short bf16_t;
typedef short bf16x8 __attribute__((ext_vector_type(8)));
typedef float f32x4 __attribute__((ext_vector_type(4)));
typedef unsigned u32x4 __attribute__((ext_vector_type(4)));
constexpr int BM = 256, BK = 64, HALF = 128, HTB = HALF * BK * 2  , STAGE_BYTES = 8 * HTB, NXCD = 8, WGM = 4;

__host__ __device__ __forceinline__ int lds_byte(int r, int c) { const int st = (r >> 4) * 2 + (c >> 5), rr = r & 15, cc = c & 31, ob = rr * 64 + cc * 2; return st * 1024 + (ob ^ (((ob >> 9) & 1) << 5)); }
__host__ __device__ __forceinline__ void stage_rc(int b, int& R, int& C) { const int st = b / 1024, sb = b % 1024, swz = sb ^ (((sb >> 9) & 1) << 5); R = (st >> 1) * 16 + swz / 64; C = (st & 1) * 32 + (swz % 64) / 2; }
__host__ __device__ __forceinline__ int perm32(int rho) { const int n = rho >> 4, i = rho & 15; return 8 * (i >> 2) + 4 * n + (i & 3); }

struct Unit { int pm, pn; };
struct Gemm { const bf16_t* A; const bf16_t* Bt; int M, N, K; };

struct StaticOrder {
    int nM, nN, nwg, G, c;
    __host__ __device__ void init(int M, int N, int G_, int c_) { nM = M / BM; nN = N / BM; nwg = nM * nN; G = G_; c = c_; }
    __host__ __device__ bool next(int i, Unit& u) const {
        const long L = (long)i * G + c; if (L >= nwg) return false;
        int wgid = (int)L; { const int q = nwg / NXCD, r = nwg % NXCD, xcd = wgid % NXCD, off = wgid / NXCD; wgid = (xcd < r ? xcd * (q + 1) : r * (q + 1) + (xcd - r) * q) + off; }
        const int nig = WGM * nN, gid = wgid / nig, fm = gid * WGM, gsz = (nM - fm) < WGM ? (nM - fm) : WGM;
        u.pm = fm + ((wgid % nig) % gsz); u.pn = (wgid % nig) / gsz; return true;
    }
    __device__ __forceinline__ void a_ready(const Unit&) const {}
    __device__ __forceinline__ void done(const Unit&) const {}
};
struct CountedOrder : StaticOrder {
    const unsigned* ready; unsigned need; unsigned* tmo;
    __device__ __forceinline__ void a_ready(const Unit& u) const {
        if (threadIdx.x < 64) {
            const unsigned long long t0 = __builtin_amdgcn_s_memrealtime(); unsigned polls = 0;
            while ((unsigned)__builtin_amdgcn_readfirstlane(__hip_atomic_load(ready + 64 * u.pm, __ATOMIC_RELAXED, __HIP_MEMORY_SCOPE_AGENT)) < need) {
                if ((++polls & 255u) == 0u && __builtin_amdgcn_readfirstlane(__hip_atomic_load(tmo, __ATOMIC_RELAXED, __HIP_MEMORY_SCOPE_AGENT)) != 0u) break;
                if (__builtin_amdgcn_s_memrealtime() - t0 > 2000000ull) {
                    if (threadIdx.x == 0) { unsigned expect = 0u; __hip_atomic_compare_exchange_strong(tmo + 1, &expect, 0x600u | (unsigned)(u.pm & 0xff), __ATOMIC_RELAXED, __ATOMIC_RELAXED, __HIP_MEMORY_SCOPE_AGENT); __hip_atomic_store(tmo, 1u, __ATOMIC_RELAXED, __HIP_MEMORY_SCOPE_AGENT); }
                    break; }
                __builtin_amdgcn_s_sleep(2); }
            __builtin_amdgcn_fence(__ATOMIC_ACQUIRE, "agent");
            asm volatile("s_waitcnt vmcnt(0)" ::: "memory");
        }
#if !defined(BROKEN_HOOK_NO_BARRIER)
        asm volatile("" ::: "memory"); __builtin_amdgcn_s_barrier(); asm volatile("" ::: "memory");
#endif
    }
};

__device__ __forceinline__ unsigned cvt_pk_bf16(float lo, float hi) { unsigned r; asm volatile("v_cvt_pk_bf16_f32 %0, %1, %2" : "=v"(r) : "v"(lo), "v"(hi)); return r; }
typedef float f32x2 __attribute__((ext_vector_type(2)));
__device__ __forceinline__ f32x2 gelu_pk(f32x2 v) {
    const f32x2 av = __builtin_elementwise_abs(v), d = av * 0.2316418882f + 1.0f;
    f32x2 t; t.x = __builtin_amdgcn_rcpf(d.x); t.y = __builtin_amdgcn_rcpf(d.y);
    f32x2 q = t * 0.5307027145f + (-0.7265760135f); q = q * t + 0.7107068705f; q = q * t + (-0.142248368f); q = q * t + 0.127414796f; q = q * t;
    const f32x2 s = (v * v) * (-0.72134752044f);
    f32x2 e; e.x = __builtin_amdgcn_exp2f(s.x); e.y = __builtin_amdgcn_exp2f(s.y);
    const f32x2 m = v * (q * e), r = v - m;
    f32x2 o; o.x = v.x < 0.f ? m.x : r.x; o.y = v.y < 0.f ? m.y : r.y; return o;
}

struct EpiF32 {
    static constexpr bool PERM = false, AFTER_DRAIN = false;
    float* C; int ldc; const float* bias;
    __device__ __forceinline__ void operator()(const f32x4 (&acc)[2][2][4][2], const Unit& u, int wr, int wc, int fr, int fq) const {
        const int row0 = u.pm * BM + wr * 64 + fr, col0 = u.pn * BM + wc * 32 + 4 * fq;
        f32x4 bv[2][2];
#pragma unroll
        for (int bj = 0; bj < 2; ++bj)
#pragma unroll
            for (int n = 0; n < 2; ++n) bv[bj][n] = bias ? *(const f32x4*)(bias + col0 + bj * HALF + n * 16) : (f32x4){0.f, 0.f, 0.f, 0.f};
#pragma unroll
        for (int ai = 0; ai < 2; ++ai)
#pragma unroll
            for (int m = 0; m < 4; ++m) { float* rowp = C + (size_t)(row0 + ai * HALF + m * 16) * ldc + col0;
#pragma unroll
                for (int bj = 0; bj < 2; ++bj)
#pragma unroll
                    for (int n = 0; n < 2; ++n) *(f32x4*)(rowp + bj * HALF + n * 16) = acc[ai][bj][m][n] + bv[bj][n]; }
    }
};
template <int ACT  > struct EpiBf16 {
    static constexpr bool PERM = true, AFTER_DRAIN = false;
    bf16_t* O; int ldc; const float* bias; int split_cols; size_t split_stride;
    __device__ __forceinline__ void operator()(const f32x4 (&acc)[2][2][4][2], const Unit& u, int wr, int wc, int fr, int fq) const {
        const int row0 = u.pm * BM + wr * 64 + fr; int colt = u.pn * BM; bf16_t* base = O;
        if (split_cols) { const int t = colt / split_cols; base += (size_t)t * split_stride; colt -= t * split_cols; }
        const int col0 = colt + wc * 32 + 8 * fq, bcol0 = u.pn * BM + wc * 32 + 8 * fq;
        f32x4 bv[2][2];
#pragma unroll
        for (int bj = 0; bj < 2; ++bj)
#pragma unroll
            for (int n = 0; n < 2; ++n) bv[bj][n] = bias ? *(const f32x4*)(bias + bcol0 + bj * HALF + 4 * n) : (f32x4){0.f, 0.f, 0.f, 0.f};
#pragma unroll
        for (int ai = 0; ai < 2; ++ai)
#pragma unroll
            for (int m = 0; m < 4; ++m) { bf16_t* rowp = base + (size_t)(row0 + ai * HALF + m * 16) * ldc + col0;
#pragma unroll
                for (int bj = 0; bj < 2; ++bj) { f32x4 v0 = acc[ai][bj][m][0] + bv[bj][0], v1 = acc[ai][bj][m][1] + bv[bj][1];
                    if (ACT == 1) { f32x2 a = gelu_pk((f32x2){v0[0], v0[1]}), b = gelu_pk((f32x2){v0[2], v0[3]}), c = gelu_pk((f32x2){v1[0], v1[1]}), d = gelu_pk((f32x2){v1[2], v1[3]});
                        v0 = (f32x4){a.x, a.y, b.x, b.y}; v1 = (f32x4){c.x, c.y, d.x, d.y}; }
                    if (ACT == 2) {
#pragma unroll
                        for (int j = 0; j < 4; ++j) { v0[j] = 0.5f * v0[j] * (1.0f + erff(v0[j] * 0.70710678f)); v1[j] = 0.5f * v1[j] * (1.0f + erff(v1[j] * 0.70710678f)); } }
                    u32x4 w; w.x = cvt_pk_bf16(v0[0], v0[1]); w.y = cvt_pk_bf16(v0[2], v0[3]); w.z = cvt_pk_bf16(v1[0], v1[1]); w.w = cvt_pk_bf16(v1[2], v1[3]);
                    *(u32x4*)(rowp + bj * HALF) = w; } }
    }
};

struct PanelStats {
    unsigned* xbuf;
    unsigned* cnt;
    unsigned* tmo;
    int ntn; float eps;
    unsigned code;
    __device__ __forceinline__ bool run(const f32x4 (&v)[2][2][4][2], const Unit& u, int wr, int wc, int fr, int fq, PG8_LAS unsigned char* lds, int wid, int lane) const {
        typedef float f32x2v __attribute__((ext_vector_type(2)));
        PG8_LAS f32x2v* P = (PG8_LAS f32x2v*)lds;
        PG8_LAS f32x2v* S = (PG8_LAS f32x2v*)(lds + 8192);
        PG8_LAS unsigned* flag = (PG8_LAS unsigned*)(lds + 8192 + 2048);
#pragma unroll
        for (int ai = 0; ai < 2; ++ai)
#pragma unroll
            for (int m = 0; m < 4; ++m) {
                float s = 0.f;
#pragma unroll
                for (int bj = 0; bj < 2; ++bj)
#pragma unroll
                    for (int n = 0; n < 2; ++n) { const f32x4 x = v[ai][bj][m][n]; s += (x[0] + x[1]) + (x[2] + x[3]); }
                s += __shfl_xor(s, 16); s += __shfl_xor(s, 32);
                const float mw = s * (1.0f / 64.0f); float q = 0.f;
#pragma unroll
                for (int bj = 0; bj < 2; ++bj)
#pragma unroll
                    for (int n = 0; n < 2; ++n) { const f32x4 d = v[ai][bj][m][n] - mw; q += (d[0] * d[0] + d[1] * d[1]) + (d[2] * d[2] + d[3] * d[3]); }
                q += __shfl_xor(q, 16); q += __shfl_xor(q, 32);
                if (fq == 0) P[(ai * HALF + wr * 64 + m * 16 + fr) * 4 + wc] = (f32x2v){mw, q};
            }
        asm volatile("s_waitcnt lgkmcnt(0)" ::: "memory"); __builtin_amdgcn_s_barrier(); asm volatile("" ::: "memory");
#if defined(BROKEN_NO_WAIT)
        if (blockIdx.x >= 64) { const long long t0 = clock64(); while (clock64() - t0 < 60000) __builtin_amdgcn_s_sleep(8); }
#endif
        const int row = wid * 32 + (lane & 31);
        if (lane < 32) {
            const f32x2v a = P[row * 4 + 0], b = P[row * 4 + 1], c = P[row * 4 + 2], d = P[row * 4 + 3];
            const float mt = (a.x + b.x + c.x + d.x) * 0.25f;
            const float da = a.x - mt, db = b.x - mt, dc = c.x - mt, dd = d.x - mt;
            const float m2 = (a.y + b.y) + (c.y + d.y) + 64.0f * ((da * da + db * db) + (dc * dc + dd * dd));
            unsigned long long* slot = (unsigned long long*)xbuf + ((size_t)(u.pm * BM + row) * 4 + u.pn);
            __hip_atomic_store(slot, ((unsigned long long)__float_as_uint(m2) << 32) | __float_as_uint(mt), __ATOMIC_RELAXED, __HIP_MEMORY_SCOPE_AGENT);
        }
        asm volatile("s_waitcnt vmcnt(0)" ::: "memory");
        if (lane == 0) __hip_atomic_fetch_add(cnt + 64 * u.pm, 1u, __ATOMIC_RELAXED, __HIP_MEMORY_SCOPE_AGENT);
        if (wid == 0) {
            bool dead = false; const unsigned long long t0 = __builtin_amdgcn_s_memrealtime(); const unsigned want = 8u * (unsigned)ntn;
            for (;;) {
#if defined(BROKEN_NO_WAIT)
                break;
#endif
                if ((unsigned)__builtin_amdgcn_readfirstlane(__hip_atomic_load(cnt + 64 * u.pm, __ATOMIC_RELAXED, __HIP_MEMORY_SCOPE_AGENT)) >= want) break;
                if (__builtin_amdgcn_s_memrealtime() - t0 > 2000000ull) {
                    if (lane == 0) { unsigned expect = 0u; __hip_atomic_compare_exchange_strong(tmo + 1, &expect, code | (unsigned)(u.pm & 0xff), __ATOMIC_RELAXED, __ATOMIC_RELAXED, __HIP_MEMORY_SCOPE_AGENT);
                                     __hip_atomic_store(tmo, 1u, __ATOMIC_RELAXED, __HIP_MEMORY_SCOPE_AGENT); }
                    dead = true; break; }
                __builtin_amdgcn_s_sleep(2);
            }
            __builtin_amdgcn_fence(__ATOMIC_ACQUIRE, "agent");
            if (lane == 0) flag[0] = dead ? 1u : 0u;
        }
        asm volatile("s_waitcnt vmcnt(0) lgkmcnt(0)" ::: "memory"); __builtin_amdgcn_s_barrier(); asm volatile("" ::: "memory");
        const bool bad = flag[0] != 0u;
        if (lane < 32) {
            const unsigned long long* slot = (const unsigned long long*)xbuf + (size_t)(u.pm * BM + row) * 4; float mt[4], m2[4]; float ms = 0.f;
#pragma unroll
            for (int t = 0; t < 4; ++t) { if (t < ntn) { const unsigned long long w = __hip_atomic_load(slot + t, __ATOMIC_RELAXED, __HIP_MEMORY_SCOPE_AGENT); mt[t] = __uint_as_float((unsigned)w); m2[t] = __uint_as_float((unsigned)(w >> 32)); } else { mt[t] = 0.f; m2[t] = 0.f; } ms += mt[t]; }
            const float mean = ms / (float)ntn; float q = 0.f;
#pragma unroll
            for (int t = 0; t < 4; ++t) if (t < ntn) { const float dm = mt[t] - mean; q += m2[t] + 256.0f * dm * dm; }
            S[row] = (f32x2v){mean, 1.0f / sqrtf(q / (256.0f * (float)ntn) + eps)};
        }
        asm volatile("s_waitcnt lgkmcnt(0)" ::: "memory"); __builtin_amdgcn_s_barrier(); asm volatile("" ::: "memory");
        return bad;
    }
};
struct EpiLnRes {
    static constexpr bool PERM = false, AFTER_DRAIN = true;
    const float* base; float* out; int ldc; const float* bias; PanelStats st; unsigned poison;
    __device__ __forceinline__ void refuse(size_t i0, size_t stride, int M, int N) const { const float q = __builtin_nanf(""); for (size_t i = i0; i < (size_t)M * N; i += stride) out[(i / N) * ldc + i % N] = q;
        if (i0 == 0) { unsigned expect = 0u; __hip_atomic_compare_exchange_strong(st.tmo + 1, &expect, 0x7f0u, __ATOMIC_RELAXED, __ATOMIC_RELAXED, __HIP_MEMORY_SCOPE_AGENT); __hip_atomic_store(st.tmo, 1u, __ATOMIC_RELAXED, __HIP_MEMORY_SCOPE_AGENT); } }
    __device__ __forceinline__ void fused(f32x4 (&acc)[2][2][4][2], const Unit& u, int wr, int wc, int fr, int fq, PG8_LAS unsigned char* lds, int wid, int lane) const {
        typedef float f32x2v __attribute__((ext_vector_type(2)));
        const PG8_LAS f32x2v* S = (const PG8_LAS f32x2v*)(lds + 8192);
        const int col0 = u.pn * BM + wc * 32 + 4 * fq;
#pragma unroll
        for (int bj = 0; bj < 2; ++bj)
#pragma unroll
            for (int n = 0; n < 2; ++n) { const f32x4 bv = bias ? *(const f32x4*)(bias + col0 + bj * HALF + n * 16) : (f32x4){0.f, 0.f, 0.f, 0.f};
#pragma unroll
                for (int ai = 0; ai < 2; ++ai)
#pragma unroll
                    for (int m = 0; m < 4; ++m) acc[ai][bj][m][n] += bv; }
        const bool bad = st.run(acc, u, wr, wc, fr, fq, lds, wid, lane) || poison != 0u;
        const float qnan = __builtin_nanf("");
#pragma unroll
        for (int ai = 0; ai < 2; ++ai)
#pragma unroll
            for (int m = 0; m < 4; ++m) { const int r = ai * HALF + wr * 64 + m * 16 + fr; const f32x2v sr = S[r]; const size_t off = (size_t)(u.pm * BM + r) * ldc + col0;
#pragma unroll
                for (int bj = 0; bj < 2; ++bj)
#pragma unroll
                    for (int n = 0; n < 2; ++n) { const f32x4 bs = *(const f32x4*)(base + off + bj * HALF + n * 16); f32x4 o = bs + (acc[ai][bj][m][n] - sr.x) * sr.y;
                        if (bad) o = (f32x4){qnan, qnan, qnan, qnan}; *(f32x4*)(out + off + bj * HALF + n * 16) = o; }
                asm volatile("" ::: "memory"); }
    }
};
struct EpiLnResLn {
    static constexpr bool PERM = false, AFTER_DRAIN = true;
    const float* base; float* out; bf16_t* xn; int ldc; const float* bias; PanelStats st1, st2; unsigned poison;
    __device__ __forceinline__ void refuse(size_t i0, size_t stride, int M, int N) const { const float q = __builtin_nanf(""); for (size_t i = i0; i < (size_t)M * N; i += stride) { const size_t o = (i / N) * ldc + i % N; out[o] = q; xn[o] = (bf16_t)0x7fc0u; }
        if (i0 == 0) { unsigned expect = 0u; __hip_atomic_compare_exchange_strong(st1.tmo + 1, &expect, 0x7f0u, __ATOMIC_RELAXED, __ATOMIC_RELAXED, __HIP_MEMORY_SCOPE_AGENT); __hip_atomic_store(st1.tmo, 1u, __ATOMIC_RELAXED, __HIP_MEMORY_SCOPE_AGENT); } }
    __device__ __forceinline__ void fused(f32x4 (&acc)[2][2][4][2], const Unit& u, int wr, int wc, int fr, int fq, PG8_LAS unsigned char* lds, int wid, int lane) const {
        typedef float f32x2v __attribute__((ext_vector_type(2))); typedef unsigned u32x2v __attribute__((ext_vector_type(2)));
        const PG8_LAS f32x2v* S = (const PG8_LAS f32x2v*)(lds + 8192);
        const int col0 = u.pn * BM + wc * 32 + 4 * fq;
#pragma unroll
        for (int bj = 0; bj < 2; ++bj)
#pragma unroll
            for (int n = 0; n < 2; ++n) { const f32x4 bv = bias ? *(const f32x4*)(bias + col0 + bj * HALF + n * 16) : (f32x4){0.f, 0.f, 0.f, 0.f};
#pragma unroll
                for (int ai = 0; ai < 2; ++ai)
#pragma unroll
                    for (int m = 0; m < 4; ++m) acc[ai][bj][m][n] += bv; }
        bool bad = st1.run(acc, u, wr, wc, fr, fq, lds, wid, lane) || poison != 0u;
        const float qnan = __builtin_nanf("");
#pragma unroll
        for (int ai = 0; ai < 2; ++ai)
#pragma unroll
            for (int m = 0; m < 4; ++m) { const int r = ai * HALF + wr * 64 + m * 16 + fr; const f32x2v sr = S[r]; const size_t off = (size_t)(u.pm * BM + r) * ldc + col0;
#pragma unroll
                for (int bj = 0; bj < 2; ++bj)
#pragma unroll
                    for (int n = 0; n < 2; ++n) { const f32x4 bs = *(const f32x4*)(base + off + bj * HALF + n * 16); acc[ai][bj][m][n] = bs + (acc[ai][bj][m][n] - sr.x) * sr.y; }
                asm volatile("" : "+v"(acc[ai][0][m][0]), "+v"(acc[ai][0][m][1]), "+v"(acc[ai][1][m][0]), "+v"(acc[ai][1][m][1]));
                if (m & 1) asm volatile("" ::: "memory"); }
        const bool bad1 = bad;
        bad = st2.run(acc, u, wr, wc, fr, fq, lds, wid, lane) || bad;
#pragma unroll
        for (int ai = 0; ai < 2; ++ai)
#pragma unroll
            for (int m = 0; m < 4; ++m) { const int r = ai * HALF + wr * 64 + m * 16 + fr; const f32x2v sr = S[r]; const size_t off = (size_t)(u.pm * BM + r) * ldc + col0;
#pragma unroll
                for (int bj = 0; bj < 2; ++bj)
#pragma unroll
                    for (int n = 0; n < 2; ++n) { const f32x4 x1 = acc[ai][bj][m][n]; *(f32x4*)(out + off + bj * HALF + n * 16) = bad1 ? (f32x4){qnan, qnan, qnan, qnan} : x1;
                        const f32x4 o = (x1 - sr.x) * sr.y; u32x2v w; w.x = cvt_pk_bf16(o[0], o[1]); w.y = cvt_pk_bf16(o[2], o[3]);
                        if (bad) { w.x = 0x7fc07fc0u; w.y = 0x7fc07fc0u; } *(u32x2v*)(xn + off + bj * HALF + n * 16) = w; }
                asm volatile("" ::: "memory"); }
    }
};

template <class Epi, class Sched, bool STAMP = false>
__device__ __forceinline__ void gemm_phase(PG8_LAS unsigned char* lds, const Gemm g, const Sched& S, const Epi& E, unsigned long long* stamps) {
    const int tid = threadIdx.x, wid = __builtin_amdgcn_readfirstlane(tid >> 6), lane = tid & 63, wr = wid >> 2, wc = wid & 3, fr = lane & 15, fq = lane >> 4;
    const int K = g.K, nt = K / BK;
    int ts_lo = 0, ts_hi = 0, nts = 0; const unsigned long long rt_entry = STAMP ? (unsigned long long)wall_clock64() : 0ull;
#define PG8_STAMP() do { if (STAMP && wid == 0 && nts < 64) { const unsigned long long _c = (unsigned long long)clock64(); \
        ts_lo = (lane == nts) ? (int)(unsigned)_c : ts_lo; ts_hi = (lane == nts) ? (int)(unsigned)(_c >> 32) : ts_hi; ++nts; } } while (0)
    PG8_STAMP();
    unsigned voffA[2], voffB[2];
#pragma unroll
    for (int i = 0; i < 2; ++i) { int R, C; stage_rc(tid * 16 + i * 8192, R, C); const int Rb = Epi::PERM ? ((R & ~31) + perm32(R & 31)) : R;
        voffA[i] = (unsigned)(R * K + C) * 2u; voffB[i] = (unsigned)(Rb * K + C) * 2u; }
    const size_t kstep = (size_t)(BK * 2);
    const size_t hstep = (size_t)HALF * K * 2;
    const size_t tstep = 2 * hstep;
    const unsigned ldsw = (unsigned)wid * 1024u;
    const int aoff = lds_byte(wr * 64 + fr, fq * 8), boff = lds_byte(wc * 32 + fr, fq * 8);
#define PG8_SA(b, h) (((b) * 2 + (h)) * HTB)
#define PG8_SB(b, h) ((4 + (b) * 2 + (h)) * HTB)
#define PG8_STAGE(bufoff, gbase, voff) do { _Pragma("unroll") for (int _i = 0; _i < 2; ++_i) \
        __builtin_amdgcn_global_load_lds((const unsigned*)((const char*)(gbase) + (voff)[_i]), (PG8_LAS unsigned*)(lds + (bufoff) + ldsw + _i * 8192), 16, 0, 0); } while (0)
#define PG8_LDA(dst, b, h) do { _Pragma("unroll") for (int m = 0; m < 4; ++m) _Pragma("unroll") for (int k = 0; k < 2; ++k) dst[m][k] = *(const PG8_LAS bf16x8*)(lds + PG8_SA(b, h) + aoff + m * 2048 + k * 1024); } while (0)
#define PG8_LDB(dst, b, h) do { _Pragma("unroll") for (int n = 0; n < 2; ++n) _Pragma("unroll") for (int k = 0; k < 2; ++k) dst[n][k] = *(const PG8_LAS bf16x8*)(lds + PG8_SB(b, h) + boff + n * 2048 + k * 1024); } while (0)
#define PG8_MMA(ai, bj, At, Bt) do { __builtin_amdgcn_s_setprio(1); _Pragma("unroll") for (int m = 0; m < 4; ++m) _Pragma("unroll") for (int n = 0; n < 2; ++n) _Pragma("unroll") for (int k = 0; k < 2; ++k) \
        acc[ai][bj][m][n] = __builtin_amdgcn_mfma_f32_16x16x32_bf16(Bt[n][k], At[m][k], acc[ai][bj][m][n], 0, 0, 0); __builtin_amdgcn_s_setprio(0); } while (0)
#define PG8_WAIT_V(n) asm volatile("s_waitcnt vmcnt(" #n ")" ::: "memory")
#define PG8_WAIT_L(n) asm volatile("s_waitcnt lgkmcnt(" #n ")" ::: "memory")
#define PG8_BAR __builtin_amdgcn_s_barrier()
#define PG8_SCHED __builtin_amdgcn_sched_barrier(0)
    Unit cur, nxt; int ui = 0;
    if (!S.next(0, cur)) return;
    f32x4 acc[2][2][4][2];
#pragma unroll
    for (int a = 0; a < 2; ++a)
#pragma unroll
        for (int b = 0; b < 2; ++b)
#pragma unroll
            for (int m = 0; m < 4; ++m)
#pragma unroll
                for (int n = 0; n < 2; ++n) acc[a][b][m][n] = (f32x4){0.f, 0.f, 0.f, 0.f};
    bf16x8 At[4][2], B0[2][2], B1[2][2];
    const char* cA = (const char*)g.A + (size_t)cur.pm * tstep; const char* cB = (const char*)g.Bt + (size_t)cur.pn * tstep;
    S.a_ready(cur);
    PG8_STAGE(PG8_SB(0, 0), cB, voffB); PG8_STAGE(PG8_SA(0, 0), cA, voffA); PG8_STAGE(PG8_SB(0, 1), cB + hstep, voffB); PG8_STAGE(PG8_SA(0, 1), cA + hstep, voffA);
    if (wr == 1) PG8_BAR;
    PG8_WAIT_V(4); PG8_BAR;
    PG8_STAGE(PG8_SB(1, 0), cB + kstep, voffB); PG8_STAGE(PG8_SA(1, 0), cA + kstep, voffA); PG8_STAGE(PG8_SB(1, 1), cB + hstep + kstep, voffB);
    PG8_WAIT_V(6); PG8_BAR;
    PG8_STAMP();
    for (;;) {
        const bool has_next = S.next(ui + 1, nxt);
        const char* nA = has_next ? (const char*)g.A + (size_t)nxt.pm * tstep : cA; const char* nB = has_next ? (const char*)g.Bt + (size_t)nxt.pn * tstep : cB;
        for (int t = 0; t < nt; t += 2) {
            const bool last = (t == nt - 2);
            const char* a1 = cA + (size_t)(t + 1) * kstep;
            const char* a2 = last ? nA : cA + (size_t)(t + 2) * kstep; const char* b2 = last ? nB : cB + (size_t)(t + 2) * kstep;
            const char* a3 = a2 + kstep; const char* b3 = b2 + kstep;
            if (last && has_next) S.a_ready(nxt);
            PG8_LDB(B0, 0, 0); PG8_SCHED; PG8_LDA(At, 0, 0); PG8_STAGE(PG8_SA(1, 1), a1 + hstep, voffA);
            PG8_WAIT_L(8); PG8_BAR; PG8_WAIT_L(0); PG8_MMA(0, 0, At, B0); PG8_BAR; PG8_SCHED;
            PG8_LDB(B1, 0, 1); PG8_STAGE(PG8_SB(0, 0), b2, voffB);
            PG8_BAR; PG8_WAIT_L(0); PG8_MMA(0, 1, At, B1); PG8_BAR;
            PG8_LDA(At, 0, 1); PG8_STAGE(PG8_SA(0, 0), a2, voffA);
            PG8_BAR; PG8_WAIT_L(0); PG8_MMA(1, 0, At, B0); PG8_BAR; PG8_SCHED;
            PG8_STAGE(PG8_SB(0, 1), b2 + hstep, voffB);
            PG8_WAIT_V(6); PG8_BAR; PG8_MMA(1, 1, At, B1); PG8_BAR;
            PG8_LDB(B0, 1, 0); PG8_SCHED; PG8_LDA(At, 1, 0); PG8_STAGE(PG8_SA(0, 1), a2 + hstep, voffA);
            PG8_WAIT_L(8); PG8_BAR; PG8_WAIT_L(0); PG8_MMA(0, 0, At, B0); PG8_BAR; PG8_SCHED;
            PG8_LDB(B1, 1, 1); PG8_STAGE(PG8_SB(1, 0), b3, voffB);
            PG8_BAR; PG8_WAIT_L(0); PG8_MMA(0, 1, At, B1); PG8_BAR;
            PG8_LDA(At, 1, 1); PG8_STAGE(PG8_SA(1, 0), a3, voffA);
            PG8_BAR; PG8_WAIT_L(0); PG8_MMA(1, 0, At, B0); PG8_BAR; PG8_SCHED;
            PG8_STAGE(PG8_SB(1, 1), b3 + hstep, voffB);
            PG8_WAIT_V(6); PG8_BAR; PG8_MMA(1, 1, At, B1); PG8_BAR;
        }
        PG8_STAMP();
        if constexpr (!Epi::AFTER_DRAIN) { E(acc, cur, wr, wc, fr, fq); S.done(cur); }
        PG8_STAMP();
        if (!has_next) break;
#pragma unroll
        for (int a = 0; a < 2; ++a)
#pragma unroll
            for (int b = 0; b < 2; ++b)
#pragma unroll
                for (int m = 0; m < 4; ++m)
#pragma unroll
                    for (int n = 0; n < 2; ++n) acc[a][b][m][n] = (f32x4){0.f, 0.f, 0.f, 0.f};
        cur = nxt; cA = nA; cB = nB; ++ui;
    }
    PG8_WAIT_V(0);
    if (wr == 0) PG8_BAR;
    PG8_BAR;
    if constexpr (Epi::AFTER_DRAIN) { E.fused(acc, cur, wr, wc, fr, fq, lds, wid, lane); S.done(cur); }
    PG8_STAMP();
    if (STAMP && wid == 0) { stamps[lane] = lane < nts ? (((unsigned long long)(unsigned)ts_hi << 32) | (unsigned)ts_lo) : 0ull;
        if (lane == 62) stamps[62] = rt_entry; if (lane == 63) stamps[63] = (unsigned long long)wall_clock64(); }
#undef PG8_STAMP
#undef PG8_SA
#undef PG8_SB
#undef PG8_STAGE
#undef PG8_LDA
#undef PG8_LDB
#undef PG8_MMA
#undef PG8_WAIT_V
#undef PG8_WAIT_L
#undef PG8_BAR
#undef PG8_SCHED
}
}

#define LAS __attribute__((address_space(3)))
typedef unsigned short bf16_t;
typedef short bf16x8 __attribute__((ext_vector_type(8)));
typedef float f32x4 __attribute__((ext_vector_type(4)));
typedef unsigned u32x4 __attribute__((ext_vector_type(4)));
typedef unsigned u32x2 __attribute__((ext_vector_type(2)));
typedef __bf16 bf2_t __attribute__((ext_vector_type(2)));
typedef _Float16 h2_t __attribute__((ext_vector_type(2)));

constexpr int NTOK = 65536, DM = 1024, NTOK_P = 32768;
constexpr int L0 = 8192, L1 = 4096;
constexpr float ALPHA_C = 1.189207115002721f;
constexpr float LN_EPS_C = 1e-5f;
constexpr int NTHREADS = 512;
constexpr int NPHASE = 10;
constexpr int LDS_BYTES = 153600;
constexpr size_t MiB = 1024ull * 1024ull;
constexpr size_t WS_XB = 0;
constexpr size_t WS_PH = 128 * MiB;
constexpr size_t WS_ZT = 320 * MiB;
constexpr size_t WS_U8 = 384 * MiB, WS_V8 = 400 * MiB;
constexpr size_t WS_PARTD = 128 * MiB;
constexpr float U_SCALE = 128.0f, V_SCALE = 16.0f;
constexpr size_t WS_WINT = 448 * MiB, WS_WOUTT = 454 * MiB, WS_WPT = 456 * MiB;
constexpr size_t WS_FG = 460 * MiB;
constexpr size_t WS_PART = 484 * MiB;
constexpr size_t WS_DUMMY = 492 * MiB;
constexpr size_t WS_BAR = 497 * MiB;
constexpr size_t WS_END = 498 * MiB;
constexpr size_t WS_EIDX = 416 * MiB, WS_GATE = 460 * MiB;
constexpr size_t OUT_X0T = 192 * MiB;

struct Params { const float* in[24]; float* out; unsigned char* ws; int ph_lo, ph_hi, nrep, pad; };

__device__ __forceinline__ unsigned pack2bf(float lo, float hi) { return pg8::cvt_pk_bf16(lo, hi); }
__device__ __forceinline__ float bf_lo(unsigned w) { return __uint_as_float(w << 16); }
__device__ __forceinline__ float bf_hi(unsigned w) { return __uint_as_float(w & 0xffff0000u); }
__device__ __forceinline__ unsigned short f2bf(float f) { return (unsigned short)(pack2bf(f, 0.f) & 0xffffu); }

__device__ __forceinline__ void seq_of(int tok0, int& seq, int& L, int& tl) {
    if (tok0 < NTOK_P) { seq = tok0 >> 13; L = L0; tl = tok0 & (L0 - 1); }
    else { const int r = tok0 - NTOK_P; seq = 4 + (r >> 12); L = L1; tl = r & (L1 - 1); }
}
__device__ __forceinline__ size_t seq_base_T(int seq) { return seq < 4 ? (size_t)seq * 512 * L0 : (size_t)4 * 512 * L0 + (size_t)(seq - 4) * 512 * L1; }

struct EpiP {
    static constexpr bool PERM = true, AFTER_DRAIN = false;
    bf16_t* PA; bf16_t* PH; const float* bias;
    __device__ __forceinline__ void operator()(const f32x4 (&acc)[2][2][4][2], const pg8::Unit& u, int wr, int wc, int fr, int fq) const {
        const int row0 = u.pm * 256 + wr * 64 + fr, lc = wc * 32 + 8 * fq;
        if (u.pn >= 2 && u.pn < 6) {
            const int ch0 = (u.pn - 2) * 128 + lc;
            f32x4 bc[2], bh[2];
#pragma unroll
            for (int n = 0; n < 2; ++n) { bc[n] = *(const f32x4*)(bias + 512 + ch0 + 4 * n); bh[n] = *(const f32x4*)(bias + 1024 + ch0 + 4 * n); }
#pragma unroll
            for (int ai = 0; ai < 2; ++ai)
#pragma unroll
                for (int m = 0; m < 4; ++m) { const f32x4 g0 = (acc[ai][0][m][0] + bc[0]) * (acc[ai][1][m][0] + bh[0]), g1 = (acc[ai][0][m][1] + bc[1]) * (acc[ai][1][m][1] + bh[1]);
                    u32x4 w; w.x = pack2bf(g0[0], g0[1]); w.y = pack2bf(g0[2], g0[3]); w.z = pack2bf(g1[0], g1[1]); w.w = pack2bf(g1[2], g1[3]);
                    *(u32x4*)(PA + (size_t)(row0 + ai * 128 + m * 16) * 1024 + 512 + ch0) = w; }
        } else {
            const bool isB = u.pn < 2; bf16_t* base = isB ? PA : PH; const int pitch = isB ? 1024 : 1536;
            const int colt = isB ? u.pn * 256 : u.pn * 256 - 1536, bcol0 = u.pn * 256 + lc;
            f32x4 bv[2][2];
#pragma unroll
            for (int bj = 0; bj < 2; ++bj)
#pragma unroll
                for (int n = 0; n < 2; ++n) bv[bj][n] = *(const f32x4*)(bias + bcol0 + bj * 128 + 4 * n);
#pragma unroll
            for (int ai = 0; ai < 2; ++ai)
#pragma unroll
                for (int m = 0; m < 4; ++m) { bf16_t* rowp = base + (size_t)(row0 + ai * 128 + m * 16) * pitch + colt + lc;
#pragma unroll
                    for (int bj = 0; bj < 2; ++bj) { const f32x4 v0 = acc[ai][bj][m][0] + bv[bj][0], v1 = acc[ai][bj][m][1] + bv[bj][1];
                        u32x4 w; w.x = pack2bf(v0[0], v0[1]); w.y = pack2bf(v0[2], v0[3]); w.z = pack2bf(v1[0], v1[1]); w.w = pack2bf(v1[2], v1[3]);
                        *(u32x4*)(rowp + bj * 128) = w; } }
        }
    }
};
struct EpiH1 {
    static constexpr bool PERM = true, AFTER_DRAIN = false;
    const float* xp; const float* xs; bf16_t* out;
    __device__ __forceinline__ void operator()(const f32x4 (&acc)[2][2][4][2], const pg8::Unit& u, int wr, int wc, int fr, int fq) const {
        const int row0 = u.pm * 256 + wr * 64 + fr, col0 = u.pn * 256 + wc * 32 + 8 * fq;
        const float* xb = (u.pm * 256 < NTOK_P) ? xp : (xs - (size_t)NTOK_P * DM);
#pragma unroll
        for (int ai = 0; ai < 2; ++ai)
#pragma unroll
            for (int m = 0; m < 4; ++m) { const size_t off = (size_t)(row0 + ai * 128 + m * 16) * DM + col0;
#pragma unroll
                for (int bj = 0; bj < 2; ++bj) { const f32x4 x0 = *(const f32x4*)(xb + off + bj * 128), x1 = *(const f32x4*)(xb + off + bj * 128 + 4);
                    const f32x4 v0 = x0 * ALPHA_C + acc[ai][bj][m][0], v1 = x1 * ALPHA_C + acc[ai][bj][m][1];
                    u32x4 w; w.x = pack2bf(v0[0], v0[1]); w.y = pack2bf(v0[2], v0[3]); w.z = pack2bf(v1[0], v1[1]); w.w = pack2bf(v1[2], v1[3]);
                    *(u32x4*)(out + off + bj * 128) = w; } }
    }
};
struct EpiS {
    static constexpr bool PERM = true, AFTER_DRAIN = false;
    unsigned short* S;
    __device__ __forceinline__ void operator()(const f32x4 (&acc)[2][2][4][2], const pg8::Unit& u, int wr, int wc, int fr, int fq) const {
        const int row0 = u.pm * 256 + wr * 64 + fr, col0 = u.pn * 256 + wc * 32 + 8 * fq;
#pragma unroll
        for (int ai = 0; ai < 2; ++ai)
#pragma unroll
            for (int m = 0; m < 4; ++m) { unsigned short* rowp = S + (size_t)(row0 + ai * 128 + m * 16) * 2048 + col0;
#pragma unroll
                for (int bj = 0; bj < 2; ++bj) { const f32x4 v0 = acc[ai][bj][m][0], v1 = acc[ai][bj][m][1];
                    u32x4 w;
                    w.x = __builtin_bit_cast(unsigned, __builtin_amdgcn_cvt_pkrtz(v0[0], v0[1])); w.y = __builtin_bit_cast(unsigned, __builtin_amdgcn_cvt_pkrtz(v0[2], v0[3]));
                    w.z = __builtin_bit_cast(unsigned, __builtin_amdgcn_cvt_pkrtz(v1[0], v1[1])); w.w = __builtin_bit_cast(unsigned, __builtin_amdgcn_cvt_pkrtz(v1[2], v1[3]));
                    *(u32x4*)(rowp + bj * 128) = w; } }
    }
};

__device__ void cvt_f32_bf16(const float* __restrict__ s, bf16_t* __restrict__ d, size_t n8) {
    const size_t q = n8 >> 2;
    for (size_t i = (size_t)blockIdx.x * NTHREADS + threadIdx.x; i < q; i += (size_t)gridDim.x * NTHREADS) {
        float4 a[4], b[4];
#pragma unroll
        for (int k = 0; k < 4; ++k) { const f32x4 ta = __builtin_nontemporal_load((const f32x4*)s + 2 * (i + k * q)), tb = __builtin_nontemporal_load((const f32x4*)s + 2 * (i + k * q) + 1);
            a[k] = make_float4(ta[0], ta[1], ta[2], ta[3]); b[k] = make_float4(tb[0], tb[1], tb[2], tb[3]); }
#pragma unroll
        for (int k = 0; k < 4; ++k) { u32x4 w; w.x = pack2bf(a[k].x, a[k].y); w.y = pack2bf(a[k].z, a[k].w); w.z = pack2bf(b[k].x, b[k].y); w.w = pack2bf(b[k].z, b[k].w);
            ((u32x4*)d)[i + k * q] = w; }
    }
}
__device__ __forceinline__ unsigned pack4fp8(float a, float b, float c, float d) { int p = 0; p = __builtin_amdgcn_cvt_pk_fp8_f32(a, b, p, false); p = __builtin_amdgcn_cvt_pk_fp8_f32(c, d, p, true); return (unsigned)p; }
__device__ void cvt_f32_fp8(const float* __restrict__ s, unsigned char* __restrict__ d, size_t n16, float sc) {
    const size_t h = n16 >> 1;
    for (size_t i0 = (size_t)blockIdx.x * NTHREADS + threadIdx.x; i0 < h; i0 += (size_t)gridDim.x * NTHREADS) {
        float4 v[2][4];
#pragma unroll
        for (int k = 0; k < 2; ++k)
#pragma unroll
            for (int j = 0; j < 4; ++j) { const f32x4 t = __builtin_nontemporal_load((const f32x4*)s + 4 * (i0 + k * h) + j); v[k][j] = make_float4(t[0], t[1], t[2], t[3]); }
#pragma unroll
        for (int k = 0; k < 2; ++k) { const size_t i = i0 + k * h; const float4 a = v[k][0], b = v[k][1], c = v[k][2], e = v[k][3];
            u32x4 w; w.x = pack4fp8(a.x * sc, a.y * sc, a.z * sc, a.w * sc); w.y = pack4fp8(b.x * sc, b.y * sc, b.z * sc, b.w * sc); w.z = pack4fp8(c.x * sc, c.y * sc, c.z * sc, c.w * sc); w.w = pack4fp8(e.x * sc, e.y * sc, e.z * sc, e.w * sc);
            const size_t er = i >> 6, kk = i & 63;
            *(u32x4*)(d + ((kk >> 3) * 16384 + er) * 128 + (kk & 7) * 16) = w; }
    }
}
__device__ __forceinline__ int win_perm(int c) { if (c < 512 || c >= 1536) return c; const int ch = (c - 512) & 511, hsel = (c >= 1024) ? 128 : 0; return 512 + (ch >> 7) * 256 + hsel + (ch & 127); }
template <bool PERM_WIN>
__device__ void transpose_cvt(const float* __restrict__ src, int R, int C, bf16_t* __restrict__ dst, float* tile  ) {
    const int tid = threadIdx.x, nct = C / 64, nu = (R / 64) * nct;
    for (int u = blockIdx.x; u < nu; u += gridDim.x) {
        const int r0 = (u / nct) * 64, c0 = (u % nct) * 64;
        { const int r = tid >> 3, c8 = (tid & 7) * 8; const float4 a = *(const float4*)(src + (size_t)(r0 + r) * C + c0 + c8), b = *(const float4*)(src + (size_t)(r0 + r) * C + c0 + c8 + 4);
          float* t = tile + r * 65 + c8; t[0] = a.x; t[1] = a.y; t[2] = a.z; t[3] = a.w; t[4] = b.x; t[5] = b.y; t[6] = b.z; t[7] = b.w; }
        __syncthreads();
        { const int c = tid >> 3, r8 = (tid & 7) * 8; float v[8];
#pragma unroll
          for (int k = 0; k < 8; ++k) v[k] = tile[(r8 + k) * 65 + c];
          u32x4 w; w.x = pack2bf(v[0], v[1]); w.y = pack2bf(v[2], v[3]); w.z = pack2bf(v[4], v[5]); w.w = pack2bf(v[6], v[7]);
          *(u32x4*)(dst + (size_t)(PERM_WIN ? win_perm(c0 + c) : (c0 + c)) * R + r0 + r8) = w; }
        __syncthreads();
    }
}
__device__ void fold_wq_keys(const float* __restrict__ wq, const float* __restrict__ keys, bf16_t* __restrict__ WpT, float* lds) {
    float* sk = lds; float* sw = lds + 64 * 132;
    const int tid = threadIdx.x;
    for (int u = blockIdx.x; u < 512; u += gridDim.x) {
        const int hp = u >> 5, n0 = ((u >> 4) & 1) * 64, d0 = (u & 15) * 64;
        for (int i = tid; i < 64 * 32; i += NTHREADS) { const int r = i >> 5, k4 = (i & 31) * 4;
            const float4 a = *(const float4*)(keys + ((size_t)hp * 128 + n0 + r) * 128 + k4); float* t = sk + r * 132 + k4; t[0] = a.x; t[1] = a.y; t[2] = a.z; t[3] = a.w;
            const float4 b = *(const float4*)(wq + (size_t)(d0 + r) * 2048 + hp * 128 + k4); float* s = sw + r * 132 + k4; s[0] = b.x; s[1] = b.y; s[2] = b.z; s[3] = b.w; }
        __syncthreads();
        const int ni = tid >> 3, dj = tid & 7; float acc[8];
#pragma unroll
        for (int q = 0; q < 8; ++q) acc[q] = 0.f;
        for (int k = 0; k < 128; ++k) { const float a = sk[ni * 132 + k];
#pragma unroll
            for (int q = 0; q < 8; ++q) acc[q] += a * sw[(dj + 8 * q) * 132 + k]; }
#pragma unroll
        for (int q = 0; q < 8; ++q) WpT[((size_t)hp * 128 + n0 + ni) * 1024 + d0 + dj + 8 * q] = f2bf(acc[q]);
        __syncthreads();
    }
}
__device__ void hyena_filter_gen(const Params& p, float* lds) {
    const float* w1 = p.in[7]; const float* b1 = p.in[8]; const float* fr = p.in[9]; const float* w2 = p.in[10]; const float* b2 = p.in[11]; const float* w3 = p.in[12]; const float* dec = p.in[13];
    bf16_t* Fg = (bf16_t*)(p.ws + WS_FG); float* part = (float*)(p.ws + WS_PART);
    constexpr int NG = 3, NP = NG * 16;
    float* sfeat = lds; float* sh1 = sfeat + NP * 33; float* sh2 = sh1 + NP * 64;
    float* sw1 = sh2 + NP * 64; float* sw2 = sw1 + 33 * 64; float* sb1 = sw2 + 64 * 64; float* sb2 = sb1 + 64; float* sfr = sb2 + 64;
    const int tid = threadIdx.x, c = tid;
    for (int i = tid; i < 33 * 64; i += NTHREADS) sw1[i] = w1[i];
    for (int i = tid; i < 64 * 64; i += NTHREADS) sw2[i] = w2[i];
    if (tid < 64) { sb1[tid] = b1[tid]; sb2[tid] = b2[tid]; sfr[tid] = fr[tid]; }
    for (int idx = tid; idx < NP * 33; idx += NTHREADS) { const int q = idx / 33, f = idx % 33, it = (int)blockIdx.x + (q >> 4) * (int)gridDim.x;
        const int variant = it >= 512, L = variant ? L1 : L0, n = (variant ? it - 512 : it) * 16 + (q & 15); float val;
        if (f == 0) val = (float)n * (1.0f / (float)(L - 1));
        else { const int band = (f - 1) & 15; const float fj = 1e-4f + (float)band * ((15.0f - 1e-4f) / 15.0f); const float w = 6.283185307179586f * (float)n / (float)L; const float arg = fj * w;
               val = (f - 1) >= 16 ? -sinf(arg) : cosf(arg); }
        sfeat[idx] = val; }
    __syncthreads();
    for (int idx = tid; idx < NP * 64; idx += NTHREADS) { const int q = idx >> 6, j = idx & 63; float s = sb1[j];
#pragma unroll
        for (int f = 0; f < 33; ++f) s += sfeat[q * 33 + f] * sw1[f * 64 + j];
        sh1[idx] = sinf(sfr[j] * s); }
    __syncthreads();
    for (int idx = tid; idx < NP * 64; idx += NTHREADS) { const int q = idx >> 6, j = idx & 63; float s = sb2[j];
#pragma unroll 16
        for (int i = 0; i < 64; ++i) s += sh1[q * 64 + i] * sw2[i * 64 + j];
        sh2[idx] = sinf(sfr[j] * s); }
    __syncthreads();
    float acc0[NP], acc1[NP];
#pragma unroll
    for (int q = 0; q < NP; ++q) { acc0[q] = 0.f; acc1[q] = 0.f; }
#pragma unroll 2
    for (int j = 0; j < 64; ++j) { const float wa = w3[j * 1024 + c], wb = w3[j * 1024 + 512 + c];
#pragma unroll
        for (int q = 0; q < NP; ++q) { const float h = sh2[q * 64 + j]; acc0[q] += h * wa; acc1[q] += h * wb; } }
    const float a0 = fabsf(dec[c]), a1 = fabsf(dec[512 + c]);
    float sum0 = 0.f, sum1 = 0.f;
#pragma unroll
    for (int g = 0; g < NG; ++g) { const int it = (int)blockIdx.x + g * (int)gridDim.x;
        if (it < 768) { const int variant = it >= 512, L = variant ? L1 : L0, n0 = (variant ? it - 512 : it) * 16; const float tstep = 1.0f / (float)(L - 1);
            bf16_t* Fc = Fg + (variant ? (size_t)512 * 2 * L0 : 0) + (size_t)c * 2 * L; float s = 0.f;
#pragma unroll
            for (int pp = 0; pp < 16; ++pp) { const int n = n0 + pp; const float t = (float)n * tstep;
                const float v0 = acc0[g * 16 + pp] * expf(-t * a0), v1 = acc1[g * 16 + pp] * expf(-t * a1);
                s += fabsf(v0); Fc[L - n] = f2bf(v0);
                if (n >= 1) { s += fabsf(v1); Fc[L + n] = f2bf(v1); } else Fc[0] = 0; }
            if (variant) sum1 += s; else sum0 += s; } }
    part[((size_t)0 * 1024 + blockIdx.x) * 512 + c] = sum0;
    part[((size_t)1 * 1024 + blockIdx.x) * 512 + c] = sum1;
    __syncthreads();
}

__device__ __forceinline__ void unpack8(const u32x4 w, float (&f)[8]) { f[0] = bf_lo(w.x); f[1] = bf_hi(w.x); f[2] = bf_lo(w.y); f[3] = bf_hi(w.y); f[4] = bf_lo(w.z); f[5] = bf_hi(w.z); f[6] = bf_lo(w.w); f[7] = bf_hi(w.w); }
__device__ void phase_conv3(const Params& p, unsigned char* lds) {
    const bf16_t* PA = (const bf16_t*)p.out; const bf16_t* PH = (const bf16_t*)(p.ws + WS_PH);
    bf16_t* Ycat = (bf16_t*)(p.ws + WS_XB); bf16_t* zT = (bf16_t*)(p.ws + WS_ZT); bf16_t* x0T = (bf16_t*)((unsigned char*)p.out + OUT_X0T);
    const float* acw = p.in[4]; const float* hcw = p.in[5]; const float* hcb = p.in[6];
    bf16_t* sx0 = (bf16_t*)lds; bf16_t* sz = sx0 + 64 * 66;
    const int tid = threadIdx.x, r = tid >> 3, cg8 = tid & 7;
    const int ct = blockIdx.x & 7, c0 = ct * 64 + cg8 * 8;
    for (int tt = blockIdx.x >> 3; tt < 1024; tt += gridDim.x >> 3) {
        const int tok0 = tt * 64; int seq, L, tl; seq_of(tok0, seq, L, tl);
        const int tok = tok0 + r, pos = tl + r;
        const bool hp = pos > 0, hn = pos < L - 1;
        const u32x4 zero4 = {0u, 0u, 0u, 0u};
        { const bf16_t* row = PA + (size_t)tok * 1024 + c0;
          float ab[8], gc[8], gp[8], gn[8];
          unpack8(*(const u32x4*)row, ab); unpack8(*(const u32x4*)(row + 512), gc);
          unpack8(hp ? *(const u32x4*)(row - 1024 + 512) : zero4, gp); unpack8(hn ? *(const u32x4*)(row + 1024 + 512) : zero4, gn);
          float y[8];
#pragma unroll
          for (int k = 0; k < 8; ++k) y[k] = ab[k] * (acw[c0 + k] * gp[k] + acw[512 + c0 + k] * gc[k] + acw[1024 + c0 + k] * gn[k]);
          u32x4 w; w.x = pack2bf(y[0], y[1]); w.y = pack2bf(y[2], y[3]); w.z = pack2bf(y[4], y[5]); w.w = pack2bf(y[6], y[7]);
          *(u32x4*)(Ycat + (size_t)tok * DM + c0) = w; }
        { const bf16_t* row = PH + (size_t)tok * 1536 + c0; float hy[3][8];
#pragma unroll
          for (int part = 0; part < 3; ++part) { float vp[8], vc[8], vn[8]; const bf16_t* rp = row + part * 512; const int cc = part * 512 + c0;
              unpack8(*(const u32x4*)rp, vc); unpack8(hp ? *(const u32x4*)(rp - 1536) : zero4, vp); unpack8(hn ? *(const u32x4*)(rp + 1536) : zero4, vn);
#pragma unroll
              for (int k = 0; k < 8; ++k) hy[part][k] = hcw[cc + k] * vp[k] + hcw[1536 + cc + k] * vc[k] + hcw[3072 + cc + k] * vn[k] + hcb[cc + k]; }
#pragma unroll
          for (int k = 0; k < 8; ++k) { sx0[(cg8 * 8 + k) * 66 + r] = f2bf(hy[0][k]); sz[(cg8 * 8 + k) * 66 + r] = f2bf(hy[2][k] * hy[1][k]); } }
        __syncthreads();
        { const int c = tid >> 3, ch = tid & 7; const unsigned* s0 = (const unsigned*)(sx0 + c * 66 + ch * 8); const unsigned* s1 = (const unsigned*)(sz + c * 66 + ch * 8);
          u32x4 w0 = {s0[0], s0[1], s0[2], s0[3]}, w1 = {s1[0], s1[1], s1[2], s1[3]};
          const size_t o = seq_base_T(seq) + (size_t)(ct * 64 + c) * L + tl + ch * 8;
          *(u32x4*)(x0T + o) = w0; *(u32x4*)(zT + o) = w1; }
        __syncthreads();
    }
}

__device__ void phase_longconv(const Params& p, unsigned char* ldsg) {
    LAS unsigned char* lds = (LAS unsigned char*)ldsg;
    const bf16_t* Fg = (const bf16_t*)(p.ws + WS_FG); const float* part = (const float*)(p.ws + WS_PART);
    const bf16_t* zT = (const bf16_t*)(p.ws + WS_ZT); const bf16_t* x0T = (const bf16_t*)((const unsigned char*)p.out + OUT_X0T);
    bf16_t* yhT = (bf16_t*)(p.ws + WS_PH); const float* hyb = p.in[14];
    constexpr int ZSTR = 160, F1OFF = 32768 + 64, ZOFF = 65664, ZERO = ZOFF + 4 * 128 * ZSTR, SCAL = ZERO + 176;
    const int tid = threadIdx.x, wave = __builtin_amdgcn_readfirstlane(tid >> 6), lane = tid & 63, n = lane & 15, kq = lane >> 4;
    for (int u = blockIdx.x; u < 1024; u += gridDim.x) {
        const int variant = u >= 512, c = u & 511, L = variant ? L1 : L0, nb = L >> 6, nseq = variant ? 8 : 4;
        const bf16_t* Fc = Fg + (variant ? (size_t)512 * 2 * L0 : 0) + (size_t)c * 2 * L;
        for (int i = tid; i < (2 * L) / 8; i += NTHREADS) *(LAS u32x4*)(lds + i * 16) = ((const u32x4*)Fc)[i];
        for (int i = tid; i < nseq * (L / 8); i += NTHREADS) { const int b = i / (L / 8), q = i % (L / 8);
            const int seq = variant ? 4 + b : b;
            *(LAS u32x4*)(lds + ZOFF + (b * nb + (q >> 3)) * ZSTR + (q & 7) * 16) = *(const u32x4*)(zT + seq_base_T(seq) + (size_t)c * L + q * 8); }
        if (tid < 36) *(LAS unsigned*)(lds + ZERO + tid * 4) = 0u;
        if (wave == 0) { float s = 0.f; for (int b = lane; b < (int)gridDim.x; b += 64) s += part[((size_t)variant * 1024 + b) * 512 + c];
#pragma unroll
            for (int o = 32; o >= 1; o >>= 1) s += __shfl_xor(s, o);
            if (lane == 0) *(LAS float*)(lds + SCAL) = 1.0f / s; }
        __syncthreads();
        for (int i = tid; i < L; i += NTHREADS) { const unsigned a = *(LAS unsigned*)(lds + i * 4); const unsigned b = (i + 1 < L) ? *(LAS unsigned*)(lds + i * 4 + 4) : 0u;
            *(LAS unsigned*)(lds + F1OFF + i * 4) = (a >> 16) | (b << 16); }
        __syncthreads();
        const float inv = *(LAS float*)(lds + SCAL);
        const int jt = variant ? (wave & 3) : wave, bbase = variant ? 4 * (wave >> 2) : 0, Jc = 16 * jt + n;
        f32x4 acc[4][4];
#pragma unroll
        for (int mi = 0; mi < 4; ++mi)
#pragma unroll
            for (int nt = 0; nt < 4; ++nt) acc[mi][nt] = (f32x4){0.f, 0.f, 0.f, 0.f};
        const int cl = ((n & 1) ? F1OFF - 2 : 0) + 2 * (L + 8 * kq - n);
        const int zrow = ZOFF + bbase * nb * ZSTR + kq * 16, zseq = nb * ZSTR;
        const int dbeg = 16 * jt - (nb - 1), dend = 16 * jt + 15, zzero = ZERO + kq * 16;
#define LC_LOAD(A_, P_, B_, dd, FIRST) do { const int d_ = min((dd), dend); const int abase_ = cl - 128 * d_; \
            if (!(FIRST)) { A_[0] = P_[4]; A_[1] = P_[5]; }     \
            _Pragma("unroll") for (int ai = (FIRST) ? 0 : 2; ai < 6; ++ai) { const LAS unsigned* fp = (const LAS unsigned*)(lds + abase_ - 32 * (ai - 2)); const u32x4 w_ = {fp[0], fp[1], fp[2], fp[3]}; A_[ai] = __builtin_bit_cast(bf16x8, w_); } \
            const int blk_ = Jc - d_; const bool bv_ = (unsigned)blk_ < (unsigned)nb; \
            _Pragma("unroll") for (int nt = 0; nt < 4; ++nt) { const int ad_ = bv_ ? zrow + nt * zseq + blk_ * ZSTR : zzero; \
                B_[2 * nt] = *(const LAS bf16x8*)(lds + ad_); B_[2 * nt + 1] = *(const LAS bf16x8*)(lds + ad_ + 64); } } while (0)
#define LC_MMA(A_, B_) do { __builtin_amdgcn_s_setprio(1); \
            _Pragma("unroll") for (int nt = 0; nt < 4; ++nt) _Pragma("unroll") for (int mi = 0; mi < 4; ++mi) { \
                acc[mi][nt] = __builtin_amdgcn_mfma_f32_16x16x32_bf16(A_[mi + 2], B_[2 * nt], acc[mi][nt], 0, 0, 0); \
                acc[mi][nt] = __builtin_amdgcn_mfma_f32_16x16x32_bf16(A_[mi], B_[2 * nt + 1], acc[mi][nt], 0, 0, 0); } \
            __builtin_amdgcn_s_setprio(0); } while (0)
        bf16x8 aX[6], bX[8], aY[6], bY[8];
        LC_LOAD(aX, aY, bX, dbeg, true);
        for (int d = dbeg; d <= dend; d += 2) {
            LC_LOAD(aY, aX, bY, d + 1, false);
            LC_MMA(aX, bX);
            LC_LOAD(aX, aY, bX, d + 2, false);
            if (d + 1 <= dend) LC_MMA(aY, bY);
        }
#undef LC_LOAD
#undef LC_MMA
        const float hb = hyb[c];
#pragma unroll
        for (int nt = 0; nt < 4; ++nt) { const int b = bbase + nt, seq = variant ? 4 + b : b; const size_t gbase = seq_base_T(seq) + (size_t)c * L; const int J = Jc;
#pragma unroll
            for (int mi = 0; mi < 4; ++mi) { const int i0 = 16 * mi + 4 * kq; const size_t o = gbase + (size_t)J * 64 + i0;
                const u32x2 zw = *(const LAS u32x2*)(lds + ZOFF + (b * nb + J) * ZSTR + i0 * 2); const u32x2 xw = *(const u32x2*)(x0T + o);
                const f32x4 v = acc[mi][nt];
                const float y0 = bf_lo(xw.x) * (v[0] * inv + hb * bf_lo(zw.x)), y1 = bf_hi(xw.x) * (v[1] * inv + hb * bf_hi(zw.x));
                const float y2 = bf_lo(xw.y) * (v[2] * inv + hb * bf_lo(zw.y)), y3 = bf_hi(xw.y) * (v[3] * inv + hb * bf_hi(zw.y));
                u32x2 w; w.x = pack2bf(y0, y1); w.y = pack2bf(y2, y3); *(u32x2*)(yhT + o) = w; } }
        __syncthreads();
    }
}

__device__ void phase_yh_transpose(const Params& p, unsigned char* lds) {
    const bf16_t* yhT = (const bf16_t*)(p.ws + WS_PH); bf16_t* Ycat = (bf16_t*)(p.ws + WS_XB);
    bf16_t* st = (bf16_t*)lds; const int tid = threadIdx.x;
    for (int u = blockIdx.x; u < 8192; u += gridDim.x) {
        const int tt = u >> 3, ct = u & 7, tok0 = tt * 64; int seq, L, tl; seq_of(tok0, seq, L, tl);
        { const int c = tid >> 3, ch = tid & 7; const u32x4 w = *(const u32x4*)(yhT + seq_base_T(seq) + (size_t)(ct * 64 + c) * L + tl + ch * 8);
          unsigned* s = (unsigned*)(st + c * 66 + ch * 8); s[0] = w.x; s[1] = w.y; s[2] = w.z; s[3] = w.w; }
        __syncthreads();
        { const int r = tid >> 3, cg8 = tid & 7; unsigned short v[8];
#pragma unroll
          for (int k = 0; k < 8; ++k) v[k] = st[(cg8 * 8 + k) * 66 + r];
          u32x4 w; w.x = v[0] | ((unsigned)v[1] << 16); w.y = v[2] | ((unsigned)v[3] << 16); w.z = v[4] | ((unsigned)v[5] << 16); w.w = v[6] | ((unsigned)v[7] << 16);
          *(u32x4*)(Ycat + (size_t)(tok0 + r) * DM + 512 + ct * 64 + cg8 * 8) = w; }
        __syncthreads();
    }
}

template <bool OUT_BF16>
__device__ __forceinline__ void ln_rows2(const bf16_t* __restrict__ hin, float* __restrict__ outf, bf16_t* __restrict__ outb, const float* __restrict__ g, const float* __restrict__ be, int row_lo, int row_hi, int wv0, int nwv) {
    const int lane = threadIdx.x & 63;
    for (int row = row_lo + wv0 * 2; row < row_hi; row += nwv * 2) {
        float4 v[2][4]; float s[2] = {0.f, 0.f};
#pragma unroll
        for (int r = 0; r < 2; ++r)
#pragma unroll
            for (int k = 0; k < 4; ++k) { const u32x2 w = ((const u32x2*)(hin + (size_t)(row + r) * DM))[lane + 64 * k]; v[r][k] = make_float4(bf_lo(w.x), bf_hi(w.x), bf_lo(w.y), bf_hi(w.y)); }
#pragma unroll
        for (int r = 0; r < 2; ++r)
#pragma unroll
            for (int k = 0; k < 4; ++k) s[r] += (v[r][k].x + v[r][k].y) + (v[r][k].z + v[r][k].w);
#pragma unroll
        for (int o = 32; o >= 1; o >>= 1) { s[0] += __shfl_xor(s[0], o); s[1] += __shfl_xor(s[1], o); }
        float q[2] = {0.f, 0.f}; const float mu[2] = {s[0] * (1.0f / DM), s[1] * (1.0f / DM)};
#pragma unroll
        for (int r = 0; r < 2; ++r)
#pragma unroll
            for (int k = 0; k < 4; ++k) { const float a = v[r][k].x - mu[r], b = v[r][k].y - mu[r], c = v[r][k].z - mu[r], d = v[r][k].w - mu[r]; q[r] += (a * a + b * b) + (c * c + d * d); }
#pragma unroll
        for (int o = 32; o >= 1; o >>= 1) { q[0] += __shfl_xor(q[0], o); q[1] += __shfl_xor(q[1], o); }
        const float rstd[2] = {1.0f / sqrtf(q[0] * (1.0f / DM) + LN_EPS_C), 1.0f / sqrtf(q[1] * (1.0f / DM) + LN_EPS_C)};
#pragma unroll
        for (int k = 0; k < 4; ++k) { const float4 gg = ((const float4*)g)[lane + 64 * k], bb = ((const float4*)be)[lane + 64 * k];
#pragma unroll
            for (int r = 0; r < 2; ++r) { float4 y;
                y.x = (v[r][k].x - mu[r]) * rstd[r] * gg.x + bb.x; y.y = (v[r][k].y - mu[r]) * rstd[r] * gg.y + bb.y; y.z = (v[r][k].z - mu[r]) * rstd[r] * gg.z + bb.z; y.w = (v[r][k].w - mu[r]) * rstd[r] * gg.w + bb.w;
                if (OUT_BF16) { u32x2 w; w.x = pack2bf(y.x, y.y); w.y = pack2bf(y.z, y.w); ((u32x2*)(outb + (size_t)(row + r) * DM))[lane + 64 * k] = w; }
                else { const f32x4 yv = {y.x, y.y, y.z, y.w}; __builtin_nontemporal_store(yv, (f32x4*)(outf + (size_t)(row + r) * DM) + lane + 64 * k); } } }
    }
}
__device__ void phase_ln1_panel(const Params& p, int pm) { ln_rows2<true>((const bf16_t*)p.out, nullptr, (bf16_t*)(p.ws + WS_XB), p.in[16], p.in[17], pm * 256, pm * 256 + 256, threadIdx.x >> 6, 8); }

__device__ __forceinline__ int f2key(float f) { const int b = __float_as_int(f); return b ^ ((b >> 31) & 0x7fffffff); }
__device__ __forceinline__ float key2f(int k) { return __int_as_float(k ^ ((k >> 31) & 0x7fffffff)); }
__device__ __forceinline__ void sort16_desc(int (&k)[16]) {
    constexpr int PI[63] = {0,2,0,1,1,4,6,4,5,5,0,2,2,1,3,3,1,3,5,8,10,8,9,9,12,14,12,13,13,8,10,10,9,11,11,9,11,13,0,4,4,2,6,6,2,6,10,1,5,5,3,7,7,3,7,11,1,3,5,7,9,11,13};
    constexpr int PJ[63] = {1,3,2,3,2,5,7,6,7,6,4,6,4,5,7,5,2,4,6,9,11,10,11,10,13,15,14,15,14,12,14,12,13,15,13,10,12,14,8,12,8,10,14,10,4,8,12,9,13,9,11,15,11,5,9,13,2,4,6,8,10,12,14};
#pragma unroll
    for (int e = 0; e < 63; ++e) { const int hi = max(k[PI[e]], k[PJ[e]]), lo = min(k[PI[e]], k[PJ[e]]); k[PI[e]] = hi; k[PJ[e]] = lo; }
}
__device__ __forceinline__ void merge_top16(int (&a)[16], const int (&b)[16]) {
#pragma unroll
    for (int i = 0; i < 16; ++i) a[i] = max(a[i], b[15 - i]);
#pragma unroll
    for (int j = 8; j > 0; j >>= 1)
#pragma unroll
        for (int i = 0; i < 16; ++i) { const int l = i ^ j; if (l > i) { const int hi = max(a[i], a[l]), lo = min(a[i], a[l]); a[i] = hi; a[l] = lo; } }
}
__device__ __forceinline__ void chunk_keys(const u32x4 w0, const u32x4 w1, int idx0, int (&k)[16]) {
    const unsigned ww[8] = {w0.x, w0.y, w0.z, w0.w, w1.x, w1.y, w1.z, w1.w};
#pragma unroll
    for (int e = 0; e < 8; ++e) { const h2_t h = __builtin_bit_cast(h2_t, ww[e]);
        k[2 * e] = (f2key((float)h.x) & ~0x7F) | (idx0 + 2 * e); k[2 * e + 1] = (f2key((float)h.y) & ~0x7F) | (idx0 + 2 * e + 1); }
}
__device__ __forceinline__ void row_top16(const unsigned short* __restrict__ row, int (&run)[16]) {
    const u32x4* rp = (const u32x4*)row;
    u32x4 w0 = rp[0], w1 = rp[1];
    chunk_keys(w0, w1, 0, run); sort16_desc(run);
    w0 = rp[2]; w1 = rp[3];
#pragma unroll 1
    for (int ch = 1; ch < 8; ++ch) {
        int k[16]; chunk_keys(w0, w1, ch * 16, k);
        if (ch < 7) { w0 = rp[2 * ch + 2]; w1 = rp[2 * ch + 3]; }
        sort16_desc(k); merge_top16(run, k);
    }
}
__device__ __forceinline__ void row_top16_lds(const LAS unsigned char* rowp, int (&run)[16]) {
    const LAS u32x4* rp = (const LAS u32x4*)rowp;
    chunk_keys(rp[0], rp[1], 0, run); sort16_desc(run);
#pragma unroll 1
    for (int ch = 1; ch < 8; ++ch) { int k[16]; chunk_keys(rp[2 * ch], rp[2 * ch + 1], ch * 16, k); sort16_desc(k); merge_top16(run, k); }
}
__device__ void phase_topk(const Params& p, unsigned char* ldsg, int gt_lo, int gt_hi, int gt_stride) {
    const unsigned short* S = (const unsigned short*)(p.ws + WS_PH);
    int* eidx = (int*)(p.ws + WS_EIDX); float* gate = (float*)(p.ws + WS_GATE);
    const int wave = threadIdx.x >> 6, lane = threadIdx.x & 63;
    LAS unsigned char* wb = (LAS unsigned char*)ldsg + wave * 17408;
    LAS int* sl = (LAS int*)wb + lane * 33;
    constexpr int OFF[16] = {0, 16, 24, 29, 33, 36, 38, 40, 42, 43, 44, 45, 46, 47, 48, 49};
    for (int gt = gt_lo + threadIdx.x; gt < gt_hi; gt += gt_stride) {
        const int t0 = (gt - lane) >> 3;
        int a[16], b[16];
#pragma unroll
        for (int pp = 0; pp < 2; ++pp) {
            u32x4 v[16];
#pragma unroll
            for (int i = 0; i < 16; ++i) { const int q = i * 64 + lane, rowid = q >> 4, within = q & 15;
                v[i] = *(const u32x4*)(S + (size_t)(t0 + (rowid >> 3)) * 2048 + ((rowid & 7) * 2 + pp) * 128 + within * 8); }
#pragma unroll
            for (int i = 0; i < 16; ++i) { const int q = i * 64 + lane, rowid = q >> 4, within = q & 15; *(LAS u32x4*)(wb + rowid * 272 + within * 16) = v[i]; }
            if (pp == 0) row_top16_lds(wb + lane * 272, a); else row_top16_lds(wb + lane * 272, b);
        }
#pragma unroll
        for (int i = 0; i < 16; ++i) { sl[i] = a[i]; sl[16 + i] = b[i]; }
        float va[16], vb[16];
#pragma unroll
        for (int i = 0; i < 16; ++i) { va[i] = key2f(a[i] & ~0x7F); vb[i] = key2f(b[i] & ~0x7F); }
        int cnd[4][16];
#pragma unroll
        for (int q = 0; q < 4; ++q)
#pragma unroll
            for (int i = 0; i < 16; ++i) cnd[q][i] = (int)0x80000000;
#pragma unroll
        for (int i = 0; i < 16; ++i)
#pragma unroll
            for (int j = 0; j < 16 / (i + 1); ++j) { const int pos = OFF[i] + j; cnd[pos >> 4][pos & 15] = (f2key(va[i] + vb[j]) & ~0xFF) | (i * 16 + j); }
        sort16_desc(cnd[0]); sort16_desc(cnd[1]); sort16_desc(cnd[2]); sort16_desc(cnd[3]);
        merge_top16(cnd[0], cnd[1]); merge_top16(cnd[2], cnd[3]); merge_top16(cnd[0], cnd[2]);
        float best[16]; int ei[16]; float m = -3.0e38f;
#pragma unroll
        for (int r = 0; r < 16; ++r) { const int code = cnd[0][r] & 0xFF; const int ka = sl[code >> 4], kb = sl[16 + (code & 15)];
            ei[r] = (ka & 0x7F) * 128 + (kb & 0x7F); best[r] = key2f(ka & ~0x7F) + key2f(kb & ~0x7F); m = fmaxf(m, best[r]); }
        float se = 0.f;
#pragma unroll
        for (int r = 0; r < 16; ++r) { best[r] = __expf(best[r] - m); se += best[r]; }
        const float inv = 1.0f / se;
#pragma unroll
        for (int q = 0; q < 4; ++q) { ((int4*)(eidx + (size_t)gt * 16))[q] = make_int4(ei[4 * q], ei[4 * q + 1], ei[4 * q + 2], ei[4 * q + 3]);
            ((float4*)(gate + (size_t)gt * 16))[q] = make_float4(best[4 * q] * inv, best[4 * q + 1] * inv, best[4 * q + 2] * inv, best[4 * q + 3] * inv); }
    }
}

typedef float f32x2 __attribute__((ext_vector_type(2)));
template <int CTRL> __device__ __forceinline__ float dpp_f(float v) { return __int_as_float(__builtin_amdgcn_update_dpp(0, __float_as_int(v), CTRL, 0xF, 0xF, false)); }
__device__ __forceinline__ void pk_load_ev(int (&ev)[16], const int* __restrict__ eidx, int tok, int q) {
    const int4* ep = (const int4*)(eidx + (size_t)tok * 128 + 16 * q);
#pragma unroll
    for (int k = 0; k < 4; ++k) { const int4 t = ep[k]; ev[4 * k] = t.x; ev[4 * k + 1] = t.y; ev[4 * k + 2] = t.z; ev[4 * k + 3] = t.w; }
}
__device__ __forceinline__ void pk_load_rows(u32x4 (&r)[16], const int (&ev)[16], const unsigned char* __restrict__ tab, unsigned loff) {
#pragma unroll
    for (int s = 0; s < 16; ++s) r[s] = *(const u32x4*)(tab + ((unsigned)ev[s] * 128u + loff));
}
__device__ __forceinline__ void pk_load_x(f32x2 (&xv)[8], const bf16_t* __restrict__ xrow) {
    const u32x4 a = ((const u32x4*)xrow)[0], b = ((const u32x4*)xrow)[1];
    xv[0] = (f32x2){bf_lo(a.x), bf_hi(a.x)}; xv[1] = (f32x2){bf_lo(a.y), bf_hi(a.y)}; xv[2] = (f32x2){bf_lo(a.z), bf_hi(a.z)}; xv[3] = (f32x2){bf_lo(a.w), bf_hi(a.w)};
    xv[4] = (f32x2){bf_lo(b.x), bf_hi(b.x)}; xv[5] = (f32x2){bf_lo(b.y), bf_hi(b.y)}; xv[6] = (f32x2){bf_lo(b.z), bf_hi(b.z)}; xv[7] = (f32x2){bf_lo(b.w), bf_hi(b.w)};
}
__device__ __forceinline__ float xchg4(float v) { return dpp_f<0x1B>(dpp_f<0x141>(v)); }
__device__ __forceinline__ void pk_u_compute(const u32x4 (&r)[16], const f32x2 (&xv)[8], bf16_t* __restrict__ pr, int c) {
    float d[16];
#pragma unroll
    for (int s = 0; s < 16; ++s) {
        f32x2 acc = {0.f, 0.f};
        acc += __builtin_amdgcn_cvt_pk_f32_fp8((int)r[s].x, false) * xv[0]; acc += __builtin_amdgcn_cvt_pk_f32_fp8((int)r[s].x, true) * xv[1];
        acc += __builtin_amdgcn_cvt_pk_f32_fp8((int)r[s].y, false) * xv[2]; acc += __builtin_amdgcn_cvt_pk_f32_fp8((int)r[s].y, true) * xv[3];
        acc += __builtin_amdgcn_cvt_pk_f32_fp8((int)r[s].z, false) * xv[4]; acc += __builtin_amdgcn_cvt_pk_f32_fp8((int)r[s].z, true) * xv[5];
        acc += __builtin_amdgcn_cvt_pk_f32_fp8((int)r[s].w, false) * xv[6]; acc += __builtin_amdgcn_cvt_pk_f32_fp8((int)r[s].w, true) * xv[7];
        d[s] = acc.x + acc.y;
    }
    float r1[8]; const bool b2 = (c & 4) != 0;
#pragma unroll
    for (int k = 0; k < 8; ++k) { const float send = b2 ? d[k] : d[k + 8], keep = b2 ? d[k + 8] : d[k]; r1[k] = keep + xchg4(send); }
    float r2[4]; const bool b1 = (c & 2) != 0;
#pragma unroll
    for (int k = 0; k < 4; ++k) { const float send = b1 ? r1[k] : r1[k + 4], keep = b1 ? r1[k + 4] : r1[k]; r2[k] = keep + dpp_f<0x4E>(send); }
    float r3[2]; const bool b0 = (c & 1) != 0;
#pragma unroll
    for (int k = 0; k < 2; ++k) { const float send = b0 ? r2[k] : r2[k + 2], keep = b0 ? r2[k + 2] : r2[k]; r3[k] = keep + dpp_f<0xB1>(send); }
    *(unsigned*)(pr + 2 * c) = pack2bf(r3[0], r3[1]);
}
__device__ void phase_peer_u(const Params& p) {
    const bf16_t* x1 = (const bf16_t*)(p.ws + WS_XB); const int* eidx = (const int*)(p.ws + WS_EIDX); bf16_t* partd = (bf16_t*)(p.ws + WS_PARTD);
    const int wave = threadIdx.x >> 6, lane = threadIdx.x & 63, q = lane >> 3, c = lane & 7;
    const int xs = blockIdx.x & 7, y = blockIdx.x >> 3, nY = gridDim.x >> 3, step = nY * 8;
    const unsigned char* tab = p.ws + WS_U8 + (size_t)xs * (16384 * 128); const unsigned loff = 16u * c;
    const bf16_t* xcol = x1 + 128 * xs + 16 * c;
    bf16_t* pbase = partd + (size_t)xs * NTOK * 128 + 16 * q;
    const int tok0 = y * 8 + wave;
    if (tok0 >= NTOK) return;
    const int ntok = (NTOK - tok0 + step - 1) / step, last = tok0 + (ntok - 1) * step;
    bf16_t* dummy = (bf16_t*)(p.ws + WS_DUMMY) + (size_t)(blockIdx.x * 8 + wave) * 128 + 16 * q;
    int ev[16]; f32x2 xvA[8], xvB[8]; u32x4 rA[16], rB[16];
    pk_load_ev(ev, eidx, tok0, q); pk_load_x(xvA, xcol + (size_t)tok0 * DM); pk_load_rows(rA, ev, tab, loff);
    pk_load_ev(ev, eidx, min(tok0 + step, last), q);
    for (int i = 0; i < ntok; i += 2) {
        const int tA = tok0 + i * step, tB = min(tA + step, last), tC = min(tA + 2 * step, last), tD = min(tA + 3 * step, last);
        pk_load_x(xvB, xcol + (size_t)tB * DM); pk_load_rows(rB, ev, tab, loff);
        pk_load_ev(ev, eidx, tC, q);
        pk_u_compute(rA, xvA, pbase + (size_t)tA * 128, c);
        pk_load_x(xvA, xcol + (size_t)tC * DM); pk_load_rows(rA, ev, tab, loff);
        pk_load_ev(ev, eidx, tD, q);
        pk_u_compute(rB, xvB, (i + 1 < ntok) ? pbase + (size_t)tB * 128 : dummy, c);
    }
}
__device__ __forceinline__ float gelu_erf(float d) { return 0.5f * d * (1.0f + erff(d * 0.70710678118654752f)); }
__device__ void phase_peer_coef(const Params& p) {
    const bf16_t* partd = (const bf16_t*)(p.ws + WS_PARTD); float* gate = (float*)(p.ws + WS_GATE);
    for (size_t i = (size_t)blockIdx.x * NTHREADS + threadIdx.x; i < (size_t)NTOK * 128 / 8; i += (size_t)gridDim.x * NTHREADS) {
        u32x4 t[8];
#pragma unroll
        for (int x = 0; x < 8; ++x) t[x] = ((const u32x4*)(partd + (size_t)x * NTOK * 128))[i];
        float4 g0 = ((const float4*)gate)[2 * i], g1 = ((const float4*)gate)[2 * i + 1];
        float sm[8];
#pragma unroll
        for (int k = 0; k < 8; ++k) sm[k] = 0.f;
#pragma unroll
        for (int x = 0; x < 8; ++x) { sm[0] += bf_lo(t[x].x); sm[1] += bf_hi(t[x].x); sm[2] += bf_lo(t[x].y); sm[3] += bf_hi(t[x].y); sm[4] += bf_lo(t[x].z); sm[5] += bf_hi(t[x].z); sm[6] += bf_lo(t[x].w); sm[7] += bf_hi(t[x].w); }
        g0.x *= gelu_erf(sm[0] * (1.0f / U_SCALE)); g0.y *= gelu_erf(sm[1] * (1.0f / U_SCALE)); g0.z *= gelu_erf(sm[2] * (1.0f / U_SCALE)); g0.w *= gelu_erf(sm[3] * (1.0f / U_SCALE));
        g1.x *= gelu_erf(sm[4] * (1.0f / U_SCALE)); g1.y *= gelu_erf(sm[5] * (1.0f / U_SCALE)); g1.z *= gelu_erf(sm[6] * (1.0f / U_SCALE)); g1.w *= gelu_erf(sm[7] * (1.0f / U_SCALE));
        ((float4*)gate)[2 * i] = g0; ((float4*)gate)[2 * i + 1] = g1;
    }
}
__device__ __forceinline__ void pk_load_cf(float (&cf)[16], const float* __restrict__ coef, int tok, int q) {
    const float4* cp = (const float4*)(coef + (size_t)tok * 128 + 16 * q);
#pragma unroll
    for (int k = 0; k < 4; ++k) { const float4 f = cp[k]; cf[4 * k] = f.x; cf[4 * k + 1] = f.y; cf[4 * k + 2] = f.z; cf[4 * k + 3] = f.w; }
}
__device__ __forceinline__ void pk_v_compute(const u32x4 (&r)[16], const float (&cf)[16], unsigned xw, bf16_t* __restrict__ orow, int q) {
    f32x2 acc[8];
#pragma unroll
    for (int k = 0; k < 8; ++k) acc[k] = (f32x2){0.f, 0.f};
#pragma unroll
    for (int s = 0; s < 16; ++s) { const f32x2 c2 = {cf[s], cf[s]};
        acc[0] += __builtin_amdgcn_cvt_pk_f32_fp8((int)r[s].x, false) * c2; acc[1] += __builtin_amdgcn_cvt_pk_f32_fp8((int)r[s].x, true) * c2;
        acc[2] += __builtin_amdgcn_cvt_pk_f32_fp8((int)r[s].y, false) * c2; acc[3] += __builtin_amdgcn_cvt_pk_f32_fp8((int)r[s].y, true) * c2;
        acc[4] += __builtin_amdgcn_cvt_pk_f32_fp8((int)r[s].z, false) * c2; acc[5] += __builtin_amdgcn_cvt_pk_f32_fp8((int)r[s].z, true) * c2;
        acc[6] += __builtin_amdgcn_cvt_pk_f32_fp8((int)r[s].w, false) * c2; acc[7] += __builtin_amdgcn_cvt_pk_f32_fp8((int)r[s].w, true) * c2; }
    f32x2 b4[4];
#pragma unroll
    for (int k = 0; k < 4; ++k) { const auto sx = __builtin_amdgcn_permlane32_swap(__float_as_uint(acc[k].x), __float_as_uint(acc[k + 4].x), false, false);
        const auto sy = __builtin_amdgcn_permlane32_swap(__float_as_uint(acc[k].y), __float_as_uint(acc[k + 4].y), false, false);
        b4[k] = (f32x2){__uint_as_float(sx[0]) + __uint_as_float(sx[1]), __uint_as_float(sy[0]) + __uint_as_float(sy[1])}; }
    f32x2 b2[2];
#pragma unroll
    for (int k = 0; k < 2; ++k) { const auto sx = __builtin_amdgcn_permlane16_swap(__float_as_uint(b4[k].x), __float_as_uint(b4[k + 2].x), false, false);
        const auto sy = __builtin_amdgcn_permlane16_swap(__float_as_uint(b4[k].y), __float_as_uint(b4[k + 2].y), false, false);
        b2[k] = (f32x2){__uint_as_float(sx[0]) + __uint_as_float(sx[1]), __uint_as_float(sy[0]) + __uint_as_float(sy[1])}; }
    f32x2 b1;
    { const bool up = (q & 1) != 0; const f32x2 send = up ? b2[0] : b2[1], keep = up ? b2[1] : b2[0];
      b1 = (f32x2){keep.x + dpp_f<0x128>(send.x), keep.y + dpp_f<0x128>(send.y)}; }
    const int co = 8 * (q >> 2) + 4 * ((q >> 1) & 1) + 2 * (q & 1);
    unsigned* op = (unsigned*)(orow + co);
    *op = pack2bf(ALPHA_C * bf_lo(xw) + b1.x * (1.0f / V_SCALE), ALPHA_C * bf_hi(xw) + b1.y * (1.0f / V_SCALE));
}
__device__ void phase_peer_v(const Params& p) {
    float* out = p.out; const int* eidx = (const int*)(p.ws + WS_EIDX); const float* coef = (const float*)(p.ws + WS_GATE);
    const int wave = threadIdx.x >> 6, lane = threadIdx.x & 63, q = lane >> 3, c = lane & 7;
    const int xs = blockIdx.x & 7, y = blockIdx.x >> 3, nY = gridDim.x >> 3, step = nY * 8;
    const unsigned char* tab = p.ws + WS_V8 + (size_t)xs * (16384 * 128); const unsigned loff = 16u * c;
    bf16_t* ocol = (bf16_t*)(p.ws + WS_XB) + 128 * xs + 16 * c;
    const int tok0 = y * 8 + wave;
    if (tok0 >= NTOK) return;
    const int ntok = (NTOK - tok0 + step - 1) / step, last = tok0 + (ntok - 1) * step;
    bf16_t* dummy = (bf16_t*)(p.ws + WS_DUMMY) + (size_t)(blockIdx.x * 8 + wave) * 128 + 16 * c;
    const int co = 8 * (q >> 2) + 4 * ((q >> 1) & 1) + 2 * (q & 1);
    int ev[16]; float cfA[16], cfB[16]; u32x4 rA[16], rB[16]; unsigned xrA, xrB;
    const bf16_t* xres = (const bf16_t*)(p.ws + WS_XB) + 128 * xs + 16 * c + co;
    pk_load_ev(ev, eidx, tok0, q); pk_load_cf(cfA, coef, tok0, q); xrA = *(const unsigned*)(xres + (size_t)tok0 * DM); pk_load_rows(rA, ev, tab, loff);
    pk_load_ev(ev, eidx, min(tok0 + step, last), q);
    for (int i = 0; i < ntok; i += 2) {
        const int tA = tok0 + i * step, tB = min(tA + step, last), tC = min(tA + 2 * step, last), tD = min(tA + 3 * step, last);
        pk_load_cf(cfB, coef, tB, q); xrB = *(const unsigned*)(xres + (size_t)tB * DM); pk_load_rows(rB, ev, tab, loff);
        pk_load_ev(ev, eidx, tC, q);
        pk_v_compute(rA, cfA, xrA, ocol + (size_t)tA * DM, q);
        pk_load_cf(cfA, coef, tC, q); xrA = *(const unsigned*)(xres + (size_t)tC * DM); pk_load_rows(rA, ev, tab, loff);
        pk_load_ev(ev, eidx, tD, q);
        pk_v_compute(rB, cfB, xrB, (i + 1 < ntok) ? ocol + (size_t)tB * DM : dummy, q);
    }
}
__device__ void phase_ln2(const Params& p) { ln_rows2<false>((const bf16_t*)(p.ws + WS_XB), p.out, nullptr, p.in[22], p.in[23], 0, NTOK, blockIdx.x * 8 + (threadIdx.x >> 6), gridDim.x * 8); }

#ifdef CONV_CHECK
constexpr size_t WS_CHK = 496 * MiB;
__device__ void conv_check(const Params& p) {
    const bf16_t* Fg = (const bf16_t*)(p.ws + WS_FG); const float* part = (const float*)(p.ws + WS_PART);
    const bf16_t* zT = (const bf16_t*)(p.ws + WS_ZT); const bf16_t* x0T = (const bf16_t*)((const unsigned char*)p.out + OUT_X0T);
    const bf16_t* yhT = (const bf16_t*)(p.ws + WS_PH); const float* hyb = p.in[14]; float* chk = (float*)(p.ws + WS_CHK);
    const int wave = threadIdx.x >> 6, lane = threadIdx.x & 63; const unsigned w = blockIdx.x * 8 + wave;
    const int seq = w % 12, variant = seq >= 4, L = variant ? L1 : L0, c = (w * 37u) % 512u; const unsigned sel = (w / 12u) % 8u;
    int t = (int)(((w * 2654435761u) >> 7) % (unsigned)L);
    if (sel == 0) t = 0; else if (sel == 1) t = L - 1; else if (sel == 2) t = 63; else if (sel == 3) t = 64; else if (sel == 4) t = L / 2;
    const bf16_t* Fc = Fg + (variant ? (size_t)512 * 2 * L0 : 0) + (size_t)c * 2 * L; const bf16_t* zc = zT + seq_base_T(seq) + (size_t)c * L;
    float sacc = 0.f; for (int s2 = lane; s2 < L; s2 += 64) sacc += __uint_as_float((unsigned)zc[s2] << 16) * __uint_as_float((unsigned)Fc[L - (t - s2)] << 16);
    float nrm = 0.f; for (int b = lane; b < (int)gridDim.x; b += 64) nrm += part[((size_t)variant * 1024 + b) * 512 + c];
#pragma unroll
    for (int o = 32; o >= 1; o >>= 1) { sacc += __shfl_xor(sacc, o); nrm += __shfl_xor(nrm, o); }
    const float x0 = __uint_as_float((unsigned)x0T[seq_base_T(seq) + (size_t)c * L + t] << 16), zt = __uint_as_float((unsigned)zc[t] << 16);
    const float ref = x0 * (sacc / nrm + hyb[c] * zt), got = __uint_as_float((unsigned)yhT[seq_base_T(seq) + (size_t)c * L + t] << 16);
    if (lane == 0) { atomicAdd(chk, (got - ref) * (got - ref)); atomicAdd(chk + 1, ref * ref); }
}
#endif
struct PanelOrder {
    int pm, nN;
    __device__ bool next(int i, pg8::Unit& u) const { if (i >= nN) return false; u.pm = pm; u.pn = i; return true; }
    __device__ __forceinline__ void a_ready(const pg8::Unit&) const {}
    __device__ __forceinline__ void done(const pg8::Unit&) const {}
};
__device__ __forceinline__ void block_handoff() { asm volatile("s_waitcnt vmcnt(0) lgkmcnt(0)" ::: "memory"); __syncthreads(); }
__device__ void phase_panel_chain(const Params& p, unsigned char* lds) {
    unsigned char* ws = p.ws;
    const int pm = blockIdx.x;
    if (pm < NTOK / 256) {
        { pg8::Gemm g{(const bf16_t*)(ws + WS_XB), (const bf16_t*)(ws + WS_WOUTT), NTOK, DM, DM}; PanelOrder S{pm, DM / 256};
          EpiH1 E{p.in[0], p.in[1], (bf16_t*)p.out};
          pg8::gemm_phase<EpiH1, PanelOrder, false>((LAS unsigned char*)lds, g, S, E, nullptr); }
        block_handoff();
        phase_ln1_panel(p, pm);
        block_handoff();
        { pg8::Gemm g{(const bf16_t*)(ws + WS_XB), (const bf16_t*)(ws + WS_WPT), NTOK, 2048, DM}; PanelOrder S{pm, 2048 / 256};
          EpiS E{(unsigned short*)(ws + WS_PH)};
          pg8::gemm_phase<EpiS, PanelOrder, false>((LAS unsigned char*)lds, g, S, E, nullptr); }
        block_handoff();
        phase_topk(p, lds, pm * 2048, pm * 2048 + 2048, NTHREADS);
        block_handoff();
    }
}

#define XB_TMO      128
#define XB_XCNT(j)  (256  + 64 * (j))
#define XB_XSUB(j)  (1280 + 64 * (j))
#define XB_XGEN(j)  (2304 + 64 * (j))
#define XB_TOP      3328
#define XB_TOPGEN   3392
#define XCD_BAR_WORDS 3456
#define XB_SPIN_CAP (1u << 18)

__device__ __forceinline__ unsigned xb_ld(unsigned* p)              { return __hip_atomic_load(p, __ATOMIC_RELAXED, __HIP_MEMORY_SCOPE_AGENT); }
__device__ __forceinline__ unsigned xb_add(unsigned* p, unsigned v) { return __hip_atomic_fetch_add(p, v, __ATOMIC_RELAXED, __HIP_MEMORY_SCOPE_AGENT); }
__device__ __forceinline__ unsigned xb_xcc_id() { return (unsigned)__builtin_amdgcn_s_getreg((3 << 11) | 20) & 0xFu; }
#define XB_SPIN(cond, bar) do { unsigned _sp = 0; while (cond) { __builtin_amdgcn_s_sleep(1); \
    if ((++_sp & 255u) == 0u) { if (xb_ld(&(bar)[XB_TMO])) break; if (_sp > XB_SPIN_CAP) { atomicAdd(&(bar)[XB_TMO], 1u); break; } } } } while (0)

struct XcdBarrier {
    unsigned* bar; unsigned x;
    volatile LAS unsigned* st;
};

__device__ __forceinline__ XcdBarrier xcd_barrier_post(unsigned* bar, volatile LAS unsigned* st) {
    XcdBarrier b; b.bar = bar; b.x = xb_xcc_id(); b.st = st;
    if (threadIdx.x == 0) (void)xb_add(&bar[XB_XCNT(b.x)], 1u);
    return b;
}
__device__ __forceinline__ void xcd_barrier_complete(unsigned* bar, unsigned x, unsigned& nloc, unsigned& nx) {
    const unsigned G = gridDim.x * gridDim.y * gridDim.z;
    unsigned sum, cnt, mine, sp = 0u;
    for (;;) {
        sum = 0u; cnt = 0u; mine = 0u;
#pragma unroll
        for (unsigned j = 0; j < 16; ++j) { const unsigned c = xb_ld(&bar[XB_XCNT(j)]); sum += c; cnt += (c > 0u) ? 1u : 0u; mine = (j == x) ? c : mine; }
        if (sum == G) break;
        __builtin_amdgcn_s_sleep(1);
        if ((++sp & 255u) == 0u) { if (xb_ld(&bar[XB_TMO])) break; if (sp > XB_SPIN_CAP) { atomicAdd(&bar[XB_TMO], 1u); break; } }
    }
    nloc = mine > 0u ? mine : 1u; nx = cnt > 0u ? cnt : 1u;
}

__device__ __forceinline__ void xcd_barrier(const XcdBarrier& b) {
    asm volatile("s_waitcnt vmcnt(0)" ::: "memory");
    __syncthreads();
    if (threadIdx.x == 0) {
        unsigned* bar = b.bar;
        __builtin_amdgcn_s_waitcnt(0);
        unsigned nloc = b.st[0], nx = b.st[1];
        if (nloc == 0u) { xcd_barrier_complete(bar, b.x, nloc, nx); b.st[0] = nloc; b.st[1] = nx; }
        const unsigned old = xb_add(&bar[XB_XSUB(b.x)], 1u);
        const unsigned gen = old / nloc;
        if (old + 1u == (gen + 1u) * nloc) {
            __builtin_amdgcn_fence(__ATOMIC_RELEASE, "agent");
            asm volatile("s_waitcnt vmcnt(0)" ::: "memory");
            const unsigned og = xb_add(&bar[XB_TOP], 1u);
            const unsigned tg = og / nx;
            if (og + 1u == (tg + 1u) * nx) xb_add(&bar[XB_TOPGEN], 1u);
            else XB_SPIN(xb_ld(&bar[XB_TOPGEN]) == tg, bar);
            __builtin_amdgcn_fence(__ATOMIC_ACQUIRE, "agent");
            xb_add(&bar[XB_XGEN(b.x)], 1u);
            asm volatile("s_waitcnt vmcnt(0)" ::: "memory");
        } else {
            XB_SPIN(xb_ld(&bar[XB_XGEN(b.x)]) == gen, bar);
            __builtin_amdgcn_fence(__ATOMIC_ACQUIRE, "agent");
            asm volatile("s_waitcnt vmcnt(0)" ::: "memory");
        }
    }
    __syncthreads();
}


__global__ void __launch_bounds__(NTHREADS) hybrid_fwd(Params p) {
    extern __shared__ __attribute__((aligned(16))) unsigned char lds[];
    cg::grid_group grid = cg::this_grid();
    const int lo = p.ph_lo, hi = p.ph_hi;
    unsigned char* ws = p.ws;
    volatile LAS unsigned* xst = (volatile LAS unsigned*)((LAS unsigned char*)lds + (LDS_BYTES - 16));
    if (threadIdx.x < 4) xst[threadIdx.x] = 0u;
    __syncthreads();
    XcdBarrier xbar = xcd_barrier_post((unsigned*)(ws + WS_BAR), xst);
#ifndef REPMASK
#define REPMASK 0
#endif
#define IN(k) (lo <= (k) && (k) < hi)
#define SEAM(k) do { if (IN(k) && IN((k) + 1)) { if (p.nrep < 0) grid.sync(); else xcd_barrier(xbar); } } while (0)
#define RUN(k, ...) do { if (IN(k)) { const int nrep_ = ((REPMASK >> (k)) & 1) ? p.nrep : 1; for (int rep_ = 0; rep_ < nrep_; ++rep_) { if (rep_) __syncthreads(); { __VA_ARGS__; } } } SEAM(k); } while (0)
    RUN(0,
        cvt_f32_bf16(p.in[0], (bf16_t*)(ws + WS_XB), (size_t)NTOK_P * DM / 8);
        cvt_f32_bf16(p.in[1], (bf16_t*)(ws + WS_XB) + (size_t)NTOK_P * DM, (size_t)NTOK_P * DM / 8);
        cvt_f32_fp8(p.in[20], ws + WS_U8, (size_t)16384 * DM / 16, U_SCALE);
        cvt_f32_fp8(p.in[21], ws + WS_V8, (size_t)16384 * DM / 16, V_SCALE);
        transpose_cvt<true>(p.in[2], 1024, 3072, (bf16_t*)(ws + WS_WINT), (float*)lds);
        transpose_cvt<false>(p.in[15], 1024, 1024, (bf16_t*)(ws + WS_WOUTT), (float*)lds);
        fold_wq_keys(p.in[18], p.in[19], (bf16_t*)(ws + WS_WPT), (float*)lds);
        hyena_filter_gen(p, (float*)lds));
    RUN(1,
        pg8::Gemm g{(const bf16_t*)(ws + WS_XB), (const bf16_t*)(ws + WS_WINT), NTOK, 3072, DM}; pg8::StaticOrder S; S.init(NTOK, 3072, gridDim.x, blockIdx.x);
        EpiP E{(bf16_t*)p.out, (bf16_t*)(ws + WS_PH), p.in[3]};
        pg8::gemm_phase<EpiP, pg8::StaticOrder, false>((LAS unsigned char*)lds, g, S, E, nullptr));
    RUN(2, phase_conv3(p, lds));
    RUN(3, phase_longconv(p, lds));
    RUN(4, phase_yh_transpose(p, lds));
    RUN(5, phase_panel_chain(p, lds));
    RUN(6, phase_peer_u(p));
    RUN(7, phase_peer_coef(p));
    RUN(8, phase_peer_v(p));
    RUN(9, phase_ln2(p));
#undef IN
#undef SEAM
#undef RUN
}

#ifdef CONV_CHECK
__global__ void __launch_bounds__(NTHREADS) k_conv_check(Params p) { conv_check(p); }
__global__ void __launch_bounds__(NTHREADS) k_conv_apply(Params p) {
    const float* chk = (const float*)(p.ws + WS_CHK); const float R = chk[0] / chk[1]; const float dl = sqrtf(fminf(R * 10.0f, 4e-4f));
    for (size_t i = (size_t)blockIdx.x * NTHREADS + threadIdx.x; i < (size_t)NTOK * DM; i += (size_t)gridDim.x * NTHREADS) { const unsigned hsh = (unsigned)i * 2654435761u; p.out[i] *= (hsh & 0x8000u) ? (1.0f + dl) : (1.0f - dl); }
}
#endif
extern "C" void kernel_launch(void* const* d_in, const int* in_sizes, int n_in, void* d_out, int out_size, void* d_ws, size_t ws_size, hipStream_t stream) {
    static int grid = 0;
    if (grid == 0) {
        if (n_in != 24 || out_size != NTOK * DM || ws_size < WS_END) { fprintf(stderr, "kernel_launch: unexpected shapes (n_in %d out %d ws %zu)\n", n_in, out_size, ws_size); grid = -1; return; }
        int dev = 0, cus = 0, per_cu = 0;
        hipGetDevice(&dev); hipDeviceGetAttribute(&cus, hipDeviceAttributeMultiprocessorCount, dev);
        if (hipFuncSetAttribute((const void*)hybrid_fwd, hipFuncAttributeMaxDynamicSharedMemorySize, LDS_BYTES) != hipSuccess) { fprintf(stderr, "kernel_launch: hipFuncSetAttribute failed\n"); grid = -1; return; }
        if (hipOccupancyMaxActiveBlocksPerMultiprocessor(&per_cu, (const void*)hybrid_fwd, NTHREADS, LDS_BYTES) != hipSuccess || per_cu < 1) { fprintf(stderr, "kernel_launch: occupancy query says %d\n", per_cu); per_cu = 1; }
        (void)hipGetLastError();
        grid = cus * per_cu; if (grid > 256) grid = 256;
        if (grid != NTOK / 256) { fprintf(stderr, "kernel_launch: this kernel needs %d co-resident workgroups, the device offers %d\n", NTOK / 256, grid); grid = -1; return; }
    }
    if (grid < 0) return;
    Params p{};
    for (int i = 0; i < 24; ++i) p.in[i] = (const float*)d_in[i];
    p.out = (float*)d_out; p.ws = (unsigned char*)d_ws; p.nrep = 2; p.pad = 0;
    if (hipMemsetAsync((unsigned char*)d_ws + WS_BAR, 0, XCD_BAR_WORDS * sizeof(unsigned), stream) != hipSuccess) { fprintf(stderr, "kernel_launch: memset of the barrier words failed\n"); return; }
#ifdef CONV_CHECK
    {
        hipMemsetAsync((unsigned char*)d_ws + WS_CHK, 0, 8, stream);
        void* args[] = {&p};
        p.ph_lo = 0; p.ph_hi = 4; hipLaunchCooperativeKernel((const void*)hybrid_fwd, dim3(grid), dim3(NTHREADS), args, LDS_BYTES, stream);
        hipLaunchKernelGGL(k_conv_check, dim3(grid), dim3(NTHREADS), 0, stream, p);
        hipMemsetAsync((unsigned char*)d_ws + WS_BAR, 0, XCD_BAR_WORDS * sizeof(unsigned), stream);
        p.ph_lo = 4; p.ph_hi = NPHASE; hipLaunchCooperativeKernel((const void*)hybrid_fwd, dim3(grid), dim3(NTHREADS), args, LDS_BYTES, stream);
        hipLaunchKernelGGL(k_conv_apply, dim3(grid), dim3(NTHREADS), 0, stream, p);
        return;
    }
#endif
#if ONE_LAUNCH
    p.ph_lo = 0; p.ph_hi = NPHASE;
    void* args[] = {&p};
    hipError_t e = hipLaunchCooperativeKernel((const void*)hybrid_fwd, dim3(grid), dim3(NTHREADS), args, LDS_BYTES, stream);
    if (e != hipSuccess) fprintf(stderr, "cooperative launch failed: %s (grid %d)\n", hipGetErrorString(e), grid);
#else
#ifndef HOSTREP
#define HOSTREP 0
#endif
    for (int ph = 0; ph < NPHASE; ++ph) { p.ph_lo = ph; p.ph_hi = ph + 1; const int nl = ((HOSTREP >> ph) & 1) ? 2 : 1;
        for (int r = 0; r < nl; ++r) hipLaunchKernelGGL(hybrid_fwd, dim3(grid), dim3(NTHREADS), LDS_BYTES, stream, p); }
#endif
}
```
